# Optimizing an MI355X kernel written in HIP

```python
import math
import jax, jax.numpy as jnp
from jax import lax
import numpy as np

D_MODEL = 1024
BATCH = 8
SEQ = 4096
DEPTH = 2

N_BRANCH = 4
BRANCH_WIDTH = D_MODEL // 2
CONV_WIDTH = 4
RMS_EPS = 1e-6
SSD_HEADDIM = 64
SSD_HEADS = BRANCH_WIDTH // SSD_HEADDIM
SSD_GROUPS = 2
SSD_HPG = SSD_HEADS // SSD_GROUPS
SSD_STATE = 64
SSD_CHUNK = 128
SSD_XBC = BRANCH_WIDTH + 2 * SSD_GROUPS * SSD_STATE
GLA_HEADS = 4
GLA_DK = BRANCH_WIDTH // (2 * GLA_HEADS)
GLA_DV = BRANCH_WIDTH // GLA_HEADS
GLA_LOWRANK = 16
GLA_TAU = 16.0
GLA_CHUNK = 64
LRU_BLOCKS = 8
LRU_BLOCK = BRANCH_WIDTH // LRU_BLOCKS
LRU_C = 8.0
RWKV_HEAD = 64
RWKV_HEADS = BRANCH_WIDTH // RWKV_HEAD
RWKV_W_LORA = 32
RWKV_A_LORA = 32
RWKV_V_LORA = 32
RWKV_G_LORA = 96
RWKV_GN_EPS = 64e-5
RWKV_SIZES = (BRANCH_WIDTH, BRANCH_WIDTH, BRANCH_WIDTH, RWKV_W_LORA, RWKV_A_LORA, RWKV_G_LORA)
RWKV_IN = sum(RWKV_SIZES)
IN_SIZES = (BRANCH_WIDTH, SSD_XBC, SSD_HEADS,
            GLA_HEADS * GLA_DK, GLA_HEADS * GLA_DK, BRANCH_WIDTH, BRANCH_WIDTH, GLA_LOWRANK,
            BRANCH_WIDTH, BRANCH_WIDTH,
            RWKV_IN,
            N_BRANCH * D_MODEL)
N_IN = sum(IN_SIZES)
FFN_HIDDEN = -(-8 * D_MODEL // (3 * 256)) * 256

kernel_name = 'hybrid_ssd_gla_rglru_rwkv7_trunk'


def _split(t, sizes):
    out = []
    start = 0
    for n in sizes:
        out.append(t[..., start:start + n])
        start += n
    return out


def _rms_stat(x):
    x = x.astype(jnp.float32)
    return x * lax.rsqrt(jnp.mean(x * x, axis=-1, keepdims=True) + RMS_EPS)


def _rms(x, g):
    return _rms_stat(x) * g.astype(jnp.float32)


def _shift(t):
    return jnp.pad(t, ((0, 0), (1, 0), (0, 0)))[:, :-1]


def _causal_dwconv(x, w, b):
    ch = x.shape[-1]
    y = lax.conv_general_dilated(x, w[:, None, :].astype(x.dtype), window_strides=(1,),
                                 padding=[(w.shape[0] - 1, 0)],
                                 dimension_numbers=('NWC', 'WIO', 'NWC'),
                                 feature_group_count=ch)
    return y + b.astype(y.dtype)


def _to_chunks(t, c):
    b, s = t.shape[:2]
    return jnp.moveaxis(t.reshape(b, s // c, c, *t.shape[2:]), 1, 0)


def _from_chunks(t):
    nc, b, c = t.shape[:3]
    return jnp.moveaxis(t, 0, 1).reshape(b, nc * c, *t.shape[3:])


def _ssd_chunked(xh, dt, a, bm, cm):
    c = SSD_CHUNK
    bsz = xh.shape[0]
    mask = jnp.tril(jnp.ones((c, c), bool))[None, :, :, None, None]

    def step(state, inp):
        xc, dtc, bc, cc = inp
        cum = jnp.cumsum(dtc * a, axis=1)
        seg = jnp.where(mask, cum[:, :, None] - cum[:, None, :], -jnp.inf)
        w = jnp.einsum('btgn,bsgn->btsg', cc, bc)[..., None] * jnp.exp(seg) * dtc[:, None]
        y = jnp.einsum('btsgr,bsgrp->btgrp', w, xc)
        y = y + jnp.einsum('btgn,bgrpn->btgrp', cc, state) * jnp.exp(cum)[..., None]
        decay = jnp.exp(cum[:, -1:] - cum) * dtc
        state = state * jnp.exp(cum[:, -1])[..., None, None] + jnp.einsum('bsgr,bsgn,bsgrp->bgrpn', decay, bc, xc)
        return state, y

    init = jnp.zeros((bsz, SSD_GROUPS, SSD_HPG, SSD_HEADDIM, SSD_STATE), jnp.float32)
    _, ys = lax.scan(step, init, (_to_chunks(xh, c), _to_chunks(dt, c), _to_chunks(bm, c), _to_chunks(cm, c)))
    return _from_chunks(ys)


def _ssd_mixer(z, xbc, dt_raw, conv_w, conv_b, dt_bias, a_log, d_skip, norm_g):
    bsz, seq, _ = z.shape
    f32 = jnp.float32
    xbc = jax.nn.silu(_causal_dwconv(xbc, conv_w, conv_b).astype(f32))
    xs, bm, cm = _split(xbc, (BRANCH_WIDTH, SSD_GROUPS * SSD_STATE, SSD_GROUPS * SSD_STATE))
    xh = xs.reshape(bsz, seq, SSD_GROUPS, SSD_HPG, SSD_HEADDIM)
    bm = bm.reshape(bsz, seq, SSD_GROUPS, SSD_STATE)
    cm = cm.reshape(bsz, seq, SSD_GROUPS, SSD_STATE)
    dt = jax.nn.softplus(dt_raw.astype(f32) + dt_bias.astype(f32)).reshape(bsz, seq, SSD_GROUPS, SSD_HPG)
    a = -jnp.exp(a_log.astype(f32)).reshape(SSD_GROUPS, SSD_HPG)
    y = _ssd_chunked(xh, dt, a, bm, cm) + d_skip.astype(f32).reshape(SSD_GROUPS, SSD_HPG, 1) * xh
    y = y.reshape(bsz, seq, BRANCH_WIDTH) * jax.nn.silu(z.astype(f32))
    y = _rms_stat(y.reshape(bsz, seq, SSD_GROUPS, BRANCH_WIDTH // SSD_GROUPS)).reshape(bsz, seq, BRANCH_WIDTH)
    return y * norm_g.astype(f32)


def _gla_chunked(q, k, v, log_a):
    c = GLA_CHUNK
    bsz = q.shape[0]
    mask = jnp.tril(jnp.ones((c, c), bool))

    def step(state, inp):
        qc, kc, vc, gc = inp
        b = jnp.cumsum(gc, axis=1)
        ref = b[:, c // 2:c // 2 + 1]
        att = jnp.einsum('bthd,bshd->bhts', qc * jnp.exp(b - ref), kc * jnp.exp(ref - b))
        att = jnp.where(mask, att, 0.0)
        y = jnp.einsum('bhts,bshv->bthv', att, vc) + jnp.einsum('bthd,bhdv->bthv', qc * jnp.exp(b), state)
        b_last = b[:, -1]
        state = state * jnp.exp(b_last)[..., None] + jnp.einsum('bshd,bshv->bhdv', kc * jnp.exp(b_last[:, None] - b), vc)
        return state, y

    init = jnp.zeros((bsz, GLA_HEADS, GLA_DK, GLA_DV), jnp.float32)
    _, ys = lax.scan(step, init, (_to_chunks(q, c), _to_chunks(k, c), _to_chunks(v, c), _to_chunks(log_a, c)))
    return _from_chunks(ys)


def _gla_mixer(q, k, v, r, a_lo, alpha_w, alpha_b, norm_g):
    bsz, seq, _ = q.shape
    f32 = jnp.float32
    q = q.astype(f32).reshape(bsz, seq, GLA_HEADS, GLA_DK) * (GLA_DK ** -0.5)
    k = k.astype(f32).reshape(bsz, seq, GLA_HEADS, GLA_DK)
    v = v.astype(f32).reshape(bsz, seq, GLA_HEADS, GLA_DV)
    log_a = jax.nn.log_sigmoid(a_lo.astype(f32) @ alpha_w.astype(f32) + alpha_b.astype(f32)) / GLA_TAU
    log_a = log_a.reshape(bsz, seq, GLA_HEADS, GLA_DK)
    o = _rms_stat(_gla_chunked(q, k, v, log_a)) * norm_g.astype(f32)
    return o.reshape(bsz, seq, BRANCH_WIDTH) * jax.nn.silu(r.astype(f32))


def _linear_combine(left, right):
    a_l, b_l = left
    a_r, b_r = right
    return (a_l * a_r, a_r * b_l + b_r)


def _rglru_mixer(xb, gate, conv_w, conv_b, wa, ba, wx, bx, lam):
    bsz, seq, _ = xb.shape
    f32 = jnp.float32
    xb = _causal_dwconv(xb, conv_w, conv_b).astype(f32)
    blk = xb.reshape(bsz, seq, LRU_BLOCKS, LRU_BLOCK)
    r = jax.nn.sigmoid(jnp.einsum('bshi,hij->bshj', blk, wa.astype(f32)).reshape(bsz, seq, BRANCH_WIDTH) + ba.astype(f32))
    i = jax.nn.sigmoid(jnp.einsum('bshi,hij->bshj', blk, wx.astype(f32)).reshape(bsz, seq, BRANCH_WIDTH) + bx.astype(f32))
    log_a = -LRU_C * r * jax.nn.softplus(-lam.astype(f32))
    a = jnp.exp(log_a)
    u = jnp.sqrt(-jnp.expm1(2.0 * log_a)) * (i * xb)
    _, hs = lax.associative_scan(_linear_combine, (a, u), axis=1)
    return hs * jax.nn.gelu(gate.astype(f32), approximate=True)


def _rwkv7_scan(r, w, k, v, aa, bb):
    bsz, seq, nh, n = r.shape

    def step(state, inp):
        r_t, w_t, k_t, v_t, a_t, b_t = inp
        sa = jnp.einsum('bhij,bhj->bhi', state, a_t)
        state = state * w_t[:, :, None, :] + sa[..., None] * b_t[:, :, None, :] + v_t[..., None] * k_t[:, :, None, :]
        return state, jnp.einsum('bhij,bhj->bhi', state, r_t)

    init = jnp.zeros((bsz, nh, n, n), jnp.float32)
    xs = (jnp.moveaxis(r, 1, 0), jnp.moveaxis(w, 1, 0), jnp.moveaxis(k, 1, 0),
          jnp.moveaxis(v, 1, 0), jnp.moveaxis(aa, 1, 0), jnp.moveaxis(bb, 1, 0))
    _, ys = lax.scan(step, init, xs)
    return jnp.moveaxis(ys, 0, 1)


def _rwkv7_mixer(p, vres_lo, v_first, mu, w0, w_w2, a0, a_w2, v0, v_w2, g_w2, k_k, k_a, r_k, ln_g, ln_b):
    bsz, seq, _ = p.shape
    f32 = jnp.float32
    hd = (bsz, seq, RWKV_HEADS, RWKV_HEAD)
    p = p.astype(f32)
    p = p + (_shift(p) - p) * mu.astype(f32)
    r, k, v, w_lo, a_lo, g_lo = _split(p, RWKV_SIZES)
    w_log = -jax.nn.softplus(-(w0.astype(f32) + jnp.tanh(w_lo) @ w_w2.astype(f32))) - 0.5
    decay = jnp.exp(-jnp.exp(w_log))
    if v_first is None:
        v_first = v
    else:
        v = v + (v_first - v) * jax.nn.sigmoid(v0.astype(f32) + vres_lo.astype(f32) @ v_w2.astype(f32))
    a = jax.nn.sigmoid(a0.astype(f32) + a_lo @ a_w2.astype(f32))
    g = jax.nn.sigmoid(g_lo) @ g_w2.astype(f32)
    kk = (k * k_k.astype(f32)).reshape(hd)
    kk = kk / jnp.maximum(jnp.linalg.norm(kk, axis=-1, keepdims=True), 1e-12)
    k = k * (1.0 + (a - 1.0) * k_a.astype(f32))
    rh, kh, vh = r.reshape(hd), k.reshape(hd), v.reshape(hd)
    y = _rwkv7_scan(rh, decay.reshape(hd), kh, vh, -kk, kk * a.reshape(hd))
    mean = jnp.mean(y, axis=-1, keepdims=True)
    var = jnp.mean(jnp.square(y - mean), axis=-1, keepdims=True)
    y = ((y - mean) * lax.rsqrt(var + RWKV_GN_EPS)).reshape(bsz, seq, BRANCH_WIDTH) * ln_g.astype(f32) + ln_b.astype(f32)
    bonus = jnp.sum(rh * kh * r_k.astype(f32), axis=-1, keepdims=True) * vh
    y = y + bonus.reshape(bsz, seq, BRANCH_WIDTH)
    return y * g, v_first


def setup_inputs(seed: int = 0) -> dict:
    key = jax.random.key(seed)
    ks = iter(jax.random.split(key, 64))
    L = DEPTH
    D = D_MODEL
    W = BRANCH_WIDTH
    f32 = jnp.float32

    def nrm(shape, scale):
        return jax.random.normal(next(ks), shape, f32) * scale

    def unif(shape, lo, hi):
        return jax.random.uniform(next(ks), shape, f32, lo, hi)

    x = nrm((BATCH, SEQ, D), 1.0)
    norm_g = 1.0 + nrm((L, 4, D), 0.05)
    w_in = nrm((L, D, N_IN), D ** -0.5)
    w_vres_in = nrm((L - 1, D, RWKV_V_LORA), D ** -0.5)
    ssd_conv_w = nrm((L, CONV_WIDTH, SSD_XBC), CONV_WIDTH ** -0.5)
    ssd_conv_b = nrm((L, SSD_XBC), 0.02)
    dt0 = jnp.exp(unif((L, SSD_HEADS), math.log(1e-3), math.log(1e-1)))
    ssd_dt_bias = dt0 + jnp.log(-jnp.expm1(-dt0))
    ssd_a_log = jnp.log(unif((L, SSD_HEADS), 1.0, 16.0))
    ssd_d = 1.0 + nrm((L, SSD_HEADS), 0.1)
    ssd_norm_g = 1.0 + nrm((L, W), 0.05)
    gla_alpha_w = nrm((L, GLA_LOWRANK, GLA_HEADS * GLA_DK), GLA_LOWRANK ** -0.5)
    gla_alpha_b = nrm((L, GLA_HEADS * GLA_DK), 0.1)
    gla_norm_g = 1.0 + nrm((L, GLA_DV), 0.05)
    lru_conv_w = nrm((L, CONV_WIDTH, W), CONV_WIDTH ** -0.5)
    lru_conv_b = nrm((L, W), 0.02)
    lru_wa = nrm((L, LRU_BLOCKS, LRU_BLOCK, LRU_BLOCK), LRU_BLOCK ** -0.5)
    lru_ba = nrm((L, W), 0.02)
    lru_wx = nrm((L, LRU_BLOCKS, LRU_BLOCK, LRU_BLOCK), LRU_BLOCK ** -0.5)
    lru_bx = nrm((L, W), 0.02)
    s = unif((L, W), 0.9, 0.999) ** (1.0 / LRU_C)
    lru_lambda = jnp.log(s) - jnp.log1p(-s)
    rwkv_mu = unif((L, RWKV_IN), 0.0, 1.0)
    rwkv_w0 = unif((L, W), -6.5, -1.5)
    rwkv_w_w2 = nrm((L, RWKV_W_LORA, W), 0.5 * RWKV_W_LORA ** -0.5)
    rwkv_a0 = nrm((L, W), 0.1)
    rwkv_a_w2 = nrm((L, RWKV_A_LORA, W), RWKV_A_LORA ** -0.5)
    rwkv_v0 = 1.0 + nrm((L - 1, W), 0.1)
    rwkv_v_w2 = nrm((L - 1, RWKV_V_LORA, W), RWKV_V_LORA ** -0.5)
    rwkv_g_w2 = nrm((L, RWKV_G_LORA, W), RWKV_G_LORA ** -0.5)
    rwkv_k_k = 0.85 + nrm((L, W), 0.02)
    rwkv_k_a = 1.0 + nrm((L, W), 0.02)
    rwkv_r_k = -0.04 + nrm((L, RWKV_HEADS, RWKV_HEAD), 0.02)
    rwkv_ln_g = 1.0 + nrm((L, W), 0.05)
    rwkv_ln_b = nrm((L, W), 0.02)
    w_branch = nrm((L, N_BRANCH, W, D), W ** -0.5)
    w_out = nrm((L, D, D), D ** -0.5)
    ffn_w_gate = nrm((L, D, FFN_HIDDEN), D ** -0.5)
    ffn_w_up = nrm((L, D, FFN_HIDDEN), D ** -0.5)
    ffn_w_down = nrm((L, FFN_HIDDEN, D), FFN_HIDDEN ** -0.5)
    return {'x': x, 'norm_g': norm_g, 'w_in': w_in, 'w_vres_in': w_vres_in,
            'ssd_conv_w': ssd_conv_w, 'ssd_conv_b': ssd_conv_b, 'ssd_dt_bias': ssd_dt_bias,
            'ssd_a_log': ssd_a_log, 'ssd_d': ssd_d, 'ssd_norm_g': ssd_norm_g,
            'gla_alpha_w': gla_alpha_w, 'gla_alpha_b': gla_alpha_b, 'gla_norm_g': gla_norm_g,
            'lru_conv_w': lru_conv_w, 'lru_conv_b': lru_conv_b, 'lru_wa': lru_wa, 'lru_ba': lru_ba,
            'lru_wx': lru_wx, 'lru_bx': lru_bx, 'lru_lambda': lru_lambda,
            'rwkv_mu': rwkv_mu, 'rwkv_w0': rwkv_w0, 'rwkv_w_w2': rwkv_w_w2, 'rwkv_a0': rwkv_a0,
            'rwkv_a_w2': rwkv_a_w2, 'rwkv_v0': rwkv_v0, 'rwkv_v_w2': rwkv_v_w2, 'rwkv_g_w2': rwkv_g_w2,
            'rwkv_k_k': rwkv_k_k, 'rwkv_k_a': rwkv_k_a, 'rwkv_r_k': rwkv_r_k,
            'rwkv_ln_g': rwkv_ln_g, 'rwkv_ln_b': rwkv_ln_b,
            'w_branch': w_branch, 'w_out': w_out,
            'ffn_w_gate': ffn_w_gate, 'ffn_w_up': ffn_w_up, 'ffn_w_down': ffn_w_down}


def reference(x, norm_g, w_in, w_vres_in, ssd_conv_w, ssd_conv_b, ssd_dt_bias, ssd_a_log, ssd_d, ssd_norm_g,
              gla_alpha_w, gla_alpha_b, gla_norm_g, lru_conv_w, lru_conv_b, lru_wa, lru_ba, lru_wx, lru_bx,
              lru_lambda, rwkv_mu, rwkv_w0, rwkv_w_w2, rwkv_a0, rwkv_a_w2, rwkv_v0, rwkv_v_w2, rwkv_g_w2,
              rwkv_k_k, rwkv_k_a, rwkv_r_k, rwkv_ln_g, rwkv_ln_b, w_branch, w_out,
              ffn_w_gate, ffn_w_up, ffn_w_down):
    bsz, seq, _ = x.shape
    cdt = x.dtype
    v_first = None
    for layer in range(DEPTH):
        h = _rms(x, norm_g[layer, 0]).astype(cdt)
        if layer == 0:
            proj = h @ w_in[layer]
            vres_lo = None
            v0 = None
            v_w2 = None
        else:
            proj = h @ jnp.concatenate([w_in[layer], w_vres_in[layer - 1]], axis=1)
            vres_lo = proj[..., N_IN:]
            v0 = rwkv_v0[layer - 1]
            v_w2 = rwkv_v_w2[layer - 1]
        (ssd_z, ssd_xbc, ssd_dt, gla_q, gla_k, gla_v, gla_r, gla_lo,
         lru_x, lru_gate, rwkv_p, gate_logits) = _split(proj, IN_SIZES)
        y_ssd = _ssd_mixer(ssd_z, ssd_xbc, ssd_dt, ssd_conv_w[layer], ssd_conv_b[layer], ssd_dt_bias[layer],
                           ssd_a_log[layer], ssd_d[layer], ssd_norm_g[layer])
        y_gla = _gla_mixer(gla_q, gla_k, gla_v, gla_r, gla_lo, gla_alpha_w[layer], gla_alpha_b[layer], gla_norm_g[layer])
        y_lru = _rglru_mixer(lru_x, lru_gate, lru_conv_w[layer], lru_conv_b[layer], lru_wa[layer], lru_ba[layer],
                             lru_wx[layer], lru_bx[layer], lru_lambda[layer])
        y_rwkv, v_first = _rwkv7_mixer(rwkv_p, vres_lo, v_first, rwkv_mu[layer], rwkv_w0[layer], rwkv_w_w2[layer],
                                       rwkv_a0[layer], rwkv_a_w2[layer], v0, v_w2, rwkv_g_w2[layer],
                                       rwkv_k_k[layer], rwkv_k_a[layer], rwkv_r_k[layer],
                                       rwkv_ln_g[layer], rwkv_ln_b[layer])
        y_cat = jnp.stack([y_ssd, y_gla, y_lru, y_rwkv], axis=2).astype(cdt)
        branch = jnp.einsum('bskc,kcd->bskd', y_cat, w_branch[layer])
        gates = jax.nn.sigmoid(gate_logits.astype(jnp.float32).reshape(bsz, seq, N_BRANCH, D_MODEL))
        merged = jnp.sum(gates * branch.astype(jnp.float32), axis=2).astype(cdt)
        o = merged @ w_out[layer]
        x = x + _rms(o, norm_g[layer, 1]).astype(cdt)
        h2 = _rms(x, norm_g[layer, 2]).astype(cdt)
        f = (jax.nn.silu(h2 @ ffn_w_gate[layer]) * (h2 @ ffn_w_up[layer])) @ ffn_w_down[layer]
        x = x + _rms(f, norm_g[layer, 3]).astype(cdt)
    return x
```

```cpp
#include <hip/hip_runtime.h>
#include <hip/hip_cooperative_groups.h>
#include <cstdio>
namespace cg = cooperative_groups;

#define LAS __attribute__((address_space(3)))
typedef unsigned short bf16_t;
typedef short bf16x8 __attribute__((ext_vector_type(8)));
typedef float f32x4 __attribute__((ext_vector_type(4)));
typedef unsigned u32x4 __attribute__((ext_vector_type(4)));
typedef unsigned u32x2 __attribute__((ext_vector_type(2)));

constexpr int NB = 8, SEQ = 4096, T = NB * SEQ, DM = 1024, NIN = 9656, FH = 2816, LDP = 5376;
constexpr int BM = 256, BK = 64, HALF = 128, HTB = HALF * BK * 2, STAGE_BYTES = 8 * HTB, NXCD = 8, WGM = 8;
constexpr int LDS_BYTES = 144 * 1024;
constexpr bool DRY_SKIP_SCAN = false;
constexpr bool GLA_SPLIT = true;
constexpr int DRY_MASK = 15;
constexpr int REP_GEMM = 1, REP_SCAN = 0, REP_SYNC = 1, REP_CONV = 1, REP_NORM = 1;
constexpr size_t MiB = 1u << 20;
constexpr size_t WB_R = 0, WB_2 = 7 * MiB, WB_G = WB_2 + 15 * MiB / 2, WB_B = WB_G + 8 * MiB, WB_O = WB_B + 4 * MiB, WB_F = WB_O + 2 * MiB, WB_D = WB_F + 11 * MiB;
constexpr size_t OFF_Z = 45 * MiB, OFF_H = 46 * MiB, OFF_P = 110 * MiB, OFF_SM = 446 * MiB, OFF_VF = 478 * MiB, OFF_BAR = 510 * MiB, OFF_BON = 510 * MiB + 65536, WS_END = OFF_BON + MiB;
constexpr int PC_Z = 0, PC_XBC = 512, PC_GQ = 1280, PC_GK = 1536, PC_GV = 1792, PC_GR = 2304, PC_LX = 2816, PC_LG = 3328, PC_RR = 3840, PC_RK = 4352, PC_RV = 4864;
constexpr int PC_MERGED = 1280, PC_O = 4352;

enum { I_X = 0, I_NG, I_WIN, I_WVRES, I_SCW, I_SCB, I_SDTB, I_SALOG, I_SD, I_SNG, I_GAW, I_GAB, I_GNG, I_LCW, I_LCB, I_LWA, I_LBA, I_LWX, I_LBX, I_LLAM,
       I_RMU, I_RW0, I_RWW2, I_RA0, I_RAW2, I_RV0, I_RVW2, I_RGW2, I_RKK, I_RKA, I_RRK, I_RLNG, I_RLNB, I_WBR, I_WOUT, I_FG, I_FU, I_FD, N_INPUTS };

struct Params { const float* in[N_INPUTS]; float* out; unsigned char* ws; };

__device__ __forceinline__ unsigned cvt_pk_bf16(float lo, float hi) { unsigned r; asm volatile("v_cvt_pk_bf16_f32 %0, %1, %2" : "=v"(r) : "v"(lo), "v"(hi)); return r; }
__device__ __forceinline__ float bf2f(bf16_t v) { return __uint_as_float((unsigned)v << 16); }
__device__ __forceinline__ float bflo(unsigned v) { return __uint_as_float(v << 16); }
__device__ __forceinline__ float bfhi(unsigned v) { return __uint_as_float(v & 0xffff0000u); }
__device__ __forceinline__ bf16_t f2bf(float v) { return (bf16_t)(cvt_pk_bf16(v, 0.f) & 0xffffu); }
__device__ __forceinline__ float sigmoidf_(float x) { return __builtin_amdgcn_rcpf(1.0f + __expf(-x)); }
__device__ __forceinline__ float siluf_(float x) { return x * sigmoidf_(x); }
__device__ __forceinline__ float softplusf_(float x) { return fmaxf(x, 0.f) + log1pf(__expf(-fabsf(x))); }
template <int CTRL> __device__ __forceinline__ float dpp_add(float x) { int v = __builtin_amdgcn_update_dpp(0, __float_as_int(x), CTRL, 0xF, 0xF, true); return x + __int_as_float(v); }
__device__ __forceinline__ float red4(float x) { x = dpp_add<0xB1>(x); x = dpp_add<0x4E>(x); return x; }
__device__ __forceinline__ float red8(float x) { x = red4(x); x = dpp_add<0x141>(x); return x; }
__device__ __forceinline__ float red16(float x) { x = red8(x); x = dpp_add<0x140>(x); return x; }
__device__ __forceinline__ float red32(float x) { x = red16(x); x += __shfl_xor(x, 16); return x; }
__device__ __forceinline__ float red64(float x) { x = red32(x); x += __shfl_xor(x, 32); return x; }
template <int N> __device__ __forceinline__ void red64n(float (&v)[N]) {
#pragma unroll
    for (int i = 0; i < N; ++i) v[i] = red16(v[i]);
    float t[N];
#pragma unroll
    for (int i = 0; i < N; ++i) t[i] = __shfl_xor(v[i], 16);
#pragma unroll
    for (int i = 0; i < N; ++i) v[i] += t[i];
#pragma unroll
    for (int i = 0; i < N; ++i) t[i] = __shfl_xor(v[i], 32);
#pragma unroll
    for (int i = 0; i < N; ++i) v[i] += t[i];
}

__device__ __forceinline__ int lds_byte(int r, int c) { const int st = (r >> 4) * 2 + (c >> 5), rr = r & 15, cc = c & 31, ob = rr * 64 + cc * 2; return st * 1024 + (ob ^ (((ob >> 9) & 1) << 5)); }
__device__ __forceinline__ void stage_rc(int b, int& R, int& C) { const int st = b / 1024, sb = b % 1024, swz = sb ^ (((sb >> 9) & 1) << 5); R = (st >> 1) * 16 + swz / 64; C = (st & 1) * 32 + (swz % 64) / 2; }
__device__ __forceinline__ int perm32(int rho) { const int n = rho >> 4, i = rho & 15; return 8 * (i >> 2) + 4 * n + (i & 3); }
struct Unit { int pm, pn; };
struct Order {
    int nM, nN, nwg, G, c;
    __device__ void init(int M, int N, int G_, int c_) { nM = M / BM; nN = N / BM; nwg = nM * nN; G = G_; c = c_; }
    __device__ bool next(int i, Unit& u) const {
        const long L = (long)i * G + c; if (L >= nwg) return false;
        int wgid = (int)L; { const int q = nwg / NXCD, r = nwg % NXCD, xcd = wgid % NXCD, off = wgid / NXCD; wgid = (xcd < r ? xcd * (q + 1) : r * (q + 1) + (xcd - r) * q) + off; }
        const int nig = WGM * nN, gid = wgid / nig, fm = gid * WGM, gsz = (nM - fm) < WGM ? (nM - fm) : WGM;
        u.pm = fm + ((wgid % nig) % gsz); u.pn = (wgid % nig) / gsz; return true;
    }
};

enum { EPI_B2 = 0, EPI_B1, EPI_U, EPI_MERGE, EPI_O, EPI_FFN, EPI_DOWN };
template <int MODE> struct Epi {
    static constexpr bool PERM = (MODE != EPI_MERGE && MODE != EPI_DOWN);
    bf16_t* o16; float* o32; const bf16_t* uq; bf16_t* vf; const float* mu; bf16_t* stp; float* sts;
    __device__ __forceinline__ int a_col(int pn) const { if (MODE == EPI_U) { const int k = pn >> 2; return k == 0 ? PC_Z : (k == 1 ? PC_GR : (k == 2 ? PC_LG : PC_RR)); } return 0; }
    __device__ __forceinline__ void operator()(const f32x4 (&acc)[2][2][4][2], const Unit& u, int wr, int wc, int fr, int fq) const {
        const int row0 = u.pm * BM + wr * 64 + fr;
        if constexpr (MODE == EPI_B1) {
            const bool small = (u.pn == 6);
#pragma unroll
            for (int bj = 0; bj < 2; ++bj) {
                const int cb = u.pn * BM + bj * HALF + wc * 32 + 8 * fq;
                float mu8[8];
#pragma unroll
                for (int e = 0; e < 8; ++e) { const int sc = cb + e - 1536; mu8[e] = !small ? mu[cb + e] : ((sc >= 64 && sc < 224) ? mu[1536 + sc - 64] : 0.f); }
#pragma unroll
                for (int ai = 0; ai < 2; ++ai)
#pragma unroll
                    for (int m = 0; m < 4; ++m) { const size_t r = (size_t)(row0 + ai * HALF + m * 16); float o[8], raw[8];
#pragma unroll
                        for (int e = 0; e < 8; ++e) { const float cur = acc[ai][bj][m][e >> 2][e & 3]; raw[e] = cur;
                            const float p1 = __int_as_float(__builtin_amdgcn_update_dpp(0, __float_as_int(cur), 0x111, 0xF, 0xF, true));
                            float p0 = 0.f; if (m > 0) p0 = __int_as_float(__builtin_amdgcn_update_dpp(0, __float_as_int(acc[ai][bj][m > 0 ? m - 1 : 0][e >> 2][e & 3]), 0x121, 0xF, 0xF, true));
                            const float prev = (fr == 0) ? p0 : p1, lerp = cur + (prev - cur) * mu8[e];
                            o[e] = (fr == 0 && m == 0) ? cur : lerp; }
                        if (small) { float* rp = o32 + r * 256 + (cb - 1536); *(f32x4*)rp = (f32x4){o[0], o[1], o[2], o[3]}; *(f32x4*)(rp + 4) = (f32x4){o[4], o[5], o[6], o[7]}; }
                        else { u32x4 w; w.x = cvt_pk_bf16(o[0], o[1]); w.y = cvt_pk_bf16(o[2], o[3]); w.z = cvt_pk_bf16(o[4], o[5]); w.w = cvt_pk_bf16(o[6], o[7]);
                            *(u32x4*)(o16 + r * LDP + PC_RR + cb) = w; if (vf != nullptr && u.pn >= 4) *(u32x4*)(vf + r * 512 + (cb - 1024)) = w; }
                        if (m == 3 && fr == 15) { const size_t g = r >> 6;
                            if (small) { float* sp = sts + g * 256 + (cb - 1536); *(f32x4*)sp = (f32x4){raw[0], raw[1], raw[2], raw[3]}; *(f32x4*)(sp + 4) = (f32x4){raw[4], raw[5], raw[6], raw[7]}; }
                            else { u32x4 w; w.x = cvt_pk_bf16(raw[0], raw[1]); w.y = cvt_pk_bf16(raw[2], raw[3]); w.z = cvt_pk_bf16(raw[4], raw[5]); w.w = cvt_pk_bf16(raw[6], raw[7]); *(u32x4*)(stp + g * 1536 + cb) = w; } } }
            }
        } else if constexpr (MODE == EPI_B2 || MODE == EPI_O || MODE == EPI_U) {
            const int ct = wc * 32 + 8 * fq;
            if (MODE == EPI_B1 && u.pn == 6) {
#pragma unroll
                for (int ai = 0; ai < 2; ++ai)
#pragma unroll
                    for (int m = 0; m < 4; ++m) { float* rowp = o32 + (size_t)(row0 + ai * HALF + m * 16) * 256 + ct;
#pragma unroll
                        for (int bj = 0; bj < 2; ++bj) { *(f32x4*)(rowp + bj * HALF) = acc[ai][bj][m][0]; *(f32x4*)(rowp + bj * HALF + 4) = acc[ai][bj][m][1]; } }
                return;
            }
            const int ld = (MODE == EPI_U) ? 4096 : LDP;
            const int colbase = (MODE == EPI_B2) ? 0 : (MODE == EPI_B1 ? PC_RR : (MODE == EPI_O ? PC_O : 0));
            const int col0 = colbase + u.pn * BM + ct;
            const bool dovf = (MODE == EPI_B1) && vf != nullptr && u.pn >= 4;
#pragma unroll
            for (int ai = 0; ai < 2; ++ai)
#pragma unroll
                for (int m = 0; m < 4; ++m) { const size_t r = (size_t)(row0 + ai * HALF + m * 16); bf16_t* rowp = o16 + r * ld + col0;
#pragma unroll
                    for (int bj = 0; bj < 2; ++bj) { const f32x4 v0 = acc[ai][bj][m][0], v1 = acc[ai][bj][m][1];
                        u32x4 w; w.x = cvt_pk_bf16(v0[0], v0[1]); w.y = cvt_pk_bf16(v0[2], v0[3]); w.z = cvt_pk_bf16(v1[0], v1[1]); w.w = cvt_pk_bf16(v1[2], v1[3]);
                        *(u32x4*)(rowp + bj * HALF) = w;
                        if (MODE == EPI_B1) { if (dovf) *(u32x4*)(vf + r * 512 + (u.pn - 4) * BM + ct + bj * HALF) = w; } } }
        } else if constexpr (MODE == EPI_FFN) {
            const int hc0 = u.pn * HALF + wc * 32 + 8 * fq;
#pragma unroll
            for (int ai = 0; ai < 2; ++ai)
#pragma unroll
                for (int m = 0; m < 4; ++m) { bf16_t* rowp = o16 + (size_t)(row0 + ai * HALF + m * 16) * FH + hc0; float a[8];
#pragma unroll
                    for (int n = 0; n < 2; ++n)
#pragma unroll
                        for (int j = 0; j < 4; ++j) a[n * 4 + j] = siluf_(acc[ai][0][m][n][j]) * acc[ai][1][m][n][j];
                    u32x4 w; w.x = cvt_pk_bf16(a[0], a[1]); w.y = cvt_pk_bf16(a[2], a[3]); w.z = cvt_pk_bf16(a[4], a[5]); w.w = cvt_pk_bf16(a[6], a[7]);
                    *(u32x4*)rowp = w; }
        } else if constexpr (MODE == EPI_DOWN) {
            const int col0 = u.pn * BM + wc * 32 + 4 * fq;
#pragma unroll
            for (int ai = 0; ai < 2; ++ai)
#pragma unroll
                for (int m = 0; m < 4; ++m) { float* rowp = o32 + (size_t)(row0 + ai * HALF + m * 16) * DM + col0;
#pragma unroll
                    for (int bj = 0; bj < 2; ++bj)
#pragma unroll
                        for (int n = 0; n < 2; ++n) *(f32x4*)(rowp + bj * HALF + n * 16) = acc[ai][bj][m][n]; }
        } else {
            const int d0 = u.pn * 64 + wc * 16 + 4 * fq;
#pragma unroll
            for (int ai = 0; ai < 2; ++ai)
#pragma unroll
                for (int m = 0; m < 4; ++m) { const size_t r = (size_t)(row0 + ai * HALF + m * 16); const bf16_t* up = uq + r * 4096 + d0; float s[4] = {0.f, 0.f, 0.f, 0.f};
#pragma unroll
                    for (int bj = 0; bj < 2; ++bj)
#pragma unroll
                        for (int n = 0; n < 2; ++n) { const u32x2 uu = *(const u32x2*)(up + (2 * bj + n) * 1024); const f32x4 g = acc[ai][bj][m][n];
                            s[0] += sigmoidf_(g[0]) * bflo(uu.x); s[1] += sigmoidf_(g[1]) * bfhi(uu.x); s[2] += sigmoidf_(g[2]) * bflo(uu.y); s[3] += sigmoidf_(g[3]) * bfhi(uu.y); }
                    u32x2 w; w.x = cvt_pk_bf16(s[0], s[1]); w.y = cvt_pk_bf16(s[2], s[3]);
                    *(u32x2*)(o16 + r * LDP + PC_MERGED + d0) = w; }
        }
    }
};

template <class EpiT, bool SHIFT>
__device__ __forceinline__ void gemm_phase(LAS unsigned char* lds, const bf16_t* A, int lda, const bf16_t* Bt, int M, int N, int K, const EpiT& E, const bf16_t* zrow, int ordG, int ordC) {
    int tid_ = threadIdx.x; asm volatile("" : "+v"(tid_));
    const int tid = tid_, wid = __builtin_amdgcn_readfirstlane(tid >> 6), lane = tid & 63, wr = wid >> 2, wc = wid & 3, fr = lane & 15, fq = lane >> 4;
    const int nt = K / BK;
    Order S; S.init(M, N, ordG, ordC);
    unsigned voffA[2], voffB[2]; bool z0[2];
#pragma unroll
    for (int i = 0; i < 2; ++i) { int R, C; stage_rc(tid * 16 + i * 8192, R, C); const int Rb = EpiT::PERM ? ((R & ~31) + perm32(R & 31)) : R;
        voffA[i] = (unsigned)(R * lda + C) * 2u; voffB[i] = (unsigned)(Rb * K + C) * 2u; z0[i] = (R == 0); }
    const size_t kstep = (size_t)(BK * 2);
    const size_t hstepA = (size_t)HALF * lda * 2, tstepA = 2 * hstepA, hstepB = (size_t)HALF * K * 2, tstepB = 2 * hstepB;
    const size_t shiftsub = (size_t)lda * 2 + (size_t)K;
    const unsigned ldsw = (unsigned)wid * 1024u;
    const int aoff = lds_byte(wr * 64 + fr, fq * 8), boff = lds_byte(wc * 32 + fr, fq * 8);
#define PG8_SA(b, h) (((b) * 2 + (h)) * HTB)
#define PG8_SB(b, h) ((4 + (b) * 2 + (h)) * HTB)
#define PG8_STAGEB(bufoff, gbase) do { _Pragma("unroll") for (int _i = 0; _i < 2; ++_i) \
        __builtin_amdgcn_global_load_lds((const unsigned*)((const char*)(gbase) + voffB[_i]), (LAS unsigned*)(lds + (bufoff) + ldsw + _i * 8192), 16, 0, 0); } while (0)
#define PG8_STAGEA(bufoff, gbase, zf) do { _Pragma("unroll") for (int _i = 0; _i < 2; ++_i) { const char* _p = (const char*)(gbase) + voffA[_i]; \
        if (SHIFT) { if ((zf) && z0[_i]) _p = (const char*)zrow + lane * 16; } \
        __builtin_amdgcn_global_load_lds((const unsigned*)_p, (LAS unsigned*)(lds + (bufoff) + ldsw + _i * 8192), 16, 0, 0); } } while (0)
#define PG8_LDA(dst, b, h) do { _Pragma("unroll") for (int m = 0; m < 4; ++m) _Pragma("unroll") for (int k = 0; k < 2; ++k) dst[m][k] = *(const LAS bf16x8*)(lds + PG8_SA(b, h) + aoff + m * 2048 + k * 1024); } while (0)
#define PG8_LDB(dst, b, h) do { _Pragma("unroll") for (int n = 0; n < 2; ++n) _Pragma("unroll") for (int k = 0; k < 2; ++k) dst[n][k] = *(const LAS bf16x8*)(lds + PG8_SB(b, h) + boff + n * 2048 + k * 1024); } while (0)
#define PG8_MMA(ai, bj, At, Bt_) do { __builtin_amdgcn_s_setprio(1); _Pragma("unroll") for (int m = 0; m < 4; ++m) _Pragma("unroll") for (int n = 0; n < 2; ++n) _Pragma("unroll") for (int k = 0; k < 2; ++k) \
        acc[ai][bj][m][n] = __builtin_amdgcn_mfma_f32_16x16x32_bf16(Bt_[n][k], At[m][k], acc[ai][bj][m][n], 0, 0, 0); __builtin_amdgcn_s_setprio(0); } while (0)
#define PG8_WAIT_V(n) asm volatile("s_waitcnt vmcnt(" #n ")" ::: "memory")
#define PG8_WAIT_L(n) asm volatile("s_waitcnt lgkmcnt(" #n ")" ::: "memory")
#define PG8_BAR __builtin_amdgcn_s_barrier()
#define PG8_SCHED __builtin_amdgcn_sched_barrier(0)
#define PG8_AOFF(tau) ((size_t)(tau) * kstep - ((SHIFT && (tau) >= nt / 2) ? shiftsub : (size_t)0))
    Unit cur, nxt; int ui = 0;
    if (!S.next(0, cur)) return;
    f32x4 acc[2][2][4][2];
#pragma unroll
    for (int a = 0; a < 2; ++a)
#pragma unroll
        for (int b = 0; b < 2; ++b)
#pragma unroll
            for (int m = 0; m < 4; ++m)
#pragma unroll
                for (int n = 0; n < 2; ++n) acc[a][b][m][n] = (f32x4){0.f, 0.f, 0.f, 0.f};
    bf16x8 At[4][2], B0[2][2], B1[2][2];
    const char* cA = (const char*)(A + E.a_col(cur.pn)) + (size_t)cur.pm * tstepA; const char* cB = (const char*)Bt + (size_t)cur.pn * tstepB;
    PG8_STAGEB(PG8_SB(0, 0), cB); PG8_STAGEA(PG8_SA(0, 0), cA, false); PG8_STAGEB(PG8_SB(0, 1), cB + hstepB); PG8_STAGEA(PG8_SA(0, 1), cA + hstepA, false);
    if (wr == 1) PG8_BAR;
    PG8_WAIT_V(4); PG8_BAR;
    PG8_STAGEB(PG8_SB(1, 0), cB + kstep); PG8_STAGEA(PG8_SA(1, 0), cA + kstep, false); PG8_STAGEB(PG8_SB(1, 1), cB + hstepB + kstep);
    PG8_WAIT_V(6); PG8_BAR;
    for (;;) {
        const bool has_next = S.next(ui + 1, nxt);
        const char* nA = has_next ? (const char*)(A + E.a_col(nxt.pn)) + (size_t)nxt.pm * tstepA : cA; const char* nB = has_next ? (const char*)Bt + (size_t)nxt.pn * tstepB : cB;
        const bool seq0 = SHIFT && ((cur.pm & 15) == 0);
        for (int t = 0; t < nt; t += 2) {
            const bool last = (t == nt - 2);
            const char* a1 = cA + PG8_AOFF(t + 1);
            const char* a2 = last ? nA : cA + PG8_AOFF(t + 2); const char* b2 = last ? nB : cB + (size_t)(t + 2) * kstep;
            const char* a3 = a2 + kstep; const char* b3 = b2 + kstep;
            const bool zf = seq0 && !last && (t + 2 >= nt / 2);
            PG8_LDB(B0, 0, 0); PG8_SCHED; PG8_LDA(At, 0, 0); PG8_STAGEA(PG8_SA(1, 1), a1 + hstepA, false);
            PG8_WAIT_L(8); PG8_BAR; PG8_WAIT_L(0); PG8_MMA(0, 0, At, B0); PG8_BAR; PG8_SCHED;
            PG8_LDB(B1, 0, 1); PG8_STAGEB(PG8_SB(0, 0), b2);
            PG8_BAR; PG8_WAIT_L(0); PG8_MMA(0, 1, At, B1); PG8_BAR;
            PG8_LDA(At, 0, 1); PG8_STAGEA(PG8_SA(0, 0), a2, zf);
            PG8_BAR; PG8_WAIT_L(0); PG8_MMA(1, 0, At, B0); PG8_BAR; PG8_SCHED;
            PG8_STAGEB(PG8_SB(0, 1), b2 + hstepB);
            PG8_WAIT_V(6); PG8_BAR; PG8_MMA(1, 1, At, B1); PG8_BAR;
            PG8_LDB(B0, 1, 0); PG8_SCHED; PG8_LDA(At, 1, 0); PG8_STAGEA(PG8_SA(0, 1), a2 + hstepA, false);
            PG8_WAIT_L(8); PG8_BAR; PG8_WAIT_L(0); PG8_MMA(0, 0, At, B0); PG8_BAR; PG8_SCHED;
            PG8_LDB(B1, 1, 1); PG8_STAGEB(PG8_SB(1, 0), b3);
            PG8_BAR; PG8_WAIT_L(0); PG8_MMA(0, 1, At, B1); PG8_BAR;
            PG8_LDA(At, 1, 1); PG8_STAGEA(PG8_SA(1, 0), a3, zf);
            PG8_BAR; PG8_WAIT_L(0); PG8_MMA(1, 0, At, B0); PG8_BAR; PG8_SCHED;
            PG8_STAGEB(PG8_SB(1, 1), b3 + hstepB);
            PG8_WAIT_V(6); PG8_BAR; PG8_MMA(1, 1, At, B1); PG8_BAR;
        }
        E(acc, cur, wr, wc, fr, fq);
        if (!has_next) break;
#pragma unroll
        for (int a = 0; a < 2; ++a)
#pragma unroll
            for (int b = 0; b < 2; ++b)
#pragma unroll
                for (int m = 0; m < 4; ++m)
#pragma unroll
                    for (int n = 0; n < 2; ++n) acc[a][b][m][n] = (f32x4){0.f, 0.f, 0.f, 0.f};
        cur = nxt; cA = nA; cB = nB; ++ui;
    }
    PG8_WAIT_V(0);
    if (wr == 0) PG8_BAR;
    PG8_BAR;
#undef PG8_SA
#undef PG8_SB
#undef PG8_STAGEA
#undef PG8_STAGEB
#undef PG8_LDA
#undef PG8_LDB
#undef PG8_MMA
#undef PG8_WAIT_V
#undef PG8_WAIT_L
#undef PG8_BAR
#undef PG8_SCHED
#undef PG8_AOFF
}

__device__ __forceinline__ float wval(const Params& p, int zo, int L, int spec, int n, int k) {
    const float* win = p.in[zo + I_WIN] + (size_t)L * DM * NIN;
    if (spec == 0) {
        if (n < 1536) return win[(size_t)k * NIN + 3864 + n];
        const int s = n - 1536;
        if (s < 8) return win[(size_t)k * NIN + 1280 + s];
        if (s < 24) return win[(size_t)k * NIN + 2824 + (s - 8)];
        if (s < 56) return (L == 0) ? 0.f : p.in[zo + I_WVRES][((size_t)(L - 1) * DM + k) * 32 + (s - 24)];
        if (s < 64) return 0.f;
        if (s < 224) return win[(size_t)k * NIN + 5400 + (s - 64)];
        return 0.f;
    } else if (spec == 1) {
        const int col = n < 1280 ? n : (n < 2816 ? n + 8 : n + 24); return win[(size_t)k * NIN + col];
    } else if (spec == 2) {
        const int pn = n >> 8, ct = n & 255, bj = ct >> 7, wc = (ct >> 5) & 3, nn = (ct >> 4) & 1, r16 = ct & 15;
        return win[(size_t)k * NIN + 5560 + (2 * bj + nn) * 1024 + pn * 64 + wc * 16 + r16];
    } else if (spec == 3) {
        const int kb = n >> 10, d = n & 1023; return p.in[zo + I_WBR][(((size_t)L * 4 + kb) * 512 + k) * 1024 + d];
    } else if (spec == 4) {
        return p.in[zo + I_WOUT][((size_t)L * 1024 + k) * 1024 + n];
    } else if (spec == 5) {
        const int pn = n >> 8, ct = n & 255;
        return ct < 128 ? p.in[zo + I_FG][((size_t)L * 1024 + k) * FH + pn * 128 + ct] : p.in[zo + I_FU][((size_t)L * 1024 + k) * FH + pn * 128 + ct - 128];
    } else {
        return p.in[zo + I_FD][((size_t)L * FH + k) * 1024 + n];
    }
}
__device__ void convert_weights(const Params& p, int L, LAS float* lf, int tile0, int tile1, int ordG, int ordC) {
    int zo = 0; asm volatile("" : "+s"(zo));
    int tid_ = threadIdx.x; asm volatile("" : "+v"(tid_));
    const int tid = tid_;
    for (int tile = tile0 + ordC; tile < tile1; tile += ordG) {
        int spec, tl = tile, ktiles; size_t dofs; int K;
        if (tl < 448) { spec = 0; ktiles = 16; dofs = WB_R; K = 1024; }
        else if ((tl -= 448) < 960) { spec = 1; ktiles = 16; dofs = WB_2; K = 1024; }
        else if ((tl -= 960) < 1024) { spec = 2; ktiles = 16; dofs = WB_G; K = 1024; }
        else if ((tl -= 1024) < 512) { spec = 3; ktiles = 8; dofs = WB_B; K = 512; }
        else if ((tl -= 512) < 256) { spec = 4; ktiles = 16; dofs = WB_O; K = 1024; }
        else if ((tl -= 256) < 1408) { spec = 5; ktiles = 16; dofs = WB_F; K = 1024; }
        else { tl -= 1408; spec = 6; ktiles = 44; dofs = WB_D; K = FH; }
        const int n0 = (tl / ktiles) * 64, k0 = (tl % ktiles) * 64;
        bf16_t* dst = (bf16_t*)(p.ws + dofs);
#pragma unroll
        for (int i = 0; i < 8; ++i) { const int idx = tid + i * 512, kk = idx >> 6, nn = idx & 63; lf[kk * 65 + nn] = wval(p, zo, L, spec, n0 + nn, k0 + kk); }
        __syncthreads();
#pragma unroll
        for (int i = 0; i < 4; ++i) { const int idx = tid + i * 512, nn = idx >> 5, k2 = (idx & 31) * 2;
            *(unsigned*)(dst + (size_t)(n0 + nn) * K + k0 + k2) = cvt_pk_bf16(lf[k2 * 65 + nn], lf[(k2 + 1) * 65 + nn]); }
        __syncthreads();
    }
}

template <int DT>
__device__ void resnorm(const float* xin, const void* delta, int ldd, const float* gd, float* xout, const float* gn, bf16_t* H) {
    int tid_ = threadIdx.x; asm volatile("" : "+v"(tid_));
    const int wid = tid_ >> 6, lane = tid_ & 63;
    const int stride = gridDim.x * 8;
    int row = blockIdx.x * 8 + wid;
    f32x4 gdv[4], gnv[4];
#pragma unroll
    for (int j = 0; j < 4; ++j) { gdv[j] = (DT != 0) ? *(const f32x4*)(gd + (j * 64 + lane) * 4) : (f32x4){0.f, 0.f, 0.f, 0.f}; gnv[j] = gn ? *(const f32x4*)(gn + (j * 64 + lane) * 4) : (f32x4){0.f, 0.f, 0.f, 0.f}; }
    f32x4 nx[4], nd[4]; u32x2 nb[4];
#define RN_LOAD(r_) do { _Pragma("unroll") for (int j = 0; j < 4; ++j) { nx[j] = *(const f32x4*)(xin + (size_t)(r_) * DM + (j * 64 + lane) * 4); \
        if (DT == 1) nb[j] = *(const u32x2*)((const bf16_t*)delta + (size_t)(r_) * ldd + (j * 64 + lane) * 4); \
        if (DT == 2) nd[j] = *(const f32x4*)((const float*)delta + (size_t)(r_) * ldd + (j * 64 + lane) * 4); } } while (0)
    if (row < T) RN_LOAD(row);
    while (row < T) {
        f32x4 xv[4], dv[4];
#pragma unroll
        for (int j = 0; j < 4; ++j) { xv[j] = nx[j]; if (DT == 1) dv[j] = (f32x4){bflo(nb[j].x), bfhi(nb[j].x), bflo(nb[j].y), bfhi(nb[j].y)}; if (DT == 2) dv[j] = nd[j]; }
        const int nrow = row + stride;
        if (nrow < T) RN_LOAD(nrow);
        if (DT != 0) {
            float ss = 0.f;
#pragma unroll
            for (int j = 0; j < 4; ++j) ss += dv[j][0] * dv[j][0] + dv[j][1] * dv[j][1] + dv[j][2] * dv[j][2] + dv[j][3] * dv[j][3];
            ss = red64(ss); const float rstd = rsqrtf(ss * (1.0f / DM) + 1e-6f);
#pragma unroll
            for (int j = 0; j < 4; ++j) xv[j] += dv[j] * rstd * gdv[j];
        }
        if (xout) {
#pragma unroll
            for (int j = 0; j < 4; ++j) *(f32x4*)(xout + (size_t)row * DM + (j * 64 + lane) * 4) = xv[j];
        }
        if (gn) {
            float ss = 0.f;
#pragma unroll
            for (int j = 0; j < 4; ++j) ss += xv[j][0] * xv[j][0] + xv[j][1] * xv[j][1] + xv[j][2] * xv[j][2] + xv[j][3] * xv[j][3];
            ss = red64(ss); const float rstd = rsqrtf(ss * (1.0f / DM) + 1e-6f);
#pragma unroll
            for (int j = 0; j < 4; ++j) { const f32x4 h = xv[j] * rstd * gnv[j];
                u32x2 w; w.x = cvt_pk_bf16(h[0], h[1]); w.y = cvt_pk_bf16(h[2], h[3]); *(u32x2*)(H + (size_t)row * DM + (j * 64 + lane) * 4) = w; }
        }
        row = nrow;
    }
#undef RN_LOAD
}

constexpr int TC = 32;
typedef float f32x2 __attribute__((ext_vector_type(2)));
template <int NE, bool RW> struct StepOps { f32x4 w[NE / 4], k[NE / 4], r[NE / 4], a[RW ? NE / 4 : 1], b[RW ? NE / 4 : 1]; float v; };
template <int NE, bool RW>
__device__ __forceinline__ void step_load(StepOps<NE, RW>& o, const LAS float* base, const LAS float* opV, int vo) {
#pragma unroll
    for (int e = 0; e < NE / 4; ++e) { o.w[e] = *(const LAS f32x4*)(base + 4 * e); o.k[e] = *(const LAS f32x4*)(base + 2048 + 4 * e); o.r[e] = *(const LAS f32x4*)(base + 4096 + 4 * e);
        if (RW) { o.a[e] = *(const LAS f32x4*)(base + 6144 + 4 * e); o.b[e] = *(const LAS f32x4*)(base + 8192 + 4 * e); } }
    o.v = opV[vo];
}
#define LO2(q) ((f32x2){(q)[0], (q)[1]})
#define HI2(q) ((f32x2){(q)[2], (q)[3]})
template <int LPR, bool RW>
__device__ __forceinline__ float step_compute(f32x2 (&s)[32 / LPR], const StepOps<64 / LPR, RW>& o) {
    constexpr int NE = 64 / LPR;
    f32x2 tk[NE / 2];
    const f32x2 v2 = (f32x2){o.v, o.v};
#pragma unroll
    for (int e = 0; e < NE / 4; ++e) { tk[2 * e] = LO2(o.k[e]) * v2; tk[2 * e + 1] = HI2(o.k[e]) * v2; }
    if (RW) {
        f32x2 sa2 = (f32x2){0.f, 0.f}, sb2 = (f32x2){0.f, 0.f};
#pragma unroll
        for (int e = 0; e < NE / 4; ++e) { sa2 += s[2 * e] * LO2(o.a[e]); sb2 += s[2 * e + 1] * HI2(o.a[e]); }
        sa2 += sb2; float sa = sa2[0] + sa2[1]; sa = (LPR == 8) ? red8(sa) : red4(sa);
        const f32x2 sv = (f32x2){sa, sa};
#pragma unroll
        for (int e = 0; e < NE / 4; ++e) { tk[2 * e] += LO2(o.b[e]) * sv; tk[2 * e + 1] += HI2(o.b[e]) * sv; }
    }
    f32x2 y2 = (f32x2){0.f, 0.f}, z2 = (f32x2){0.f, 0.f};
#pragma unroll
    for (int e = 0; e < NE / 4; ++e) { s[2 * e] = s[2 * e] * LO2(o.w[e]) + tk[2 * e]; s[2 * e + 1] = s[2 * e + 1] * HI2(o.w[e]) + tk[2 * e + 1];
        y2 += s[2 * e] * LO2(o.r[e]); z2 += s[2 * e + 1] * HI2(o.r[e]); }
    y2 += z2; float y = y2[0] + y2[1]; y = (LPR == 8) ? red8(y) : red4(y);
    return y;
}
template <int LPR, bool RW>
__device__ __forceinline__ void scan_chunk(f32x2 (&s)[32 / LPR], const LAS float* opW, const LAS float* opK, const LAS float* opR, const LAS float* opA, const LAS float* opB,
                                           const LAS float* opV, LAS float* Y, int vstride, int row, int sub) {
    constexpr int NE = 64 / LPR;
    StepOps<NE, RW> o0, o1;
    unsigned bt = (unsigned)(size_t)(opW + sub * NE), bv = (unsigned)(size_t)(opV + row);
    step_load<NE, RW>(o0, (const LAS float*)(size_t)bt, (const LAS float*)(size_t)bv, 0);
#pragma unroll 1
    for (int t = 0; t < TC; t += 2) {
        asm volatile("" : "+v"(bt), "+v"(bv));
        const LAS float* b0 = (const LAS float*)(size_t)bt; const LAS float* v0 = (const LAS float*)(size_t)bv;
        step_load<NE, RW>(o1, b0 + 64, v0, vstride);
        const float y0 = step_compute<LPR, RW>(s, o0);
        step_load<NE, RW>(o0, b0 + 128, v0, 2 * vstride);
        const float y1 = step_compute<LPR, RW>(s, o1);
        if (sub == 0) { Y[t * vstride + row] = y0; Y[(t + 1) * vstride + row] = y1; }
        bt += 512; bv += 8 * vstride;
    }
}

__device__ void rwkv_item_old(const Params& p, int L, int item, LAS unsigned char* lds, bool dry) {
    int zo = 0; asm volatile("" : "+s"(zo));
    int tid_ = threadIdx.x; asm volatile("" : "+v"(tid_));
    const int b = item >> 3, h = item & 7, tid = tid_, wv = tid >> 6, lane = tid & 63, c = lane, hc = h * 64 + c;
    LAS bf16_t* WT = (LAS bf16_t*)lds;
    LAS bf16_t* LOSB = WT + 64 * 200;
    LAS float* AW = (LAS float*)(lds + 38400); LAS float* AA = AW + 2048; LAS float* AV = AA + 2048; LAS float* G = AV + 2048;
    LAS float* opW = G + 2048; LAS float* opK = opW + 2048; LAS float* opR = opK + 2048; LAS float* opA = opR + 2048; LAS float* opB = opA + 2048;
    LAS float* opV = opB + 2048; LAS float* Y = opV + 2048; LAS float* BON = Y + 2048;
    bf16_t* P = (bf16_t*)(p.ws + OFF_P); const float* SM = (const float*)(p.ws + OFF_SM); const bf16_t* VF = (const bf16_t*)(p.ws + OFF_VF);
    __syncthreads();
    for (int i = tid; i < 192 * 64; i += 512) { const int j = i >> 6, cc = i & 63; float v;
        if (j < 32) v = p.in[zo + I_RWW2][((size_t)L * 32 + j) * 512 + h * 64 + cc];
        else if (j < 64) v = p.in[zo + I_RAW2][((size_t)L * 32 + (j - 32)) * 512 + h * 64 + cc];
        else if (j < 96) v = (L > 0) ? p.in[zo + I_RVW2][((size_t)(L - 1) * 32 + (j - 64)) * 512 + h * 64 + cc] : 0.f;
        else v = p.in[zo + I_RGW2][((size_t)L * 96 + (j - 96)) * 512 + h * 64 + cc];
        WT[cc * 200 + j] = f2bf(v); }
    const float w0 = p.in[zo + I_RW0][L * 512 + hc], a0 = p.in[zo + I_RA0][L * 512 + hc], v0 = (L > 0) ? p.in[zo + I_RV0][(L - 1) * 512 + hc] : 0.f;
    const float k_k = p.in[zo + I_RKK][L * 512 + hc], k_a = p.in[zo + I_RKA][L * 512 + hc], r_k = p.in[zo + I_RRK][L * 512 + hc], ln_g = p.in[zo + I_RLNG][L * 512 + hc], ln_b = p.in[zo + I_RLNB][L * 512 + hc];
    f32x2 s[4];
#pragma unroll
    for (int e = 0; e < 4; ++e) s[e] = (f32x2){0.f, 0.f};
    const int row = wv * 8 + (lane >> 3), sub = lane & 7;
    int smo[12];
#pragma unroll
    for (int i = 0; i < 12; ++i) { const int idx = tid + i * 512, t = idx / 192, j = idx % 192; smo[i] = t * 256 + (j < 64 ? 64 + j : (j < 96 ? j - 40 : j + 32)); }
    float nsm[12]; bf16_t nr[4], nk[4], nv[4], nf[4];
#define RWKV_LOAD(chn) do { const size_t Rn = (size_t)b * SEQ + (size_t)(chn) * TC; \
        _Pragma("unroll") for (int i = 0; i < 12; ++i) nsm[i] = SM[Rn * 256 + smo[i]]; \
        _Pragma("unroll") for (int i = 0; i < 4; ++i) { const size_t R = Rn + wv * 4 + i; nr[i] = P[R * LDP + PC_RR + hc]; nk[i] = P[R * LDP + PC_RK + hc]; nv[i] = P[R * LDP + PC_RV + hc]; nf[i] = (L > 0) ? VF[R * 512 + hc] : (bf16_t)0; } } while (0)
    RWKV_LOAD(0);
    for (int ch = 0; ch < SEQ / TC; ++ch) {
        const size_t R0 = (size_t)b * SEQ + (size_t)ch * TC;
        float csm[12]; bf16_t cr[4], ck[4], cv[4], cf[4];
#pragma unroll
        for (int i = 0; i < 12; ++i) csm[i] = nsm[i];
#pragma unroll
        for (int i = 0; i < 4; ++i) { cr[i] = nr[i]; ck[i] = nk[i]; cv[i] = nv[i]; cf[i] = nf[i]; }
        if (ch + 1 < SEQ / TC) RWKV_LOAD(ch + 1);
#pragma unroll
        for (int i = 0; i < 12; ++i) { const int idx = tid + i * 512, t = idx / 192, j = idx % 192;
            const float v = csm[i], e = __expf(j < 32 ? 2.0f * v : -v), rr = __builtin_amdgcn_rcpf(1.0f + e);
            LOSB[t * 200 + j] = f2bf(j < 32 ? 1.0f - 2.0f * rr : (j >= 96 ? rr : v)); }
        __syncthreads();
        { const int mt = wv & 1, nt = wv >> 1; const int ao = (mt * 16 + (lane & 15)) * 200 + 8 * (lane >> 4), bo = (nt * 16 + (lane & 15)) * 200 + 8 * (lane >> 4);
            bf16x8 af[6], bfr[6];
#pragma unroll
            for (int ks = 0; ks < 6; ++ks) { af[ks] = *(const LAS bf16x8*)(LOSB + ao + ks * 32); bfr[ks] = *(const LAS bf16x8*)(WT + bo + ks * 32); }
            const f32x4 z4 = (f32x4){0.f, 0.f, 0.f, 0.f};
            const f32x4 cw = __builtin_amdgcn_mfma_f32_16x16x32_bf16(af[0], bfr[0], z4, 0, 0, 0);
            const f32x4 ca = __builtin_amdgcn_mfma_f32_16x16x32_bf16(af[1], bfr[1], z4, 0, 0, 0);
            const f32x4 cvv = __builtin_amdgcn_mfma_f32_16x16x32_bf16(af[2], bfr[2], z4, 0, 0, 0);
            f32x4 cg = __builtin_amdgcn_mfma_f32_16x16x32_bf16(af[3], bfr[3], z4, 0, 0, 0);
            cg = __builtin_amdgcn_mfma_f32_16x16x32_bf16(af[4], bfr[4], cg, 0, 0, 0);
            cg = __builtin_amdgcn_mfma_f32_16x16x32_bf16(af[5], bfr[5], cg, 0, 0, 0);
#pragma unroll
            for (int rg = 0; rg < 4; ++rg) { const int o = (mt * 16 + (lane >> 4) * 4 + rg) * 64 + nt * 16 + (lane & 15); AW[o] = cw[rg]; AA[o] = ca[rg]; AV[o] = cvv[rg]; G[o] = cg[rg]; } }
        __syncthreads();
        { float kkr[4], km[4], av_[4], vv[4], rr_[4], red[8];
#pragma unroll
            for (int i = 0; i < 4; ++i) { const int t = wv * 4 + i;
                av_[i] = sigmoidf_(a0 + AA[t * 64 + c]);
                const float k_ = bf2f(ck[i]); rr_[i] = bf2f(cr[i]); vv[i] = bf2f(cv[i]);
                if (L > 0) { const float vf = bf2f(cf[i]); vv[i] = vv[i] + (vf - vv[i]) * sigmoidf_(v0 + AV[t * 64 + c]); }
                kkr[i] = k_ * k_k; km[i] = k_ * (1.0f + (av_[i] - 1.0f) * k_a);
                red[i] = kkr[i] * kkr[i]; red[4 + i] = rr_[i] * km[i] * r_k; }
            red64n<8>(red);
#pragma unroll
            for (int i = 0; i < 4; ++i) { const int t = wv * 4 + i;
                const float wdec = __expf(-0.60653066f * sigmoidf_(w0 + AW[t * 64 + c]));
                const float kk = kkr[i] * rsqrtf(fmaxf(red[i], 1e-24f));
                opW[t * 64 + c] = wdec; opK[t * 64 + c] = km[i]; opR[t * 64 + c] = rr_[i]; opA[t * 64 + c] = -kk; opB[t * 64 + c] = kk * av_[i]; opV[t * 64 + c] = vv[i];
                if (lane == 0) BON[t] = red[4 + i]; } }
        __syncthreads();
        if (!(dry && DRY_SKIP_SCAN)) scan_chunk<8, true>(s, opW, opK, opR, opA, opB, opV, Y, 64, row, sub);
        __syncthreads();
        { float y[4], m[4], q[4];
#pragma unroll
            for (int i = 0; i < 4; ++i) { y[i] = Y[(wv * 4 + i) * 64 + c]; m[i] = y[i]; }
            red64n<4>(m);
#pragma unroll
            for (int i = 0; i < 4; ++i) { y[i] -= m[i] * (1.0f / 64.0f); q[i] = y[i] * y[i]; }
            red64n<4>(q);
#pragma unroll
            for (int i = 0; i < 4; ++i) { const int t = wv * 4 + i; const size_t R = R0 + t;
                float yn = y[i] * rsqrtf(q[i] * (1.0f / 64.0f) + 64e-5f) * ln_g + ln_b; yn += BON[t] * opV[t * 64 + c];
                if (!dry) P[R * LDP + PC_RR + hc] = f2bf(yn * G[t * 64 + c]); } }
    }
#undef RWKV_LOAD
}


__device__ void gla_item(const Params& p, int L, int item, LAS float* lf, bool dry) {
    int zo = 0; asm volatile("" : "+s"(zo));
    int tid_ = threadIdx.x; asm volatile("" : "+v"(tid_));
    const int tid = tid_, wv = tid >> 6, lane = tid & 63, c = lane;
    LAS float* opW = lf; LAS float* opK = opW + 2048; LAS float* opR = opK + 2048; LAS float* opV = opR + 2048; LAS float* Y = opV + 2048; LAS float* X0 = Y + 2048; LAS float* X1 = X0 + 512;
    bf16_t* P = (bf16_t*)(p.ws + OFF_P); const float* SM = (const float*)(p.ws + OFF_SM);
    const int half = item & 1, bh = item >> 1, b = bh >> 2, h = bh & 3, vcol = PC_GV + h * 128 + half * 64;
    __syncthreads();
    for (int i = tid; i < 16 * 64; i += 512) X1[i] = p.in[zo + I_GAW][((size_t)L * 16 + (i >> 6)) * 256 + h * 64 + (i & 63)];
    const float ab = p.in[zo + I_GAB][L * 256 + h * 64 + c];
    f32x2 s[4];
#pragma unroll
    for (int e = 0; e < 4; ++e) s[e] = (f32x2){0.f, 0.f};
    const int row = wv * 8 + (lane >> 3), sub = lane & 7;
    float nlo; bf16_t nvv[4], nk[4], nq[4];
#define GLA_LOAD(chn) do { const size_t Rn = (size_t)b * SEQ + (size_t)(chn) * TC; nlo = SM[(Rn + (tid >> 4)) * 256 + 8 + (tid & 15)]; \
        _Pragma("unroll") for (int i = 0; i < 4; ++i) { const int idx = tid + i * 512; nvv[i] = P[(Rn + (idx >> 6)) * LDP + vcol + (idx & 63)]; } \
        _Pragma("unroll") for (int i = 0; i < 4; ++i) { const size_t R = Rn + wv * 4 + i; nk[i] = P[R * LDP + PC_GK + h * 64 + c]; nq[i] = P[R * LDP + PC_GQ + h * 64 + c]; } } while (0)
    GLA_LOAD(0);
    for (int ch = 0; ch < SEQ / TC; ++ch) {
        const size_t R0 = (size_t)b * SEQ + (size_t)ch * TC;
        X0[tid] = nlo;
#pragma unroll
        for (int i = 0; i < 4; ++i) opV[tid + i * 512] = bf2f(nvv[i]);
        bf16_t ck[4], cq[4];
#pragma unroll
        for (int i = 0; i < 4; ++i) { ck[i] = nk[i]; cq[i] = nq[i]; }
        if (ch + 1 < SEQ / TC) GLA_LOAD(ch + 1);
        __syncthreads();
#pragma unroll
        for (int i = 0; i < 4; ++i) { const int t = wv * 4 + i; float la = ab;
#pragma unroll
            for (int j = 0; j < 16; ++j) la += X0[t * 16 + j] * X1[j * 64 + c];
            opW[t * 64 + c] = __expf(__logf(sigmoidf_(la)) * (1.0f / 16.0f));
            opK[t * 64 + c] = bf2f(ck[i]); opR[t * 64 + c] = bf2f(cq[i]) * 0.125f; }
        __syncthreads();
        scan_chunk<8, false>(s, opW, opK, opR, opW, opW, opV, Y, 64, row, sub);
        __syncthreads();
        if (!dry) {
#pragma unroll
            for (int i = 0; i < 4; ++i) { const int t = wv * 4 + i; P[(R0 + t) * LDP + vcol + c] = f2bf(Y[t * 64 + c]); }
        }
    }
#undef GLA_LOAD
}

template <int MODE>
__device__ void plain_item(const Params& p, int L, int item, LAS float* lf, bool dry) {
    int zo = 0; asm volatile("" : "+s"(zo));
    int tid_ = threadIdx.x; asm volatile("" : "+v"(tid_));
    const int tid = tid_, wv = tid >> 6, lane = tid & 63, c = lane;
    constexpr int VS = (MODE == 0) ? 128 : 64;
    LAS float* opW = lf; LAS float* opK = opW + 2048; LAS float* opR = opK + 2048; LAS float* opV = opR + 2048; LAS float* Y = opV + TC * VS; LAS float* X0 = Y + TC * VS; LAS float* X1 = X0 + 2048;
    bf16_t* P = (bf16_t*)(p.ws + OFF_P); const float* SM = (const float*)(p.ws + OFF_SM);
    __syncthreads();
    if (MODE == 0) {
        const int b = item >> 2, h = item & 3;
        for (int i = tid; i < 16 * 64; i += 512) X1[i] = p.in[zo + I_GAW][((size_t)L * 16 + (i >> 6)) * 256 + h * 64 + (i & 63)];
        const float ab = p.in[zo + I_GAB][L * 256 + h * 64 + c], gn0 = p.in[zo + I_GNG][L * 128 + lane], gn1 = p.in[zo + I_GNG][L * 128 + 64 + lane];
        f32x2 s[8];
#pragma unroll
        for (int e = 0; e < 8; ++e) s[e] = (f32x2){0.f, 0.f};
        const int row = wv * 16 + (lane >> 2), sub = lane & 3;
        float nlo; bf16_t nvv[8], nk[4], nq[4], ng0[4], ng1[4];
#define GLA_LOAD(chn) do { const size_t Rn = (size_t)b * SEQ + (size_t)(chn) * TC; nlo = SM[(Rn + (tid >> 4)) * 256 + 8 + (tid & 15)]; \
        _Pragma("unroll") for (int i = 0; i < 8; ++i) { const int idx = tid + i * 512; nvv[i] = P[(Rn + (idx >> 7)) * LDP + PC_GV + h * 128 + (idx & 127)]; } \
        _Pragma("unroll") for (int i = 0; i < 4; ++i) { const size_t R = Rn + wv * 4 + i; nk[i] = P[R * LDP + PC_GK + h * 64 + c]; nq[i] = P[R * LDP + PC_GQ + h * 64 + c]; \
            ng0[i] = P[R * LDP + PC_GR + h * 128 + lane]; ng1[i] = P[R * LDP + PC_GR + h * 128 + 64 + lane]; } } while (0)
        GLA_LOAD(0);
        for (int ch = 0; ch < SEQ / TC; ++ch) {
            const size_t R0 = (size_t)b * SEQ + (size_t)ch * TC;
            X0[tid] = nlo;
#pragma unroll
            for (int i = 0; i < 8; ++i) opV[tid + i * 512] = bf2f(nvv[i]);
            bf16_t ck[4], cq[4], cg0[4], cg1[4];
#pragma unroll
            for (int i = 0; i < 4; ++i) { ck[i] = nk[i]; cq[i] = nq[i]; cg0[i] = ng0[i]; cg1[i] = ng1[i]; }
            if (ch + 1 < SEQ / TC) GLA_LOAD(ch + 1);
            __syncthreads();
#pragma unroll
            for (int i = 0; i < 4; ++i) { const int t = wv * 4 + i; float la = ab;
#pragma unroll
                for (int j = 0; j < 16; ++j) la += X0[t * 16 + j] * X1[j * 64 + c];
                opW[t * 64 + c] = __expf(__logf(sigmoidf_(la)) * (1.0f / 16.0f));
                opK[t * 64 + c] = bf2f(ck[i]); opR[t * 64 + c] = bf2f(cq[i]) * 0.125f; }
            __syncthreads();
            scan_chunk<4, false>(s, opW, opK, opR, opW, opW, opV, Y, 128, row, sub);
            __syncthreads();
#pragma unroll
            for (int i = 0; i < 4; ++i) { const int t = wv * 4 + i; const size_t R = R0 + t;
                const float y0 = Y[t * 128 + lane], y1 = Y[t * 128 + 64 + lane], ss = red64(y0 * y0 + y1 * y1), rstd = rsqrtf(ss * (1.0f / 128.0f) + 1e-6f);
                bf16_t* rp = P + R * LDP + PC_GR + h * 128;
                const float r0 = bf2f(cg0[i]), r1 = bf2f(cg1[i]);
                if (!dry) { rp[lane] = f2bf(y0 * rstd * gn0 * siluf_(r0)); rp[64 + lane] = f2bf(y1 * rstd * gn1 * siluf_(r1)); } }
        }
#undef GLA_LOAD
    } else {
        const int b = item >> 3, hh = item & 7, g = hh >> 2;
        const int chx = hh * 64 + c, chb = 512 + g * 64 + c, chc = 640 + g * 64 + c;
        const float* cw = p.in[zo + I_SCW] + (size_t)L * 4 * 768; const float* cb = p.in[zo + I_SCB] + (size_t)L * 768;
        float cwx[4], cwb[4], cwc[4];
#pragma unroll
        for (int k = 0; k < 4; ++k) { cwx[k] = cw[k * 768 + chx]; cwb[k] = cw[k * 768 + chb]; cwc[k] = cw[k * 768 + chc]; }
        const float cbx = cb[chx], cbb = cb[chb], cbc = cb[chc];
        const float dtb = p.in[zo + I_SDTB][L * 8 + hh], Aneg = -__expf(p.in[zo + I_SALOG][L * 8 + hh]), Dsk = p.in[zo + I_SD][L * 8 + hh];
        f32x2 s[4];
#pragma unroll
        for (int e = 0; e < 4; ++e) s[e] = (f32x2){0.f, 0.f};
        const int row = wv * 8 + (lane >> 3), sub = lane & 7;
        const int t0 = wv * 4;
        bf16_t nx[7], nb[7], nc[7], nz[4]; float ndt[4];
#define SSD_LOAD(chn) do { const int sp0 = (chn) * TC + t0; \
        _Pragma("unroll") for (int q = 0; q < 7; ++q) { const int sp = sp0 - 3 + q; const size_t R = (size_t)b * SEQ + sp; \
            if (sp >= 0) { nx[q] = P[R * LDP + PC_XBC + chx]; nb[q] = P[R * LDP + PC_XBC + chb]; nc[q] = P[R * LDP + PC_XBC + chc]; } else { nx[q] = 0; nb[q] = 0; nc[q] = 0; } } \
        _Pragma("unroll") for (int i = 0; i < 4; ++i) { const size_t R = (size_t)b * SEQ + sp0 + i; nz[i] = P[R * LDP + PC_Z + chx]; ndt[i] = SM[R * 256 + hh]; } } while (0)
        SSD_LOAD(0);
        for (int ch = 0; ch < SEQ / TC; ++ch) {
            const size_t R0 = (size_t)b * SEQ + (size_t)ch * TC;
            float rx[7], rb[7], rc[7], cz[4], cdt[4];
#pragma unroll
            for (int q = 0; q < 7; ++q) { rx[q] = bf2f(nx[q]); rb[q] = bf2f(nb[q]); rc[q] = bf2f(nc[q]); }
#pragma unroll
            for (int i = 0; i < 4; ++i) { cz[i] = bf2f(nz[i]); cdt[i] = ndt[i]; }
            if (ch + 1 < SEQ / TC) SSD_LOAD(ch + 1);
#pragma unroll
            for (int i = 0; i < 4; ++i) { const int t = t0 + i;
                float x = cbx, bm = cbb, cm = cbc;
#pragma unroll
                for (int k = 0; k < 4; ++k) { x += cwx[k] * rx[i + k]; bm += cwb[k] * rb[i + k]; cm += cwc[k] * rc[i + k]; }
                x = siluf_(x); bm = siluf_(bm); cm = siluf_(cm);
                const float dt = softplusf_(cdt[i] + dtb);
                opW[t * 64 + c] = __expf(dt * Aneg); opK[t * 64 + c] = bm; opR[t * 64 + c] = cm; opV[t * 64 + c] = dt * x; X0[t * 64 + c] = x; }
            __syncthreads();
            scan_chunk<8, false>(s, opW, opK, opR, opW, opW, opV, Y, 64, row, sub);
            __syncthreads();
#pragma unroll
            for (int i = 0; i < 4; ++i) { const int t = t0 + i; const size_t R = R0 + t;
                const float y = Y[t * 64 + c] + Dsk * X0[t * 64 + c];
                if (!dry) P[R * LDP + PC_Z + chx] = f2bf(y * siluf_(cz[i])); }
            __syncthreads();
        }
#undef SSD_LOAD
    }
}

__device__ void lru_item(const Params& p, int L, int item, LAS float* lf, bool dry) {
    int zo = 0; asm volatile("" : "+s"(zo));
    int tid_ = threadIdx.x; asm volatile("" : "+v"(tid_));
    const int b = item >> 3, blk = item & 7, tid = tid_, wv = tid >> 6, lane = tid & 63, c = lane, cbi = blk * 64 + c;
    LAS float* wa = lf; LAS float* wx = wa + 4096; LAS float* XB = wx + 4096; LAS float* A_ = XB + 2048; LAS float* U_ = A_ + 2048; LAS float* HS = U_ + 2048;
    bf16_t* P = (bf16_t*)(p.ws + OFF_P);
    __syncthreads();
    for (int i = tid; i < 4096; i += 512) { wa[i] = p.in[zo + I_LWA][((size_t)L * 8 + blk) * 4096 + i]; wx[i] = p.in[zo + I_LWX][((size_t)L * 8 + blk) * 4096 + i]; }
    float cwv[4];
#pragma unroll
    for (int k = 0; k < 4; ++k) cwv[k] = p.in[zo + I_LCW][((size_t)L * 4 + k) * 512 + cbi];
    const float cbv = p.in[zo + I_LCB][L * 512 + cbi], ba = p.in[zo + I_LBA][L * 512 + cbi], bx = p.in[zo + I_LBX][L * 512 + cbi];
    const float spl = softplusf_(-p.in[zo + I_LLAM][L * 512 + cbi]);
    float hstate = 0.f;
    const int t0 = wv * 4;
    bf16_t nx[7], ngt[4];
#define LRU_LOAD(chn) do { const int sp0 = (chn) * TC + t0; \
        _Pragma("unroll") for (int q = 0; q < 7; ++q) { const int sp = sp0 - 3 + q; nx[q] = (sp >= 0) ? P[((size_t)b * SEQ + sp) * LDP + PC_LX + cbi] : (bf16_t)0; } \
        _Pragma("unroll") for (int i = 0; i < 4; ++i) ngt[i] = P[((size_t)b * SEQ + sp0 + i) * LDP + PC_LG + cbi]; } while (0)
    LRU_LOAD(0);
    for (int ch = 0; ch < SEQ / TC; ++ch) {
        const size_t R0 = (size_t)b * SEQ + (size_t)ch * TC;
        float rx[7], cg[4];
#pragma unroll
        for (int q = 0; q < 7; ++q) rx[q] = bf2f(nx[q]);
#pragma unroll
        for (int i = 0; i < 4; ++i) cg[i] = bf2f(ngt[i]);
        if (ch + 1 < SEQ / TC) LRU_LOAD(ch + 1);
        float xb[4];
#pragma unroll
        for (int i = 0; i < 4; ++i) { float x = cbv;
#pragma unroll
            for (int k = 0; k < 4; ++k) x += cwv[k] * rx[i + k];
            xb[i] = x; XB[(t0 + i) * 64 + c] = x; }
        __syncthreads();
        float ar[4] = {ba, ba, ba, ba}, ai[4] = {bx, bx, bx, bx};
#pragma unroll 4
        for (int j4 = 0; j4 < 16; ++j4) {
            float wra[4], wrx[4];
#pragma unroll
            for (int e = 0; e < 4; ++e) { wra[e] = wa[(j4 * 4 + e) * 64 + c]; wrx[e] = wx[(j4 * 4 + e) * 64 + c]; }
#pragma unroll
            for (int i = 0; i < 4; ++i) { const f32x4 x4 = *(const LAS f32x4*)(XB + (t0 + i) * 64 + j4 * 4);
                ar[i] += x4[0] * wra[0] + x4[1] * wra[1] + x4[2] * wra[2] + x4[3] * wra[3]; ai[i] += x4[0] * wrx[0] + x4[1] * wrx[1] + x4[2] * wrx[2] + x4[3] * wrx[3]; }
        }
#pragma unroll
        for (int i = 0; i < 4; ++i) { const float r = sigmoidf_(ar[i]), ig = sigmoidf_(ai[i]), la = -8.0f * r * spl, a = __expf(la);
            const float u = sqrtf(fmaxf(1.0f - a * a, 0.f)) * (ig * xb[i]);
            A_[(t0 + i) * 64 + c] = a; U_[(t0 + i) * 64 + c] = u; }
        __syncthreads();
        if (wv == 0) {
#pragma unroll 8
            for (int t = 0; t < TC; ++t) { hstate = A_[t * 64 + c] * hstate + U_[t * 64 + c]; HS[t * 64 + c] = hstate; }
        }
        __syncthreads();
#pragma unroll
        for (int i = 0; i < 4; ++i) { const size_t R = R0 + t0 + i; const float g = cg[i];
            const float u2 = 1.5957691216f * (g + 0.044715f * g * g * g);
            if (!dry) P[R * LDP + PC_LG + cbi] = f2bf(HS[(t0 + i) * 64 + c] * g * sigmoidf_(u2)); }
    }
#undef LRU_LOAD
}

__device__ void ssd_post(const Params& p, int L, int ordG, int ordC) {
    int zo = 0; asm volatile("" : "+s"(zo));
    int tid_ = threadIdx.x; asm volatile("" : "+v"(tid_));
    const int wid = tid_ >> 6, lane = tid_ & 63;
    bf16_t* P = (bf16_t*)(p.ws + OFF_P);
    const f32x4 g0 = *(const f32x4*)(p.in[zo + I_SNG] + L * 512 + lane * 8), g1 = *(const f32x4*)(p.in[zo + I_SNG] + L * 512 + lane * 8 + 4);
    const f32x4 gg0 = *(const f32x4*)(p.in[zo + I_GNG] + L * 128 + (lane & 15) * 8), gg1 = *(const f32x4*)(p.in[zo + I_GNG] + L * 128 + (lane & 15) * 8 + 4);
    for (int row = ordC * 8 + wid; row < T; row += ordG * 8) {
        u32x4* pp = (u32x4*)(P + (size_t)row * LDP + PC_Z + lane * 8); const u32x4 w = *pp;
        float v[8] = {bflo(w.x), bfhi(w.x), bflo(w.y), bfhi(w.y), bflo(w.z), bfhi(w.z), bflo(w.w), bfhi(w.w)};
        float ss = 0.f;
#pragma unroll
        for (int j = 0; j < 8; ++j) ss += v[j] * v[j];
        ss = red32(ss); const float rstd = rsqrtf(ss * (1.0f / 256.0f) + 1e-6f);
        u32x4 o; o.x = cvt_pk_bf16(v[0] * rstd * g0[0], v[1] * rstd * g0[1]); o.y = cvt_pk_bf16(v[2] * rstd * g0[2], v[3] * rstd * g0[3]);
        o.z = cvt_pk_bf16(v[4] * rstd * g1[0], v[5] * rstd * g1[1]); o.w = cvt_pk_bf16(v[6] * rstd * g1[2], v[7] * rstd * g1[3]);
        *pp = o;
        if (!GLA_SPLIT) continue;
        u32x4* gp = (u32x4*)(P + (size_t)row * LDP + PC_GR + lane * 8); const u32x4 yw = *(const u32x4*)(P + (size_t)row * LDP + PC_GV + lane * 8), rw = *gp;
        float y[8] = {bflo(yw.x), bfhi(yw.x), bflo(yw.y), bfhi(yw.y), bflo(yw.z), bfhi(yw.z), bflo(yw.w), bfhi(yw.w)};
        float rg[8] = {bflo(rw.x), bfhi(rw.x), bflo(rw.y), bfhi(rw.y), bflo(rw.z), bfhi(rw.z), bflo(rw.w), bfhi(rw.w)};
        float s2 = 0.f;
#pragma unroll
        for (int j = 0; j < 8; ++j) s2 += y[j] * y[j];
        s2 = red16(s2); const float rs2 = rsqrtf(s2 * (1.0f / 128.0f) + 1e-6f);
        float og[8];
#pragma unroll
        for (int j = 0; j < 8; ++j) og[j] = y[j] * rs2 * (j < 4 ? gg0[j] : gg1[j - 4]) * siluf_(rg[j]);
        u32x4 o2; o2.x = cvt_pk_bf16(og[0], og[1]); o2.y = cvt_pk_bf16(og[2], og[3]); o2.z = cvt_pk_bf16(og[4], og[5]); o2.w = cvt_pk_bf16(og[6], og[7]);
        *gp = o2;
    }
}


__device__ __forceinline__ void b1_fixup(const Params& p, int L, const bf16_t* stp, const float* sts) {
    int zo = 0; asm volatile("" : "+s"(zo));
    int tid_ = threadIdx.x; asm volatile("" : "+v"(tid_));
    bf16_t* P = (bf16_t*)(p.ws + OFF_P); float* SM = (float*)(p.ws + OFF_SM); bf16_t* VF = (bf16_t*)(p.ws + OFF_VF);
    const float* mu = p.in[zo + I_RMU] + L * 1696;
    for (int idx = blockIdx.x * 512 + tid_; idx < 512 * 1792; idx += gridDim.x * 512) {
        const int g = idx / 1792, c = idx % 1792; const size_t R = (size_t)g * 64; const bool first = (R % SEQ) == 0;
        if (c < 1536) { const float cur = bf2f(P[R * LDP + PC_RR + c]), prev = first ? 0.f : bf2f(stp[(size_t)(g - 1) * 1536 + c]);
            const bf16_t o = f2bf(cur + (prev - cur) * mu[c]); P[R * LDP + PC_RR + c] = o; if (L == 0 && c >= 1024) VF[R * 512 + c - 1024] = o; }
        else { const int sc = c - 1536; const float m = (sc >= 64 && sc < 224) ? mu[1536 + sc - 64] : 0.f;
            const float cur = SM[R * 256 + sc], prev = first ? 0.f : sts[(size_t)(g - 1) * 256 + sc]; SM[R * 256 + sc] = cur + (prev - cur) * m; }
    }
}

#define XB_TMO      128
#define XB_XCNT(j)  (256  + 64 * (j))
#define XB_XSUB(j)  (1280 + 64 * (j))
#define XB_XGEN(j)  (2304 + 64 * (j))
#define XB_TOP      3328
#define XB_TOPGEN   3392
#define XCD_BAR_WORDS 3456
#define XB_SPIN_CAP (1u << 22)
__device__ __forceinline__ unsigned xb_ld(unsigned* p)              { return __hip_atomic_load(p, __ATOMIC_RELAXED, __HIP_MEMORY_SCOPE_AGENT); }
__device__ __forceinline__ unsigned xb_add(unsigned* p, unsigned v) { return __hip_atomic_fetch_add(p, v, __ATOMIC_RELAXED, __HIP_MEMORY_SCOPE_AGENT); }
__device__ __forceinline__ unsigned xb_xcc_id() { return (unsigned)__builtin_amdgcn_s_getreg((3 << 11) | 20) & 0xFu; }
#define XB_SPIN(cond, bar) do { unsigned _sp = 0; while (cond) { __builtin_amdgcn_s_sleep(1); \
    if ((++_sp & 255u) == 0u) { if (xb_ld(&(bar)[XB_TMO])) break; if (_sp > XB_SPIN_CAP) { atomicAdd(&(bar)[XB_TMO], 1u); break; } } } } while (0)
struct XcdBarrier { unsigned* bar; unsigned x; volatile LAS unsigned* st; };
__device__ __forceinline__ XcdBarrier xcd_barrier_post(unsigned* bar, volatile LAS unsigned* st) {
    XcdBarrier b; b.bar = bar; b.x = xb_xcc_id(); b.st = st;
    if (threadIdx.x == 0) (void)xb_add(&bar[XB_XCNT(b.x)], 1u);
    return b;
}
__device__ __forceinline__ void xcd_barrier_complete(unsigned* bar, unsigned x, unsigned& nloc, unsigned& nx) {
    const unsigned G = gridDim.x * gridDim.y * gridDim.z;
    unsigned sum, cnt, mine, sp = 0u;
    for (;;) {
        sum = 0u; cnt = 0u; mine = 0u;
#pragma unroll
        for (unsigned j = 0; j < 16; ++j) { const unsigned c = xb_ld(&bar[XB_XCNT(j)]); sum += c; cnt += (c > 0u) ? 1u : 0u; mine = (j == x) ? c : mine; }
        if (sum == G) break;
        __builtin_amdgcn_s_sleep(1);
        if ((++sp & 255u) == 0u) { if (xb_ld(&bar[XB_TMO])) break; if (sp > XB_SPIN_CAP) { atomicAdd(&bar[XB_TMO], 1u); break; } }
    }
    nloc = mine > 0u ? mine : 1u; nx = cnt > 0u ? cnt : 1u;
}
__device__ __attribute__((noinline)) void xcd_barrier(const XcdBarrier b) {
    asm volatile("s_waitcnt vmcnt(0)" ::: "memory");
    __syncthreads();
    if (threadIdx.x == 0) {
        unsigned* bar = b.bar;
        __builtin_amdgcn_s_waitcnt(0);
        unsigned nloc = b.st[0], nx = b.st[1];
        if (nloc == 0u) { xcd_barrier_complete(bar, b.x, nloc, nx); b.st[0] = nloc; b.st[1] = nx; }
        const unsigned old = xb_add(&bar[XB_XSUB(b.x)], 1u);
        const unsigned gen = old / nloc;
        if (old + 1u == (gen + 1u) * nloc) {
            __builtin_amdgcn_fence(__ATOMIC_RELEASE, "agent");
            asm volatile("s_waitcnt vmcnt(0)" ::: "memory");
            const unsigned og = xb_add(&bar[XB_TOP], 1u);
            const unsigned tg = og / nx;
            if (og + 1u == (tg + 1u) * nx) xb_add(&bar[XB_TOPGEN], 1u);
            else XB_SPIN(xb_ld(&bar[XB_TOPGEN]) == tg, bar);
            __builtin_amdgcn_fence(__ATOMIC_ACQUIRE, "agent");
            xb_add(&bar[XB_XGEN(b.x)], 1u);
            asm volatile("s_waitcnt vmcnt(0)" ::: "memory");
        } else {
            XB_SPIN(xb_ld(&bar[XB_XGEN(b.x)]) == gen, bar);
            __builtin_amdgcn_fence(__ATOMIC_ACQUIRE, "agent");
            asm volatile("s_waitcnt vmcnt(0)" ::: "memory");
        }
    }
    __syncthreads();
}

__device__ __attribute__((noinline)) void sub_barrier(unsigned* word, unsigned n) {
    asm volatile("s_waitcnt vmcnt(0)" ::: "memory");
    __syncthreads();
    if (threadIdx.x == 0) {
        __builtin_amdgcn_fence(__ATOMIC_RELEASE, "agent");
        asm volatile("s_waitcnt vmcnt(0)" ::: "memory");
        (void)xb_add(word, 1u);
        unsigned sp = 0;
        while (xb_ld(word) < n) { __builtin_amdgcn_s_sleep(2); if (++sp > (1u << 24)) break; }
        __builtin_amdgcn_fence(__ATOMIC_ACQUIRE, "agent");
        asm volatile("s_waitcnt vmcnt(0)" ::: "memory");
    }
    __syncthreads();
}

__global__ __launch_bounds__(512) void mega(Params p) {
    extern __shared__ __attribute__((aligned(16))) unsigned char smem[];
    cg::grid_group grid = cg::this_grid();
    LAS unsigned char* lds = (LAS unsigned char*)smem; LAS float* lf = (LAS float*)smem;
    unsigned char* ws = p.ws;
    int zo = 0; asm volatile("" : "+s"(zo));
    bf16_t* H = (bf16_t*)(ws + OFF_H); bf16_t* P = (bf16_t*)(ws + OFF_P); float* SM = (float*)(ws + OFF_SM); bf16_t* VF = (bf16_t*)(ws + OFF_VF);
    const bf16_t* zrow = (const bf16_t*)(ws + OFF_Z);
    volatile LAS unsigned* xst = (volatile LAS unsigned*)(lds + LDS_BYTES - 16);
    if (threadIdx.x == 0) { xst[0] = 0u; xst[1] = 0u; }
    __syncthreads();
    const XcdBarrier xb = xcd_barrier_post((unsigned*)(ws + OFF_BAR), xst);
    float* X = p.out;
    bf16_t* ACT = P; float* FO = (float*)(ws + OFF_P + 176 * MiB);
    const int G = (int)gridDim.x, bid = (int)blockIdx.x;
    unsigned* subw = (unsigned*)(ws + OFF_BAR) + 3584;
    if (blockIdx.x == 0) for (int i = threadIdx.x; i < 1024; i += 512) ((unsigned*)(ws + OFF_Z))[i] = 0u;
    convert_weights(p, 0, lf, 0, 1408, G, bid);
    resnorm<0>(p.in[zo + I_X], nullptr, 0, nullptr, nullptr, p.in[zo + I_NG] + 0, H);
    grid.sync();
    for (int L = 0; L < 2; ++L) {
        asm volatile("" : "+s"(zo));
        const float* ng = p.in[zo + I_NG] + (size_t)L * 4 * DM;
        const float* xin = (L == 0) ? p.in[zo + I_X] : X;
        { Epi<EPI_B1> e{}; e.o16 = P; e.o32 = SM; e.vf = (L == 0) ? VF : nullptr; e.mu = p.in[zo + I_RMU] + L * 1696; e.stp = (bf16_t*)(ws + WB_R + 7 * MiB / 2); e.sts = (float*)(ws + WB_R + 5 * MiB);
          gemm_phase<Epi<EPI_B1>, false>(lds, H, DM, (const bf16_t*)(ws + WB_R), T, 1792, 1024, e, zrow, G, bid); }
        xcd_barrier(xb);
        b1_fixup(p, L, (const bf16_t*)(ws + WB_R + 7 * MiB / 2), (const float*)(ws + WB_R + 5 * MiB));
        xcd_barrier(xb);
        {
            const int NR = 64, NO = G - NR;
            if (bid < NR) {
                for (int item = bid; item < 64; item += NR) rwkv_item_old(p, L, item, lds, false);
            } else {
                const int oc = bid - NR;
                { Epi<EPI_B2> e{}; e.o16 = P; gemm_phase<Epi<EPI_B2>, false>(lds, H, DM, (const bf16_t*)(ws + WB_2), T, 3840, 1024, e, zrow, NO, oc); }
                sub_barrier(subw + (L * 2 + 0) * 64, (unsigned)NO);
                for (int item = oc; item < 192; item += NO) {
                    if (item < 64) gla_item(p, L, item, lf, false);
                    else if (item < 128) plain_item<1>(p, L, item - 64, lf, false);
                    else lru_item(p, L, item - 128, lf, false);
                }
                sub_barrier(subw + (L * 2 + 1) * 64, (unsigned)NO);
                ssd_post(p, L, NO, oc);
                convert_weights(p, L, lf, 1408, 5312, NO, oc);
                if (L == 0) convert_weights(p, 1, lf, 0, 1408, NO, oc);
            }
        }
        xcd_barrier(xb);
        bf16_t* U = (L == 0) ? (bf16_t*)p.out : (bf16_t*)(ws + OFF_SM);
        for (int q = 0; q < 4; ++q) {
            { Epi<EPI_U> e{}; e.o16 = U; gemm_phase<Epi<EPI_U>, false>(lds, P + (size_t)q * 8192 * LDP, LDP, (const bf16_t*)(ws + WB_B), 8192, 4096, 512, e, zrow, G, bid); }
            xcd_barrier(xb);
            { Epi<EPI_MERGE> e{}; e.o16 = P + (size_t)q * 8192 * LDP; e.uq = U; gemm_phase<Epi<EPI_MERGE>, false>(lds, H + (size_t)q * 8192 * DM, DM, (const bf16_t*)(ws + WB_G), 8192, 4096, 1024, e, zrow, G, bid); }
            xcd_barrier(xb);
        }
        { Epi<EPI_O> e{}; e.o16 = P; gemm_phase<Epi<EPI_O>, false>(lds, P + PC_MERGED, LDP, (const bf16_t*)(ws + WB_O), T, 1024, 1024, e, zrow, G, bid); }
        xcd_barrier(xb);
        resnorm<1>(xin, P + PC_O, LDP, ng + DM, X, ng + 2 * DM, H);
        xcd_barrier(xb);
        { Epi<EPI_FFN> e{}; e.o16 = ACT; gemm_phase<Epi<EPI_FFN>, false>(lds, H, DM, (const bf16_t*)(ws + WB_F), T, 5632, 1024, e, zrow, G, bid); }
        xcd_barrier(xb);
        { Epi<EPI_DOWN> e{}; e.o32 = FO; gemm_phase<Epi<EPI_DOWN>, false>(lds, ACT, FH, (const bf16_t*)(ws + WB_D), T, 1024, FH, e, zrow, G, bid); }
        xcd_barrier(xb);
        if (L == 0) {
            resnorm<2>(X, FO, DM, ng + 3 * DM, X, p.in[zo + I_NG] + 4 * DM, H);
            xcd_barrier(xb);
        } else {
            resnorm<2>(X, FO, DM, ng + 3 * DM, X, nullptr, nullptr);
        }
    }
}

extern "C" void kernel_launch(void* const* d_in, const int* in_sizes, int n_in, void* d_out, int out_size, void* d_ws, size_t ws_size, hipStream_t stream) {
    static int grid_blocks = 0;
    if (grid_blocks == 0) {
        if (n_in != N_INPUTS || out_size != T * DM || ws_size < WS_END) { fprintf(stderr, "kernel_launch: unexpected problem (n_in %d, out %d, ws %zu)\n", n_in, out_size, ws_size); grid_blocks = -1; return; }
        int dev = 0, cus = 0, per_cu = 0;
        (void)hipGetDevice(&dev); (void)hipDeviceGetAttribute(&cus, hipDeviceAttributeMultiprocessorCount, dev);
        if (hipFuncSetAttribute((const void*)mega, hipFuncAttributeMaxDynamicSharedMemorySize, LDS_BYTES) != hipSuccess) { fprintf(stderr, "kernel_launch: hipFuncSetAttribute failed\n"); grid_blocks = -1; return; }
        if (hipOccupancyMaxActiveBlocksPerMultiprocessor(&per_cu, (const void*)mega, 512, LDS_BYTES) != hipSuccess || per_cu < 1) { fprintf(stderr, "kernel_launch: occupancy query says %d\n", per_cu); per_cu = 1; }
        (void)hipGetLastError();
        grid_blocks = cus * 1;
        if (grid_blocks < 128) { fprintf(stderr, "kernel_launch: needs at least 128 CUs\n"); grid_blocks = -1; return; }
    }
    if (grid_blocks < 0) return;
    if (hipMemsetAsync((char*)d_ws + OFF_BAR, 0, 4096 * 4, stream) != hipSuccess) { fprintf(stderr, "kernel_launch: memset failed\n"); return; }
    Params p{};
    for (int i = 0; i < N_INPUTS; ++i) p.in[i] = (const float*)d_in[i];
    p.out = (float*)d_out; p.ws = (unsigned char*)d_ws;
    void* args[] = {&p};
    hipError_t e = hipLaunchCooperativeKernel((const void*)mega, dim3(grid_blocks), dim3(512), args, LDS_BYTES, stream);
    if (e != hipSuccess) fprintf(stderr, "cooperative launch failed: %s (grid %d)\n", hipGetErrorString(e), grid_blocks);
}
```

```cpp
#include <hip/hip_runtime.h>
#include <hip/hip_cooperative_groups.h>
#include <cstdio>
namespace cg = cooperative_groups;

#define LAS __attribute__((address_space(3)))
typedef unsigned short bf16_t;
typedef short bf16x8 __attribute__((ext_vector_type(8)));
typedef float f32x4 __attribute__((ext_vector_type(4)));
typedef unsigned u32x4 __attribute__((ext_vector_type(4)));
typedef unsigned u32x2 __attribute__((ext_vector_type(2)));

constexpr int NB = 8, SEQ = 4096, T = NB * SEQ, DM = 1024, NIN = 9656, FH = 2816, LDP = 5376;
constexpr int BM = 256, BK = 64, HALF = 128, HTB = HALF * BK * 2, STAGE_BYTES = 8 * HTB, NXCD = 8, WGM = 8;
constexpr int LDS_BYTES = 144 * 1024;
constexpr bool DRY_SKIP_SCAN = false;
constexpr bool GLA_SPLIT = true;
constexpr int DRY_MASK = 15;
constexpr int REP_GEMM = 1, REP_SCAN = 0, REP_SYNC = 1, REP_CONV = 1, REP_NORM = 1;
constexpr size_t MiB = 1u << 20;
constexpr size_t WB_R = 0, WB_2 = 7 * MiB, WB_G = WB_2 + 15 * MiB / 2, WB_B = WB_G + 8 * MiB, WB_O = WB_B + 4 * MiB, WB_F = WB_O + 2 * MiB, WB_D = WB_F + 11 * MiB;
constexpr size_t OFF_Z = 45 * MiB, OFF_H = 46 * MiB, OFF_P = 110 * MiB, OFF_SM = 446 * MiB, OFF_VF = 478 * MiB, OFF_BAR = 510 * MiB, OFF_BON = 510 * MiB + 65536, WS_END = OFF_BON + MiB;
constexpr int PC_Z = 0, PC_XBC = 512, PC_GQ = 1280, PC_GK = 1536, PC_GV = 1792, PC_GR = 2304, PC_LX = 2816, PC_LG = 3328, PC_RR = 3840, PC_RK = 4352, PC_RV = 4864;
constexpr int PC_MERGED = 1280, PC_O = 4352;

enum { I_X = 0, I_NG, I_WIN, I_WVRES, I_SCW, I_SCB, I_SDTB, I_SALOG, I_SD, I_SNG, I_GAW, I_GAB, I_GNG, I_LCW, I_LCB, I_LWA, I_LBA, I_LWX, I_LBX, I_LLAM,
       I_RMU, I_RW0, I_RWW2, I_RA0, I_RAW2, I_RV0, I_RVW2, I_RGW2, I_RKK, I_RKA, I_RRK, I_RLNG, I_RLNB, I_WBR, I_WOUT, I_FG, I_FU, I_FD, N_INPUTS };

struct Params { const float* in[N_INPUTS]; float* out; unsigned char* ws; };

__device__ __forceinline__ unsigned cvt_pk_bf16(float lo, float hi) { unsigned r; asm volatile("v_cvt_pk_bf16_f32 %0, %1, %2" : "=v"(r) : "v"(lo), "v"(hi)); return r; }
__device__ __forceinline__ float bf2f(bf16_t v) { return __uint_as_float((unsigned)v << 16); }
__device__ __forceinline__ float bflo(unsigned v) { return __uint_as_float(v << 16); }
__device__ __forceinline__ float bfhi(unsigned v) { return __uint_as_float(v & 0xffff0000u); }
__device__ __forceinline__ bf16_t f2bf(float v) { return (bf16_t)(cvt_pk_bf16(v, 0.f) & 0xffffu); }
__device__ __forceinline__ float sigmoidf_(float x) { return __builtin_amdgcn_rcpf(1.0f + __expf(-x)); }
__device__ __forceinline__ float siluf_(float x) { return x * sigmoidf_(x); }
__device__ __forceinline__ float softplusf_(float x) { return fmaxf(x, 0.f) + log1pf(__expf(-fabsf(x))); }
template <int CTRL> __device__ __forceinline__ float dpp_add(float x) { int v = __builtin_amdgcn_update_dpp(0, __float_as_int(x), CTRL, 0xF, 0xF, true); return x + __int_as_float(v); }
__device__ __forceinline__ float red4(float x) { x = dpp_add<0xB1>(x); x = dpp_add<0x4E>(x); return x; }
__device__ __forceinline__ float red8(float x) { x = red4(x); x = dpp_add<0x141>(x); return x; }
__device__ __forceinline__ float red16(float x) { x = red8(x); x = dpp_add<0x140>(x); return x; }
__device__ __forceinline__ float red32(float x) { x = red16(x); x += __shfl_xor(x, 16); return x; }
__device__ __forceinline__ float red64(float x) { x = red32(x); x += __shfl_xor(x, 32); return x; }
template <int N> __device__ __forceinline__ void red64n(float (&v)[N]) {
#pragma unroll
    for (int i = 0; i < N; ++i) v[i] = red16(v[i]);
    float t[N];
#pragma unroll
    for (int i = 0; i < N; ++i) t[i] = __shfl_xor(v[i], 16);
#pragma unroll
    for (int i = 0; i < N; ++i) v[i] += t[i];
#pragma unroll
    for (int i = 0; i < N; ++i) t[i] = __shfl_xor(v[i], 32);
#pragma unroll
    for (int i = 0; i < N; ++i) v[i] += t[i];
}

__device__ __forceinline__ int lds_byte(int r, int c) { const int st = (r >> 4) * 2 + (c >> 5), rr = r & 15, cc = c & 31, ob = rr * 64 + cc * 2; return st * 1024 + (ob ^ (((ob >> 9) & 1) << 5)); }
__device__ __forceinline__ void stage_rc(int b, int& R, int& C) { const int st = b / 1024, sb = b % 1024, swz = sb ^ (((sb >> 9) & 1) << 5); R = (st >> 1) * 16 + swz / 64; C = (st & 1) * 32 + (swz % 64) / 2; }
__device__ __forceinline__ int perm32(int rho) { const int n = rho >> 4, i = rho & 15; return 8 * (i >> 2) + 4 * n + (i & 3); }
struct Unit { int pm, pn; };
struct Order {
    int nM, nN, nwg, G, c;
    __device__ void init(int M, int N, int G_, int c_) { nM = M / BM; nN = N / BM; nwg = nM * nN; G = G_; c = c_; }
    __device__ bool next(int i, Unit& u) const {
        const long L = (long)i * G + c; if (L >= nwg) return false;
        int wgid = (int)L; { const int q = nwg / NXCD, r = nwg % NXCD, xcd = wgid % NXCD, off = wgid / NXCD; wgid = (xcd < r ? xcd * (q + 1) : r * (q + 1) + (xcd - r) * q) + off; }
        const int nig = WGM * nN, gid = wgid / nig, fm = gid * WGM, gsz = (nM - fm) < WGM ? (nM - fm) : WGM;
        u.pm = fm + ((wgid % nig) % gsz); u.pn = (wgid % nig) / gsz; return true;
    }
};

enum { EPI_B2 = 0, EPI_B1, EPI_U, EPI_MERGE, EPI_O, EPI_FFN, EPI_DOWN };
template <int MODE> struct Epi {
    static constexpr bool PERM = (MODE != EPI_MERGE);
    bf16_t* o16; float* o32; const bf16_t* uq; bf16_t* vf; const float* mu; bf16_t* stp; float* sts;
    __device__ __forceinline__ int a_col(int pn) const { if (MODE == EPI_U) { const int k = pn >> 2; return k == 0 ? PC_Z : (k == 1 ? PC_GR : (k == 2 ? PC_LG : PC_RR)); } return 0; }
    __device__ __forceinline__ void operator()(const f32x4 (&acc)[2][2][4][2], const Unit& u, int wr, int wc, int fr, int fq) const {
        const int row0 = u.pm * BM + wr * 64 + fr;
        if constexpr (MODE == EPI_B1) {
            const bool small = (u.pn == 6);
#pragma unroll
            for (int bj = 0; bj < 2; ++bj) {
                const int cb = u.pn * BM + bj * HALF + wc * 32 + 8 * fq;
                float mu8[8];
#pragma unroll
                for (int e = 0; e < 8; ++e) { const int sc = cb + e - 1536; mu8[e] = !small ? mu[cb + e] : ((sc >= 64 && sc < 224) ? mu[1536 + sc - 64] : 0.f); }
#pragma unroll
                for (int ai = 0; ai < 2; ++ai)
#pragma unroll
                    for (int m = 0; m < 4; ++m) { const size_t r = (size_t)(row0 + ai * HALF + m * 16); float o[8], raw[8];
#pragma unroll
                        for (int e = 0; e < 8; ++e) { const float cur = acc[ai][bj][m][e >> 2][e & 3]; raw[e] = cur;
                            const float p1 = __int_as_float(__builtin_amdgcn_update_dpp(0, __float_as_int(cur), 0x111, 0xF, 0xF, true));
                            float p0 = 0.f; if (m > 0) p0 = __int_as_float(__builtin_amdgcn_update_dpp(0, __float_as_int(acc[ai][bj][m > 0 ? m - 1 : 0][e >> 2][e & 3]), 0x121, 0xF, 0xF, true));
                            const float prev = (fr == 0) ? p0 : p1, lerp = cur + (prev - cur) * mu8[e];
                            o[e] = (fr == 0 && m == 0) ? cur : lerp; }
                        if (small) { float* rp = o32 + r * 256 + (cb - 1536); *(f32x4*)rp = (f32x4){o[0], o[1], o[2], o[3]}; *(f32x4*)(rp + 4) = (f32x4){o[4], o[5], o[6], o[7]}; }
                        else { u32x4 w; w.x = cvt_pk_bf16(o[0], o[1]); w.y = cvt_pk_bf16(o[2], o[3]); w.z = cvt_pk_bf16(o[4], o[5]); w.w = cvt_pk_bf16(o[6], o[7]);
                            *(u32x4*)(o16 + r * LDP + PC_RR + cb) = w; if (vf != nullptr && u.pn >= 4) *(u32x4*)(vf + r * 512 + (cb - 1024)) = w; }
                        if (m == 3 && fr == 15) { const size_t g = r >> 6;
                            if (small) { float* sp = sts + g * 256 + (cb - 1536); *(f32x4*)sp = (f32x4){raw[0], raw[1], raw[2], raw[3]}; *(f32x4*)(sp + 4) = (f32x4){raw[4], raw[5], raw[6], raw[7]}; }
                            else { u32x4 w; w.x = cvt_pk_bf16(raw[0], raw[1]); w.y = cvt_pk_bf16(raw[2], raw[3]); w.z = cvt_pk_bf16(raw[4], raw[5]); w.w = cvt_pk_bf16(raw[6], raw[7]); *(u32x4*)(stp + g * 1536 + cb) = w; } } }
            }
        } else if constexpr (MODE == EPI_B2 || MODE == EPI_O || MODE == EPI_U || MODE == EPI_DOWN) {
            const int ct = wc * 32 + 8 * fq;
            if (MODE == EPI_B1 && u.pn == 6) {
#pragma unroll
                for (int ai = 0; ai < 2; ++ai)
#pragma unroll
                    for (int m = 0; m < 4; ++m) { float* rowp = o32 + (size_t)(row0 + ai * HALF + m * 16) * 256 + ct;
#pragma unroll
                        for (int bj = 0; bj < 2; ++bj) { *(f32x4*)(rowp + bj * HALF) = acc[ai][bj][m][0]; *(f32x4*)(rowp + bj * HALF + 4) = acc[ai][bj][m][1]; } }
                return;
            }
            const int ld = (MODE == EPI_U) ? 4096 : (MODE == EPI_DOWN ? DM : LDP);
            const int colbase = (MODE == EPI_B2) ? 0 : (MODE == EPI_B1 ? PC_RR : (MODE == EPI_O ? PC_O : 0));
            const int col0 = colbase + u.pn * BM + ct;
            const bool dovf = (MODE == EPI_B1) && vf != nullptr && u.pn >= 4;
#pragma unroll
            for (int ai = 0; ai < 2; ++ai)
#pragma unroll
                for (int m = 0; m < 4; ++m) { const size_t r = (size_t)(row0 + ai * HALF + m * 16); bf16_t* rowp = o16 + r * ld + col0;
#pragma unroll
                    for (int bj = 0; bj < 2; ++bj) { const f32x4 v0 = acc[ai][bj][m][0], v1 = acc[ai][bj][m][1];
                        u32x4 w; w.x = cvt_pk_bf16(v0[0], v0[1]); w.y = cvt_pk_bf16(v0[2], v0[3]); w.z = cvt_pk_bf16(v1[0], v1[1]); w.w = cvt_pk_bf16(v1[2], v1[3]);
                        *(u32x4*)(rowp + bj * HALF) = w;
                        if (MODE == EPI_B1) { if (dovf) *(u32x4*)(vf + r * 512 + (u.pn - 4) * BM + ct + bj * HALF) = w; } } }
        } else if constexpr (MODE == EPI_FFN) {
            const int hc0 = u.pn * HALF + wc * 32 + 8 * fq;
#pragma unroll
            for (int ai = 0; ai < 2; ++ai)
#pragma unroll
                for (int m = 0; m < 4; ++m) { bf16_t* rowp = o16 + (size_t)(row0 + ai * HALF + m * 16) * FH + hc0; float a[8];
#pragma unroll
                    for (int n = 0; n < 2; ++n)
#pragma unroll
                        for (int j = 0; j < 4; ++j) a[n * 4 + j] = siluf_(acc[ai][0][m][n][j]) * acc[ai][1][m][n][j];
                    u32x4 w; w.x = cvt_pk_bf16(a[0], a[1]); w.y = cvt_pk_bf16(a[2], a[3]); w.z = cvt_pk_bf16(a[4], a[5]); w.w = cvt_pk_bf16(a[6], a[7]);
                    *(u32x4*)rowp = w; }
        } else {
            const int d0 = u.pn * 64 + wc * 16 + 4 * fq;
#pragma unroll
            for (int ai = 0; ai < 2; ++ai)
#pragma unroll
                for (int m = 0; m < 4; ++m) { const size_t r = (size_t)(row0 + ai * HALF + m * 16); const bf16_t* up = uq + r * 4096 + d0; float s[4] = {0.f, 0.f, 0.f, 0.f};
#pragma unroll
                    for (int bj = 0; bj < 2; ++bj)
#pragma unroll
                        for (int n = 0; n < 2; ++n) { const u32x2 uu = *(const u32x2*)(up + (2 * bj + n) * 1024); const f32x4 g = acc[ai][bj][m][n];
                            s[0] += sigmoidf_(g[0]) * bflo(uu.x); s[1] += sigmoidf_(g[1]) * bfhi(uu.x); s[2] += sigmoidf_(g[2]) * bflo(uu.y); s[3] += sigmoidf_(g[3]) * bfhi(uu.y); }
                    u32x2 w; w.x = cvt_pk_bf16(s[0], s[1]); w.y = cvt_pk_bf16(s[2], s[3]);
                    *(u32x2*)(o16 + r * LDP + PC_MERGED + d0) = w; }
        }
    }
};

template <class EpiT, bool SHIFT>
__device__ __forceinline__ void gemm_phase(LAS unsigned char* lds, const bf16_t* A, int lda, const bf16_t* Bt, int M, int N, int K, const EpiT& E, const bf16_t* zrow, int ordG, int ordC) {
    int tid_ = threadIdx.x; asm volatile("" : "+v"(tid_));
    const int tid = tid_, wid = __builtin_amdgcn_readfirstlane(tid >> 6), lane = tid & 63, wr = wid >> 2, wc = wid & 3, fr = lane & 15, fq = lane >> 4;
    const int nt = K / BK;
    Order S; S.init(M, N, ordG, ordC);
    unsigned voffA[2], voffB[2]; bool z0[2];
#pragma unroll
    for (int i = 0; i < 2; ++i) { int R, C; stage_rc(tid * 16 + i * 8192, R, C); const int Rb = EpiT::PERM ? ((R & ~31) + perm32(R & 31)) : R;
        voffA[i] = (unsigned)(R * lda + C) * 2u; voffB[i] = (unsigned)(Rb * K + C) * 2u; z0[i] = (R == 0); }
    const size_t kstep = (size_t)(BK * 2);
    const size_t hstepA = (size_t)HALF * lda * 2, tstepA = 2 * hstepA, hstepB = (size_t)HALF * K * 2, tstepB = 2 * hstepB;
    const size_t shiftsub = (size_t)lda * 2 + (size_t)K;
    const unsigned ldsw = (unsigned)wid * 1024u;
    const int aoff = lds_byte(wr * 64 + fr, fq * 8), boff = lds_byte(wc * 32 + fr, fq * 8);
#define PG8_SA(b, h) (((b) * 2 + (h)) * HTB)
#define PG8_SB(b, h) ((4 + (b) * 2 + (h)) * HTB)
#define PG8_STAGEB(bufoff, gbase) do { _Pragma("unroll") for (int _i = 0; _i < 2; ++_i) \
        __builtin_amdgcn_global_load_lds((const unsigned*)((const char*)(gbase) + voffB[_i]), (LAS unsigned*)(lds + (bufoff) + ldsw + _i * 8192), 16, 0, 0); } while (0)
#define PG8_STAGEA(bufoff, gbase, zf) do { _Pragma("unroll") for (int _i = 0; _i < 2; ++_i) { const char* _p = (const char*)(gbase) + voffA[_i]; \
        if (SHIFT) { if ((zf) && z0[_i]) _p = (const char*)zrow + lane * 16; } \
        __builtin_amdgcn_global_load_lds((const unsigned*)_p, (LAS unsigned*)(lds + (bufoff) + ldsw + _i * 8192), 16, 0, 0); } } while (0)
#define PG8_LDA(dst, b, h) do { _Pragma("unroll") for (int m = 0; m < 4; ++m) _Pragma("unroll") for (int k = 0; k < 2; ++k) dst[m][k] = *(const LAS bf16x8*)(lds + PG8_SA(b, h) + aoff + m * 2048 + k * 1024); } while (0)
#define PG8_LDB(dst, b, h) do { _Pragma("unroll") for (int n = 0; n < 2; ++n) _Pragma("unroll") for (int k = 0; k < 2; ++k) dst[n][k] = *(const LAS bf16x8*)(lds + PG8_SB(b, h) + boff + n * 2048 + k * 1024); } while (0)
#define PG8_MMA(ai, bj, At, Bt_) do { __builtin_amdgcn_s_setprio(1); _Pragma("unroll") for (int m = 0; m < 4; ++m) _Pragma("unroll") for (int n = 0; n < 2; ++n) _Pragma("unroll") for (int k = 0; k < 2; ++k) \
        acc[ai][bj][m][n] = __builtin_amdgcn_mfma_f32_16x16x32_bf16(Bt_[n][k], At[m][k], acc[ai][bj][m][n], 0, 0, 0); __builtin_amdgcn_s_setprio(0); } while (0)
#define PG8_WAIT_V(n) asm volatile("s_waitcnt vmcnt(" #n ")" ::: "memory")
#define PG8_WAIT_L(n) asm volatile("s_waitcnt lgkmcnt(" #n ")" ::: "memory")
#define PG8_BAR __builtin_amdgcn_s_barrier()
#define PG8_SCHED __builtin_amdgcn_sched_barrier(0)
#define PG8_AOFF(tau) ((size_t)(tau) * kstep - ((SHIFT && (tau) >= nt / 2) ? shiftsub : (size_t)0))
    Unit cur, nxt; int ui = 0;
    if (!S.next(0, cur)) return;
    f32x4 acc[2][2][4][2];
#pragma unroll
    for (int a = 0; a < 2; ++a)
#pragma unroll
        for (int b = 0; b < 2; ++b)
#pragma unroll
            for (int m = 0; m < 4; ++m)
#pragma unroll
                for (int n = 0; n < 2; ++n) acc[a][b][m][n] = (f32x4){0.f, 0.f, 0.f, 0.f};
    bf16x8 At[4][2], B0[2][2], B1[2][2];
    const char* cA = (const char*)(A + E.a_col(cur.pn)) + (size_t)cur.pm * tstepA; const char* cB = (const char*)Bt + (size_t)cur.pn * tstepB;
    PG8_STAGEB(PG8_SB(0, 0), cB); PG8_STAGEA(PG8_SA(0, 0), cA, false); PG8_STAGEB(PG8_SB(0, 1), cB + hstepB); PG8_STAGEA(PG8_SA(0, 1), cA + hstepA, false);
    if (wr == 1) PG8_BAR;
    PG8_WAIT_V(4); PG8_BAR;
    PG8_STAGEB(PG8_SB(1, 0), cB + kstep); PG8_STAGEA(PG8_SA(1, 0), cA + kstep, false); PG8_STAGEB(PG8_SB(1, 1), cB + hstepB + kstep);
    PG8_WAIT_V(6); PG8_BAR;
    for (;;) {
        const bool has_next = S.next(ui + 1, nxt);
        const char* nA = has_next ? (const char*)(A + E.a_col(nxt.pn)) + (size_t)nxt.pm * tstepA : cA; const char* nB = has_next ? (const char*)Bt + (size_t)nxt.pn * tstepB : cB;
        const bool seq0 = SHIFT && ((cur.pm & 15) == 0);
        for (int t = 0; t < nt; t += 2) {
            const bool last = (t == nt - 2);
            const char* a1 = cA + PG8_AOFF(t + 1);
            const char* a2 = last ? nA : cA + PG8_AOFF(t + 2); const char* b2 = last ? nB : cB + (size_t)(t + 2) * kstep;
            const char* a3 = a2 + kstep; const char* b3 = b2 + kstep;
            const bool zf = seq0 && !last && (t + 2 >= nt / 2);
            PG8_LDB(B0, 0, 0); PG8_SCHED; PG8_LDA(At, 0, 0); PG8_STAGEA(PG8_SA(1, 1), a1 + hstepA, false);
            PG8_WAIT_L(8); PG8_BAR; PG8_WAIT_L(0); PG8_MMA(0, 0, At, B0); PG8_BAR; PG8_SCHED;
            PG8_LDB(B1, 0, 1); PG8_STAGEB(PG8_SB(0, 0), b2);
            PG8_BAR; PG8_WAIT_L(0); PG8_MMA(0, 1, At, B1); PG8_BAR;
            PG8_LDA(At, 0, 1); PG8_STAGEA(PG8_SA(0, 0), a2, zf);
            PG8_BAR; PG8_WAIT_L(0); PG8_MMA(1, 0, At, B0); PG8_BAR; PG8_SCHED;
            PG8_STAGEB(PG8_SB(0, 1), b2 + hstepB);
            PG8_WAIT_V(6); PG8_BAR; PG8_MMA(1, 1, At, B1); PG8_BAR;
            PG8_LDB(B0, 1, 0); PG8_SCHED; PG8_LDA(At, 1, 0); PG8_STAGEA(PG8_SA(0, 1), a2 + hstepA, false);
            PG8_WAIT_L(8); PG8_BAR; PG8_WAIT_L(0); PG8_MMA(0, 0, At, B0); PG8_BAR; PG8_SCHED;
            PG8_LDB(B1, 1, 1); PG8_STAGEB(PG8_SB(1, 0), b3);
            PG8_BAR; PG8_WAIT_L(0); PG8_MMA(0, 1, At, B1); PG8_BAR;
            PG8_LDA(At, 1, 1); PG8_STAGEA(PG8_SA(1, 0), a3, zf);
            PG8_BAR; PG8_WAIT_L(0); PG8_MMA(1, 0, At, B0); PG8_BAR; PG8_SCHED;
            PG8_STAGEB(PG8_SB(1, 1), b3 + hstepB);
            PG8_WAIT_V(6); PG8_BAR; PG8_MMA(1, 1, At, B1); PG8_BAR;
        }
        E(acc, cur, wr, wc, fr, fq);
        if (!has_next) break;
#pragma unroll
        for (int a = 0; a < 2; ++a)
#pragma unroll
            for (int b = 0; b < 2; ++b)
#pragma unroll
                for (int m = 0; m < 4; ++m)
#pragma unroll
                    for (int n = 0; n < 2; ++n) acc[a][b][m][n] = (f32x4){0.f, 0.f, 0.f, 0.f};
        cur = nxt; cA = nA; cB = nB; ++ui;
    }
    PG8_WAIT_V(0);
    if (wr == 0) PG8_BAR;
    PG8_BAR;
#undef PG8_SA
#undef PG8_SB
#undef PG8_STAGEA
#undef PG8_STAGEB
#undef PG8_LDA
#undef PG8_LDB
#undef PG8_MMA
#undef PG8_WAIT_V
#undef PG8_WAIT_L
#undef PG8_BAR
#undef PG8_SCHED
#undef PG8_AOFF
}

__device__ __forceinline__ float wval(const Params& p, int zo, int L, int spec, int n, int k) {
    const float* win = p.in[zo + I_WIN] + (size_t)L * DM * NIN;
    if (spec == 0) {
        if (n < 1536) return win[(size_t)k * NIN + 3864 + n];
        const int s = n - 1536;
        if (s < 8) return win[(size_t)k * NIN + 1280 + s];
        if (s < 24) return win[(size_t)k * NIN + 2824 + (s - 8)];
        if (s < 56) return (L == 0) ? 0.f : p.in[zo + I_WVRES][((size_t)(L - 1) * DM + k) * 32 + (s - 24)];
        if (s < 64) return 0.f;
        if (s < 224) return win[(size_t)k * NIN + 5400 + (s - 64)];
        return 0.f;
    } else if (spec == 1) {
        const int col = n < 1280 ? n : (n < 2816 ? n + 8 : n + 24); return win[(size_t)k * NIN + col];
    } else if (spec == 2) {
        const int pn = n >> 8, ct = n & 255, bj = ct >> 7, wc = (ct >> 5) & 3, nn = (ct >> 4) & 1, r16 = ct & 15;
        return win[(size_t)k * NIN + 5560 + (2 * bj + nn) * 1024 + pn * 64 + wc * 16 + r16];
    } else if (spec == 3) {
        const int kb = n >> 10, d = n & 1023; return p.in[zo + I_WBR][(((size_t)L * 4 + kb) * 512 + k) * 1024 + d];
    } else if (spec == 4) {
        return p.in[zo + I_WOUT][((size_t)L * 1024 + k) * 1024 + n];
    } else if (spec == 5) {
        const int pn = n >> 8, ct = n & 255;
        return ct < 128 ? p.in[zo + I_FG][((size_t)L * 1024 + k) * FH + pn * 128 + ct] : p.in[zo + I_FU][((size_t)L * 1024 + k) * FH + pn * 128 + ct - 128];
    } else {
        return p.in[zo + I_FD][((size_t)L * FH + k) * 1024 + n];
    }
}
__device__ void convert_weights(const Params& p, int L, LAS float* lf, int tile0, int tile1, int ordG, int ordC) {
    int zo = 0; asm volatile("" : "+s"(zo));
    int tid_ = threadIdx.x; asm volatile("" : "+v"(tid_));
    const int tid = tid_;
    for (int tile = tile0 + ordC; tile < tile1; tile += ordG) {
        int spec, tl = tile, ktiles; size_t dofs; int K;
        if (tl < 448) { spec = 0; ktiles = 16; dofs = WB_R; K = 1024; }
        else if ((tl -= 448) < 960) { spec = 1; ktiles = 16; dofs = WB_2; K = 1024; }
        else if ((tl -= 960) < 1024) { spec = 2; ktiles = 16; dofs = WB_G; K = 1024; }
        else if ((tl -= 1024) < 512) { spec = 3; ktiles = 8; dofs = WB_B; K = 512; }
        else if ((tl -= 512) < 256) { spec = 4; ktiles = 16; dofs = WB_O; K = 1024; }
        else if ((tl -= 256) < 1408) { spec = 5; ktiles = 16; dofs = WB_F; K = 1024; }
        else { tl -= 1408; spec = 6; ktiles = 44; dofs = WB_D; K = FH; }
        const int n0 = (tl / ktiles) * 64, k0 = (tl % ktiles) * 64;
        bf16_t* dst = (bf16_t*)(p.ws + dofs);
#pragma unroll
        for (int i = 0; i < 8; ++i) { const int idx = tid + i * 512, kk = idx >> 6, nn = idx & 63; lf[kk * 65 + nn] = wval(p, zo, L, spec, n0 + nn, k0 + kk); }
        __syncthreads();
#pragma unroll
        for (int i = 0; i < 4; ++i) { const int idx = tid + i * 512, nn = idx >> 5, k2 = (idx & 31) * 2;
            *(unsigned*)(dst + (size_t)(n0 + nn) * K + k0 + k2) = cvt_pk_bf16(lf[k2 * 65 + nn], lf[(k2 + 1) * 65 + nn]); }
        __syncthreads();
    }
}

template <int DT>
__device__ void resnorm(const float* xin, const void* delta, int ldd, const float* gd, float* xout, const float* gn, bf16_t* H) {
    int tid_ = threadIdx.x; asm volatile("" : "+v"(tid_));
    const int wid = tid_ >> 6, lane = tid_ & 63;
    const int stride = gridDim.x * 8;
    int row = blockIdx.x * 8 + wid;
    f32x4 gdv[4], gnv[4];
#pragma unroll
    for (int j = 0; j < 4; ++j) { gdv[j] = (DT != 0) ? *(const f32x4*)(gd + (j * 64 + lane) * 4) : (f32x4){0.f, 0.f, 0.f, 0.f}; gnv[j] = gn ? *(const f32x4*)(gn + (j * 64 + lane) * 4) : (f32x4){0.f, 0.f, 0.f, 0.f}; }
    f32x4 nx[4], nd[4]; u32x2 nb[4];
#define RN_LOAD(r_) do { _Pragma("unroll") for (int j = 0; j < 4; ++j) { nx[j] = *(const f32x4*)(xin + (size_t)(r_) * DM + (j * 64 + lane) * 4); \
        if (DT == 1) nb[j] = *(const u32x2*)((const bf16_t*)delta + (size_t)(r_) * ldd + (j * 64 + lane) * 4); \
        if (DT == 2) nd[j] = *(const f32x4*)((const float*)delta + (size_t)(r_) * ldd + (j * 64 + lane) * 4); } } while (0)
    if (row < T) RN_LOAD(row);
    while (row < T) {
        f32x4 xv[4], dv[4];
#pragma unroll
        for (int j = 0; j < 4; ++j) { xv[j] = nx[j]; if (DT == 1) dv[j] = (f32x4){bflo(nb[j].x), bfhi(nb[j].x), bflo(nb[j].y), bfhi(nb[j].y)}; if (DT == 2) dv[j] = nd[j]; }
        const int nrow = row + stride;
        if (nrow < T) RN_LOAD(nrow);
        if (DT != 0) {
            float ss = 0.f;
#pragma unroll
            for (int j = 0; j < 4; ++j) ss += dv[j][0] * dv[j][0] + dv[j][1] * dv[j][1] + dv[j][2] * dv[j][2] + dv[j][3] * dv[j][3];
            ss = red64(ss); const float rstd = rsqrtf(ss * (1.0f / DM) + 1e-6f);
#pragma unroll
            for (int j = 0; j < 4; ++j) xv[j] += dv[j] * rstd * gdv[j];
        }
        if (xout) {
#pragma unroll
            for (int j = 0; j < 4; ++j) *(f32x4*)(xout + (size_t)row * DM + (j * 64 + lane) * 4) = xv[j];
        }
        if (gn) {
            float ss = 0.f;
#pragma unroll
            for (int j = 0; j < 4; ++j) ss += xv[j][0] * xv[j][0] + xv[j][1] * xv[j][1] + xv[j][2] * xv[j][2] + xv[j][3] * xv[j][3];
            ss = red64(ss); const float rstd = rsqrtf(ss * (1.0f / DM) + 1e-6f);
#pragma unroll
            for (int j = 0; j < 4; ++j) { const f32x4 h = xv[j] * rstd * gnv[j];
                u32x2 w; w.x = cvt_pk_bf16(h[0], h[1]); w.y = cvt_pk_bf16(h[2], h[3]); *(u32x2*)(H + (size_t)row * DM + (j * 64 + lane) * 4) = w; }
        }
        row = nrow;
    }
#undef RN_LOAD
}

constexpr int TC = 32;
typedef float f32x2 __attribute__((ext_vector_type(2)));
template <int NE, bool RW> struct StepOps { f32x4 w[NE / 4], k[NE / 4], r[NE / 4], a[RW ? NE / 4 : 1], b[RW ? NE / 4 : 1]; float v; };
template <int NE, bool RW>
__device__ __forceinline__ void step_load(StepOps<NE, RW>& o, const LAS float* base, const LAS float* opV, int vo) {
#pragma unroll
    for (int e = 0; e < NE / 4; ++e) { o.w[e] = *(const LAS f32x4*)(base + 4 * e); o.k[e] = *(const LAS f32x4*)(base + 2048 + 4 * e); o.r[e] = *(const LAS f32x4*)(base + 4096 + 4 * e);
        if (RW) { o.a[e] = *(const LAS f32x4*)(base + 6144 + 4 * e); o.b[e] = *(const LAS f32x4*)(base + 8192 + 4 * e); } }
    o.v = opV[vo];
}
#define LO2(q) ((f32x2){(q)[0], (q)[1]})
#define HI2(q) ((f32x2){(q)[2], (q)[3]})
template <int LPR, bool RW>
__device__ __forceinline__ float step_compute(f32x2 (&s)[32 / LPR], const StepOps<64 / LPR, RW>& o) {
    constexpr int NE = 64 / LPR;
    f32x2 tk[NE / 2];
    const f32x2 v2 = (f32x2){o.v, o.v};
#pragma unroll
    for (int e = 0; e < NE / 4; ++e) { tk[2 * e] = LO2(o.k[e]) * v2; tk[2 * e + 1] = HI2(o.k[e]) * v2; }
    if (RW) {
        f32x2 sa2 = (f32x2){0.f, 0.f}, sb2 = (f32x2){0.f, 0.f};
#pragma unroll
        for (int e = 0; e < NE / 4; ++e) { sa2 += s[2 * e] * LO2(o.a[e]); sb2 += s[2 * e + 1] * HI2(o.a[e]); }
        sa2 += sb2; float sa = sa2[0] + sa2[1]; sa = (LPR == 8) ? red8(sa) : red4(sa);
        const f32x2 sv = (f32x2){sa, sa};
#pragma unroll
        for (int e = 0; e < NE / 4; ++e) { tk[2 * e] += LO2(o.b[e]) * sv; tk[2 * e + 1] += HI2(o.b[e]) * sv; }
    }
    f32x2 y2 = (f32x2){0.f, 0.f}, z2 = (f32x2){0.f, 0.f};
#pragma unroll
    for (int e = 0; e < NE / 4; ++e) { s[2 * e] = s[2 * e] * LO2(o.w[e]) + tk[2 * e]; s[2 * e + 1] = s[2 * e + 1] * HI2(o.w[e]) + tk[2 * e + 1];
        y2 += s[2 * e] * LO2(o.r[e]); z2 += s[2 * e + 1] * HI2(o.r[e]); }
    y2 += z2; float y = y2[0] + y2[1]; y = (LPR == 8) ? red8(y) : red4(y);
    return y;
}
template <int LPR, bool RW>
__device__ __forceinline__ void scan_chunk(f32x2 (&s)[32 / LPR], const LAS float* opW, const LAS float* opK, const LAS float* opR, const LAS float* opA, const LAS float* opB,
                                           const LAS float* opV, LAS float* Y, int vstride, int row, int sub) {
    constexpr int NE = 64 / LPR;
    StepOps<NE, RW> o0, o1;
    unsigned bt = (unsigned)(size_t)(opW + sub * NE), bv = (unsigned)(size_t)(opV + row);
    step_load<NE, RW>(o0, (const LAS float*)(size_t)bt, (const LAS float*)(size_t)bv, 0);
#pragma unroll 1
    for (int t = 0; t < TC; t += 2) {
        asm volatile("" : "+v"(bt), "+v"(bv));
        const LAS float* b0 = (const LAS float*)(size_t)bt; const LAS float* v0 = (const LAS float*)(size_t)bv;
        step_load<NE, RW>(o1, b0 + 64, v0, vstride);
        const float y0 = step_compute<LPR, RW>(s, o0);
        step_load<NE, RW>(o0, b0 + 128, v0, 2 * vstride);
        const float y1 = step_compute<LPR, RW>(s, o1);
        if (sub == 0) { Y[t * vstride + row] = y0; Y[(t + 1) * vstride + row] = y1; }
        bt += 512; bv += 8 * vstride;
    }
}

__device__ void rwkv_item_old(const Params& p, int L, int item, LAS unsigned char* lds, bool dry) {
    int zo = 0; asm volatile("" : "+s"(zo));
    int tid_ = threadIdx.x; asm volatile("" : "+v"(tid_));
    const int b = item >> 3, h = item & 7, tid = tid_, wv = tid >> 6, lane = tid & 63, c = lane, hc = h * 64 + c;
    LAS bf16_t* WT = (LAS bf16_t*)lds;
    LAS bf16_t* LOSB = WT + 64 * 200;
    LAS float* AW = (LAS float*)(lds + 38400); LAS float* AA = AW + 2048; LAS float* AV = AA + 2048; LAS float* G = AV + 2048;
    LAS float* opW = G + 2048; LAS float* opK = opW + 2048; LAS float* opR = opK + 2048; LAS float* opA = opR + 2048; LAS float* opB = opA + 2048;
    LAS float* opV = opB + 2048; LAS float* Y = opV + 2048; LAS float* BON = Y + 2048;
    bf16_t* P = (bf16_t*)(p.ws + OFF_P); const float* SM = (const float*)(p.ws + OFF_SM); const bf16_t* VF = (const bf16_t*)(p.ws + OFF_VF);
    __syncthreads();
    for (int i = tid; i < 192 * 64; i += 512) { const int j = i >> 6, cc = i & 63; float v;
        if (j < 32) v = p.in[zo + I_RWW2][((size_t)L * 32 + j) * 512 + h * 64 + cc];
        else if (j < 64) v = p.in[zo + I_RAW2][((size_t)L * 32 + (j - 32)) * 512 + h * 64 + cc];
        else if (j < 96) v = (L > 0) ? p.in[zo + I_RVW2][((size_t)(L - 1) * 32 + (j - 64)) * 512 + h * 64 + cc] : 0.f;
        else v = p.in[zo + I_RGW2][((size_t)L * 96 + (j - 96)) * 512 + h * 64 + cc];
        WT[cc * 200 + j] = f2bf(v); }
    const float w0 = p.in[zo + I_RW0][L * 512 + hc], a0 = p.in[zo + I_RA0][L * 512 + hc], v0 = (L > 0) ? p.in[zo + I_RV0][(L - 1) * 512 + hc] : 0.f;
    const float k_k = p.in[zo + I_RKK][L * 512 + hc], k_a = p.in[zo + I_RKA][L * 512 + hc], r_k = p.in[zo + I_RRK][L * 512 + hc], ln_g = p.in[zo + I_RLNG][L * 512 + hc], ln_b = p.in[zo + I_RLNB][L * 512 + hc];
    f32x2 s[4];
#pragma unroll
    for (int e = 0; e < 4; ++e) s[e] = (f32x2){0.f, 0.f};
    const int row = wv * 8 + (lane >> 3), sub = lane & 7;
    int smo[12];
#pragma unroll
    for (int i = 0; i < 12; ++i) { const int idx = tid + i * 512, t = idx / 192, j = idx % 192; smo[i] = t * 256 + (j < 64 ? 64 + j : (j < 96 ? j - 40 : j + 32)); }
    float nsm[12]; bf16_t nr[4], nk[4], nv[4], nf[4];
#define RWKV_LOAD(chn) do { const size_t Rn = (size_t)b * SEQ + (size_t)(chn) * TC; \
        _Pragma("unroll") for (int i = 0; i < 12; ++i) nsm[i] = SM[Rn * 256 + smo[i]]; \
        _Pragma("unroll") for (int i = 0; i < 4; ++i) { const size_t R = Rn + wv * 4 + i; nr[i] = P[R * LDP + PC_RR + hc]; nk[i] = P[R * LDP + PC_RK + hc]; nv[i] = P[R * LDP + PC_RV + hc]; nf[i] = (L > 0) ? VF[R * 512 + hc] : (bf16_t)0; } } while (0)
    RWKV_LOAD(0);
    for (int ch = 0; ch < SEQ / TC; ++ch) {
        const size_t R0 = (size_t)b * SEQ + (size_t)ch * TC;
        float csm[12]; bf16_t cr[4], ck[4], cv[4], cf[4];
#pragma unroll
        for (int i = 0; i < 12; ++i) csm[i] = nsm[i];
#pragma unroll
        for (int i = 0; i < 4; ++i) { cr[i] = nr[i]; ck[i] = nk[i]; cv[i] = nv[i]; cf[i] = nf[i]; }
        if (ch + 1 < SEQ / TC) RWKV_LOAD(ch + 1);
#pragma unroll
        for (int i = 0; i < 12; ++i) { const int idx = tid + i * 512, t = idx / 192, j = idx % 192;
            const float v = csm[i], e = __expf(j < 32 ? 2.0f * v : -v), rr = __builtin_amdgcn_rcpf(1.0f + e);
            LOSB[t * 200 + j] = f2bf(j < 32 ? 1.0f - 2.0f * rr : (j >= 96 ? rr : v)); }
        __syncthreads();
        { const int mt = wv & 1, nt = wv >> 1; const int ao = (mt * 16 + (lane & 15)) * 200 + 8 * (lane >> 4), bo = (nt * 16 + (lane & 15)) * 200 + 8 * (lane >> 4);
            bf16x8 af[6], bfr[6];
#pragma unroll
            for (int ks = 0; ks < 6; ++ks) { af[ks] = *(const LAS bf16x8*)(LOSB + ao + ks * 32); bfr[ks] = *(const LAS bf16x8*)(WT + bo + ks * 32); }
            const f32x4 z4 = (f32x4){0.f, 0.f, 0.f, 0.f};
            const f32x4 cw = __builtin_amdgcn_mfma_f32_16x16x32_bf16(af[0], bfr[0], z4, 0, 0, 0);
            const f32x4 ca = __builtin_amdgcn_mfma_f32_16x16x32_bf16(af[1], bfr[1], z4, 0, 0, 0);
            const f32x4 cvv = __builtin_amdgcn_mfma_f32_16x16x32_bf16(af[2], bfr[2], z4, 0, 0, 0);
            f32x4 cg = __builtin_amdgcn_mfma_f32_16x16x32_bf16(af[3], bfr[3], z4, 0, 0, 0);
            cg = __builtin_amdgcn_mfma_f32_16x16x32_bf16(af[4], bfr[4], cg, 0, 0, 0);
            cg = __builtin_amdgcn_mfma_f32_16x16x32_bf16(af[5], bfr[5], cg, 0, 0, 0);
#pragma unroll
            for (int rg = 0; rg < 4; ++rg) { const int o = (mt * 16 + (lane >> 4) * 4 + rg) * 64 + nt * 16 + (lane & 15); AW[o] = cw[rg]; AA[o] = ca[rg]; AV[o] = cvv[rg]; G[o] = cg[rg]; } }
        __syncthreads();
        { float kkr[4], km[4], av_[4], vv[4], rr_[4], red[8];
#pragma unroll
            for (int i = 0; i < 4; ++i) { const int t = wv * 4 + i;
                av_[i] = sigmoidf_(a0 + AA[t * 64 + c]);
                const float k_ = bf2f(ck[i]); rr_[i] = bf2f(cr[i]); vv[i] = bf2f(cv[i]);
                if (L > 0) { const float vf = bf2f(cf[i]); vv[i] = vv[i] + (vf - vv[i]) * sigmoidf_(v0 + AV[t * 64 + c]); }
                kkr[i] = k_ * k_k; km[i] = k_ * (1.0f + (av_[i] - 1.0f) * k_a);
                red[i] = kkr[i] * kkr[i]; red[4 + i] = rr_[i] * km[i] * r_k; }
            red64n<8>(red);
#pragma unroll
            for (int i = 0; i < 4; ++i) { const int t = wv * 4 + i;
                const float wdec = __expf(-0.60653066f * sigmoidf_(w0 + AW[t * 64 + c]));
                const float kk = kkr[i] * rsqrtf(fmaxf(red[i], 1e-24f));
                opW[t * 64 + c] = wdec; opK[t * 64 + c] = km[i]; opR[t * 64 + c] = rr_[i]; opA[t * 64 + c] = -kk; opB[t * 64 + c] = kk * av_[i]; opV[t * 64 + c] = vv[i];
                if (lane == 0) BON[t] = red[4 + i]; } }
        __syncthreads();
        if (!(dry && DRY_SKIP_SCAN)) scan_chunk<8, true>(s, opW, opK, opR, opA, opB, opV, Y, 64, row, sub);
        __syncthreads();
        { float y[4], m[4], q[4];
#pragma unroll
            for (int i = 0; i < 4; ++i) { y[i] = Y[(wv * 4 + i) * 64 + c]; m[i] = y[i]; }
            red64n<4>(m);
#pragma unroll
            for (int i = 0; i < 4; ++i) { y[i] -= m[i] * (1.0f / 64.0f); q[i] = y[i] * y[i]; }
            red64n<4>(q);
#pragma unroll
            for (int i = 0; i < 4; ++i) { const int t = wv * 4 + i; const size_t R = R0 + t;
                float yn = y[i] * rsqrtf(q[i] * (1.0f / 64.0f) + 64e-5f) * ln_g + ln_b; yn += BON[t] * opV[t * 64 + c];
                if (!dry) P[R * LDP + PC_RR + hc] = f2bf(yn * G[t * 64 + c]); } }
    }
#undef RWKV_LOAD
}


__device__ void gla_item(const Params& p, int L, int item, LAS float* lf, bool dry) {
    int zo = 0; asm volatile("" : "+s"(zo));
    int tid_ = threadIdx.x; asm volatile("" : "+v"(tid_));
    const int tid = tid_, wv = tid >> 6, lane = tid & 63, c = lane;
    LAS float* opW = lf; LAS float* opK = opW + 2048; LAS float* opR = opK + 2048; LAS float* opV = opR + 2048; LAS float* Y = opV + 2048; LAS float* X0 = Y + 2048; LAS float* X1 = X0 + 512;
    bf16_t* P = (bf16_t*)(p.ws + OFF_P); const float* SM = (const float*)(p.ws + OFF_SM);
    const int half = item & 1, bh = item >> 1, b = bh >> 2, h = bh & 3, vcol = PC_GV + h * 128 + half * 64;
    __syncthreads();
    for (int i = tid; i < 16 * 64; i += 512) X1[i] = p.in[zo + I_GAW][((size_t)L * 16 + (i >> 6)) * 256 + h * 64 + (i & 63)];
    const float ab = p.in[zo + I_GAB][L * 256 + h * 64 + c];
    f32x2 s[4];
#pragma unroll
    for (int e = 0; e < 4; ++e) s[e] = (f32x2){0.f, 0.f};
    const int row = wv * 8 + (lane >> 3), sub = lane & 7;
    float nlo; bf16_t nvv[4], nk[4], nq[4];
#define GLA_LOAD(chn) do { const size_t Rn = (size_t)b * SEQ + (size_t)(chn) * TC; nlo = SM[(Rn + (tid >> 4)) * 256 + 8 + (tid & 15)]; \
        _Pragma("unroll") for (int i = 0; i < 4; ++i) { const int idx = tid + i * 512; nvv[i] = P[(Rn + (idx >> 6)) * LDP + vcol + (idx & 63)]; } \
        _Pragma("unroll") for (int i = 0; i < 4; ++i) { const size_t R = Rn + wv * 4 + i; nk[i] = P[R * LDP + PC_GK + h * 64 + c]; nq[i] = P[R * LDP + PC_GQ + h * 64 + c]; } } while (0)
    GLA_LOAD(0);
    for (int ch = 0; ch < SEQ / TC; ++ch) {
        const size_t R0 = (size_t)b * SEQ + (size_t)ch * TC;
        X0[tid] = nlo;
#pragma unroll
        for (int i = 0; i < 4; ++i) opV[tid + i * 512] = bf2f(nvv[i]);
        bf16_t ck[4], cq[4];
#pragma unroll
        for (int i = 0; i < 4; ++i) { ck[i] = nk[i]; cq[i] = nq[i]; }
        if (ch + 1 < SEQ / TC) GLA_LOAD(ch + 1);
        __syncthreads();
#pragma unroll
        for (int i = 0; i < 4; ++i) { const int t = wv * 4 + i; float la = ab;
#pragma unroll
            for (int j = 0; j < 16; ++j) la += X0[t * 16 + j] * X1[j * 64 + c];
            opW[t * 64 + c] = __expf(__logf(sigmoidf_(la)) * (1.0f / 16.0f));
            opK[t * 64 + c] = bf2f(ck[i]); opR[t * 64 + c] = bf2f(cq[i]) * 0.125f; }
        __syncthreads();
        scan_chunk<8, false>(s, opW, opK, opR, opW, opW, opV, Y, 64, row, sub);
        __syncthreads();
        if (!dry) {
#pragma unroll
            for (int i = 0; i < 4; ++i) { const int t = wv * 4 + i; P[(R0 + t) * LDP + vcol + c] = f2bf(Y[t * 64 + c]); }
        }
    }
#undef GLA_LOAD
}

template <int MODE>
__device__ void plain_item(const Params& p, int L, int item, LAS float* lf, bool dry) {
    int zo = 0; asm volatile("" : "+s"(zo));
    int tid_ = threadIdx.x; asm volatile("" : "+v"(tid_));
    const int tid = tid_, wv = tid >> 6, lane = tid & 63, c = lane;
    constexpr int VS = (MODE == 0) ? 128 : 64;
    LAS float* opW = lf; LAS float* opK = opW + 2048; LAS float* opR = opK + 2048; LAS float* opV = opR + 2048; LAS float* Y = opV + TC * VS; LAS float* X0 = Y + TC * VS; LAS float* X1 = X0 + 2048;
    bf16_t* P = (bf16_t*)(p.ws + OFF_P); const float* SM = (const float*)(p.ws + OFF_SM);
    __syncthreads();
    if (MODE == 0) {
        const int b = item >> 2, h = item & 3;
        for (int i = tid; i < 16 * 64; i += 512) X1[i] = p.in[zo + I_GAW][((size_t)L * 16 + (i >> 6)) * 256 + h * 64 + (i & 63)];
        const float ab = p.in[zo + I_GAB][L * 256 + h * 64 + c], gn0 = p.in[zo + I_GNG][L * 128 + lane], gn1 = p.in[zo + I_GNG][L * 128 + 64 + lane];
        f32x2 s[8];
#pragma unroll
        for (int e = 0; e < 8; ++e) s[e] = (f32x2){0.f, 0.f};
        const int row = wv * 16 + (lane >> 2), sub = lane & 3;
        float nlo; bf16_t nvv[8], nk[4], nq[4], ng0[4], ng1[4];
#define GLA_LOAD(chn) do { const size_t Rn = (size_t)b * SEQ + (size_t)(chn) * TC; nlo = SM[(Rn + (tid >> 4)) * 256 + 8 + (tid & 15)]; \
        _Pragma("unroll") for (int i = 0; i < 8; ++i) { const int idx = tid + i * 512; nvv[i] = P[(Rn + (idx >> 7)) * LDP + PC_GV + h * 128 + (idx & 127)]; } \
        _Pragma("unroll") for (int i = 0; i < 4; ++i) { const size_t R = Rn + wv * 4 + i; nk[i] = P[R * LDP + PC_GK + h * 64 + c]; nq[i] = P[R * LDP + PC_GQ + h * 64 + c]; \
            ng0[i] = P[R * LDP + PC_GR + h * 128 + lane]; ng1[i] = P[R * LDP + PC_GR + h * 128 + 64 + lane]; } } while (0)
        GLA_LOAD(0);
        for (int ch = 0; ch < SEQ / TC; ++ch) {
            const size_t R0 = (size_t)b * SEQ + (size_t)ch * TC;
            X0[tid] = nlo;
#pragma unroll
            for (int i = 0; i < 8; ++i) opV[tid + i * 512] = bf2f(nvv[i]);
            bf16_t ck[4], cq[4], cg0[4], cg1[4];
#pragma unroll
            for (int i = 0; i < 4; ++i) { ck[i] = nk[i]; cq[i] = nq[i]; cg0[i] = ng0[i]; cg1[i] = ng1[i]; }
            if (ch + 1 < SEQ / TC) GLA_LOAD(ch + 1);
            __syncthreads();
#pragma unroll
            for (int i = 0; i < 4; ++i) { const int t = wv * 4 + i; float la = ab;
#pragma unroll
                for (int j = 0; j < 16; ++j) la += X0[t * 16 + j] * X1[j * 64 + c];
                opW[t * 64 + c] = __expf(__logf(sigmoidf_(la)) * (1.0f / 16.0f));
                opK[t * 64 + c] = bf2f(ck[i]); opR[t * 64 + c] = bf2f(cq[i]) * 0.125f; }
            __syncthreads();
            scan_chunk<4, false>(s, opW, opK, opR, opW, opW, opV, Y, 128, row, sub);
            __syncthreads();
#pragma unroll
            for (int i = 0; i < 4; ++i) { const int t = wv * 4 + i; const size_t R = R0 + t;
                const float y0 = Y[t * 128 + lane], y1 = Y[t * 128 + 64 + lane], ss = red64(y0 * y0 + y1 * y1), rstd = rsqrtf(ss * (1.0f / 128.0f) + 1e-6f);
                bf16_t* rp = P + R * LDP + PC_GR + h * 128;
                const float r0 = bf2f(cg0[i]), r1 = bf2f(cg1[i]);
                if (!dry) { rp[lane] = f2bf(y0 * rstd * gn0 * siluf_(r0)); rp[64 + lane] = f2bf(y1 * rstd * gn1 * siluf_(r1)); } }
        }
#undef GLA_LOAD
    } else {
        const int b = item >> 3, hh = item & 7, g = hh >> 2;
        const int chx = hh * 64 + c, chb = 512 + g * 64 + c, chc = 640 + g * 64 + c;
        const float* cw = p.in[zo + I_SCW] + (size_t)L * 4 * 768; const float* cb = p.in[zo + I_SCB] + (size_t)L * 768;
        float cwx[4], cwb[4], cwc[4];
#pragma unroll
        for (int k = 0; k < 4; ++k) { cwx[k] = cw[k * 768 + chx]; cwb[k] = cw[k * 768 + chb]; cwc[k] = cw[k * 768 + chc]; }
        const float cbx = cb[chx], cbb = cb[chb], cbc = cb[chc];
        const float dtb = p.in[zo + I_SDTB][L * 8 + hh], Aneg = -__expf(p.in[zo + I_SALOG][L * 8 + hh]), Dsk = p.in[zo + I_SD][L * 8 + hh];
        f32x2 s[4];
#pragma unroll
        for (int e = 0; e < 4; ++e) s[e] = (f32x2){0.f, 0.f};
        const int row = wv * 8 + (lane >> 3), sub = lane & 7;
        const int t0 = wv * 4;
        bf16_t nx[7], nb[7], nc[7], nz[4]; float ndt[4];
#define SSD_LOAD(chn) do { const int sp0 = (chn) * TC + t0; \
        _Pragma("unroll") for (int q = 0; q < 7; ++q) { const int sp = sp0 - 3 + q; const size_t R = (size_t)b * SEQ + sp; \
            if (sp >= 0) { nx[q] = P[R * LDP + PC_XBC + chx]; nb[q] = P[R * LDP + PC_XBC + chb]; nc[q] = P[R * LDP + PC_XBC + chc]; } else { nx[q] = 0; nb[q] = 0; nc[q] = 0; } } \
        _Pragma("unroll") for (int i = 0; i < 4; ++i) { const size_t R = (size_t)b * SEQ + sp0 + i; nz[i] = P[R * LDP + PC_Z + chx]; ndt[i] = SM[R * 256 + hh]; } } while (0)
        SSD_LOAD(0);
        for (int ch = 0; ch < SEQ / TC; ++ch) {
            const size_t R0 = (size_t)b * SEQ + (size_t)ch * TC;
            float rx[7], rb[7], rc[7], cz[4], cdt[4];
#pragma unroll
            for (int q = 0; q < 7; ++q) { rx[q] = bf2f(nx[q]); rb[q] = bf2f(nb[q]); rc[q] = bf2f(nc[q]); }
#pragma unroll
            for (int i = 0; i < 4; ++i) { cz[i] = bf2f(nz[i]); cdt[i] = ndt[i]; }
            if (ch + 1 < SEQ / TC) SSD_LOAD(ch + 1);
#pragma unroll
            for (int i = 0; i < 4; ++i) { const int t = t0 + i;
                float x = cbx, bm = cbb, cm = cbc;
#pragma unroll
                for (int k = 0; k < 4; ++k) { x += cwx[k] * rx[i + k]; bm += cwb[k] * rb[i + k]; cm += cwc[k] * rc[i + k]; }
                x = siluf_(x); bm = siluf_(bm); cm = siluf_(cm);
                const float dt = softplusf_(cdt[i] + dtb);
                opW[t * 64 + c] = __expf(dt * Aneg); opK[t * 64 + c] = bm; opR[t * 64 + c] = cm; opV[t * 64 + c] = dt * x; X0[t * 64 + c] = x; }
            __syncthreads();
            scan_chunk<8, false>(s, opW, opK, opR, opW, opW, opV, Y, 64, row, sub);
            __syncthreads();
#pragma unroll
            for (int i = 0; i < 4; ++i) { const int t = t0 + i; const size_t R = R0 + t;
                const float y = Y[t * 64 + c] + Dsk * X0[t * 64 + c];
                if (!dry) P[R * LDP + PC_Z + chx] = f2bf(y * siluf_(cz[i])); }
            __syncthreads();
        }
#undef SSD_LOAD
    }
}

__device__ void lru_item(const Params& p, int L, int item, LAS float* lf, bool dry) {
    int zo = 0; asm volatile("" : "+s"(zo));
    int tid_ = threadIdx.x; asm volatile("" : "+v"(tid_));
    const int b = item >> 3, blk = item & 7, tid = tid_, wv = tid >> 6, lane = tid & 63, c = lane, cbi = blk * 64 + c;
    LAS float* wa = lf; LAS float* wx = wa + 4096; LAS float* XB = wx + 4096; LAS float* A_ = XB + 2048; LAS float* U_ = A_ + 2048; LAS float* HS = U_ + 2048;
    bf16_t* P = (bf16_t*)(p.ws + OFF_P);
    __syncthreads();
    for (int i = tid; i < 4096; i += 512) { wa[i] = p.in[zo + I_LWA][((size_t)L * 8 + blk) * 4096 + i]; wx[i] = p.in[zo + I_LWX][((size_t)L * 8 + blk) * 4096 + i]; }
    float cwv[4];
#pragma unroll
    for (int k = 0; k < 4; ++k) cwv[k] = p.in[zo + I_LCW][((size_t)L * 4 + k) * 512 + cbi];
    const float cbv = p.in[zo + I_LCB][L * 512 + cbi], ba = p.in[zo + I_LBA][L * 512 + cbi], bx = p.in[zo + I_LBX][L * 512 + cbi];
    const float spl = softplusf_(-p.in[zo + I_LLAM][L * 512 + cbi]);
    float hstate = 0.f;
    const int t0 = wv * 4;
    bf16_t nx[7], ngt[4];
#define LRU_LOAD(chn) do { const int sp0 = (chn) * TC + t0; \
        _Pragma("unroll") for (int q = 0; q < 7; ++q) { const int sp = sp0 - 3 + q; nx[q] = (sp >= 0) ? P[((size_t)b * SEQ + sp) * LDP + PC_LX + cbi] : (bf16_t)0; } \
        _Pragma("unroll") for (int i = 0; i < 4; ++i) ngt[i] = P[((size_t)b * SEQ + sp0 + i) * LDP + PC_LG + cbi]; } while (0)
    LRU_LOAD(0);
    for (int ch = 0; ch < SEQ / TC; ++ch) {
        const size_t R0 = (size_t)b * SEQ + (size_t)ch * TC;
        float rx[7], cg[4];
#pragma unroll
        for (int q = 0; q < 7; ++q) rx[q] = bf2f(nx[q]);
#pragma unroll
        for (int i = 0; i < 4; ++i) cg[i] = bf2f(ngt[i]);
        if (ch + 1 < SEQ / TC) LRU_LOAD(ch + 1);
        float xb[4];
#pragma unroll
        for (int i = 0; i < 4; ++i) { float x = cbv;
#pragma unroll
            for (int k = 0; k < 4; ++k) x += cwv[k] * rx[i + k];
            xb[i] = x; XB[(t0 + i) * 64 + c] = x; }
        __syncthreads();
        float ar[4] = {ba, ba, ba, ba}, ai[4] = {bx, bx, bx, bx};
#pragma unroll 4
        for (int j4 = 0; j4 < 16; ++j4) {
            float wra[4], wrx[4];
#pragma unroll
            for (int e = 0; e < 4; ++e) { wra[e] = wa[(j4 * 4 + e) * 64 + c]; wrx[e] = wx[(j4 * 4 + e) * 64 + c]; }
#pragma unroll
            for (int i = 0; i < 4; ++i) { const f32x4 x4 = *(const LAS f32x4*)(XB + (t0 + i) * 64 + j4 * 4);
                ar[i] += x4[0] * wra[0] + x4[1] * wra[1] + x4[2] * wra[2] + x4[3] * wra[3]; ai[i] += x4[0] * wrx[0] + x4[1] * wrx[1] + x4[2] * wrx[2] + x4[3] * wrx[3]; }
        }
#pragma unroll
        for (int i = 0; i < 4; ++i) { const float r = sigmoidf_(ar[i]), ig = sigmoidf_(ai[i]), la = -8.0f * r * spl, a = __expf(la);
            const float u = sqrtf(fmaxf(1.0f - a * a, 0.f)) * (ig * xb[i]);
            A_[(t0 + i) * 64 + c] = a; U_[(t0 + i) * 64 + c] = u; }
        __syncthreads();
        if (wv == 0) {
#pragma unroll 8
            for (int t = 0; t < TC; ++t) { hstate = A_[t * 64 + c] * hstate + U_[t * 64 + c]; HS[t * 64 + c] = hstate; }
        }
        __syncthreads();
#pragma unroll
        for (int i = 0; i < 4; ++i) { const size_t R = R0 + t0 + i; const float g = cg[i];
            const float u2 = 1.5957691216f * (g + 0.044715f * g * g * g);
            if (!dry) P[R * LDP + PC_LG + cbi] = f2bf(HS[(t0 + i) * 64 + c] * g * sigmoidf_(u2)); }
    }
#undef LRU_LOAD
}

__device__ void ssd_post(const Params& p, int L, int ordG, int ordC) {
    int zo = 0; asm volatile("" : "+s"(zo));
    int tid_ = threadIdx.x; asm volatile("" : "+v"(tid_));
    const int wid = tid_ >> 6, lane = tid_ & 63;
    bf16_t* P = (bf16_t*)(p.ws + OFF_P);
    const f32x4 g0 = *(const f32x4*)(p.in[zo + I_SNG] + L * 512 + lane * 8), g1 = *(const f32x4*)(p.in[zo + I_SNG] + L * 512 + lane * 8 + 4);
    const f32x4 gg0 = *(const f32x4*)(p.in[zo + I_GNG] + L * 128 + (lane & 15) * 8), gg1 = *(const f32x4*)(p.in[zo + I_GNG] + L * 128 + (lane & 15) * 8 + 4);
    for (int row = ordC * 8 + wid; row < T; row += ordG * 8) {
        u32x4* pp = (u32x4*)(P + (size_t)row * LDP + PC_Z + lane * 8); const u32x4 w = *pp;
        float v[8] = {bflo(w.x), bfhi(w.x), bflo(w.y), bfhi(w.y), bflo(w.z), bfhi(w.z), bflo(w.w), bfhi(w.w)};
        float ss = 0.f;
#pragma unroll
        for (int j = 0; j < 8; ++j) ss += v[j] * v[j];
        ss = red32(ss); const float rstd = rsqrtf(ss * (1.0f / 256.0f) + 1e-6f);
        u32x4 o; o.x = cvt_pk_bf16(v[0] * rstd * g0[0], v[1] * rstd * g0[1]); o.y = cvt_pk_bf16(v[2] * rstd * g0[2], v[3] * rstd * g0[3]);
        o.z = cvt_pk_bf16(v[4] * rstd * g1[0], v[5] * rstd * g1[1]); o.w = cvt_pk_bf16(v[6] * rstd * g1[2], v[7] * rstd * g1[3]);
        *pp = o;
        if (!GLA_SPLIT) continue;
        u32x4* gp = (u32x4*)(P + (size_t)row * LDP + PC_GR + lane * 8); const u32x4 yw = *(const u32x4*)(P + (size_t)row * LDP + PC_GV + lane * 8), rw = *gp;
        float y[8] = {bflo(yw.x), bfhi(yw.x), bflo(yw.y), bfhi(yw.y), bflo(yw.z), bfhi(yw.z), bflo(yw.w), bfhi(yw.w)};
        float rg[8] = {bflo(rw.x), bfhi(rw.x), bflo(rw.y), bfhi(rw.y), bflo(rw.z), bfhi(rw.z), bflo(rw.w), bfhi(rw.w)};
        float s2 = 0.f;
#pragma unroll
        for (int j = 0; j < 8; ++j) s2 += y[j] * y[j];
        s2 = red16(s2); const float rs2 = rsqrtf(s2 * (1.0f / 128.0f) + 1e-6f);
        float og[8];
#pragma unroll
        for (int j = 0; j < 8; ++j) og[j] = y[j] * rs2 * (j < 4 ? gg0[j] : gg1[j - 4]) * siluf_(rg[j]);
        u32x4 o2; o2.x = cvt_pk_bf16(og[0], og[1]); o2.y = cvt_pk_bf16(og[2], og[3]); o2.z = cvt_pk_bf16(og[4], og[5]); o2.w = cvt_pk_bf16(og[6], og[7]);
        *gp = o2;
    }
}


__device__ __forceinline__ void b1_fixup(const Params& p, int L, const bf16_t* stp, const float* sts) {
    int zo = 0; asm volatile("" : "+s"(zo));
    int tid_ = threadIdx.x; asm volatile("" : "+v"(tid_));
    bf16_t* P = (bf16_t*)(p.ws + OFF_P); float* SM = (float*)(p.ws + OFF_SM); bf16_t* VF = (bf16_t*)(p.ws + OFF_VF);
    const float* mu = p.in[zo + I_RMU] + L * 1696;
    for (int idx = blockIdx.x * 512 + tid_; idx < 512 * 1792; idx += gridDim.x * 512) {
        const int g = idx / 1792, c = idx % 1792; const size_t R = (size_t)g * 64; const bool first = (R % SEQ) == 0;
        if (c < 1536) { const float cur = bf2f(P[R * LDP + PC_RR + c]), prev = first ? 0.f : bf2f(stp[(size_t)(g - 1) * 1536 + c]);
            const bf16_t o = f2bf(cur + (prev - cur) * mu[c]); P[R * LDP + PC_RR + c] = o; if (L == 0 && c >= 1024) VF[R * 512 + c - 1024] = o; }
        else { const int sc = c - 1536; const float m = (sc >= 64 && sc < 224) ? mu[1536 + sc - 64] : 0.f;
            const float cur = SM[R * 256 + sc], prev = first ? 0.f : sts[(size_t)(g - 1) * 256 + sc]; SM[R * 256 + sc] = cur + (prev - cur) * m; }
    }
}

#define XB_TMO      128
#define XB_XCNT(j)  (256  + 64 * (j))
#define XB_XSUB(j)  (1280 + 64 * (j))
#define XB_XGEN(j)  (2304 + 64 * (j))
#define XB_TOP      3328
#define XB_TOPGEN   3392
#define XCD_BAR_WORDS 3456
#define XB_SPIN_CAP (1u << 22)
__device__ __forceinline__ unsigned xb_ld(unsigned* p)              { return __hip_atomic_load(p, __ATOMIC_RELAXED, __HIP_MEMORY_SCOPE_AGENT); }
__device__ __forceinline__ unsigned xb_add(unsigned* p, unsigned v) { return __hip_atomic_fetch_add(p, v, __ATOMIC_RELAXED, __HIP_MEMORY_SCOPE_AGENT); }
__device__ __forceinline__ unsigned xb_xcc_id() { return (unsigned)__builtin_amdgcn_s_getreg((3 << 11) | 20) & 0xFu; }
#define XB_SPIN(cond, bar) do { unsigned _sp = 0; while (cond) { __builtin_amdgcn_s_sleep(1); \
    if ((++_sp & 255u) == 0u) { if (xb_ld(&(bar)[XB_TMO])) break; if (_sp > XB_SPIN_CAP) { atomicAdd(&(bar)[XB_TMO], 1u); break; } } } } while (0)
struct XcdBarrier { unsigned* bar; unsigned x; volatile LAS unsigned* st; };
__device__ __forceinline__ XcdBarrier xcd_barrier_post(unsigned* bar, volatile LAS unsigned* st) {
    XcdBarrier b; b.bar = bar; b.x = xb_xcc_id(); b.st = st;
    if (threadIdx.x == 0) (void)xb_add(&bar[XB_XCNT(b.x)], 1u);
    return b;
}
__device__ __forceinline__ void xcd_barrier_complete(unsigned* bar, unsigned x, unsigned& nloc, unsigned& nx) {
    const unsigned G = gridDim.x * gridDim.y * gridDim.z;
    unsigned sum, cnt, mine, sp = 0u;
    for (;;) {
        sum = 0u; cnt = 0u; mine = 0u;
#pragma unroll
        for (unsigned j = 0; j < 16; ++j) { const unsigned c = xb_ld(&bar[XB_XCNT(j)]); sum += c; cnt += (c > 0u) ? 1u : 0u; mine = (j == x) ? c : mine; }
        if (sum == G) break;
        __builtin_amdgcn_s_sleep(1);
        if ((++sp & 255u) == 0u) { if (xb_ld(&bar[XB_TMO])) break; if (sp > XB_SPIN_CAP) { atomicAdd(&bar[XB_TMO], 1u); break; } }
    }
    nloc = mine > 0u ? mine : 1u; nx = cnt > 0u ? cnt : 1u;
}
__device__ __attribute__((noinline)) void xcd_barrier(const XcdBarrier b) {
    asm volatile("s_waitcnt vmcnt(0)" ::: "memory");
    __syncthreads();
    if (threadIdx.x == 0) {
        unsigned* bar = b.bar;
        __builtin_amdgcn_s_waitcnt(0);
        unsigned nloc = b.st[0], nx = b.st[1];
        if (nloc == 0u) { xcd_barrier_complete(bar, b.x, nloc, nx); b.st[0] = nloc; b.st[1] = nx; }
        const unsigned old = xb_add(&bar[XB_XSUB(b.x)], 1u);
        const unsigned gen = old / nloc;
        if (old + 1u == (gen + 1u) * nloc) {
            __builtin_amdgcn_fence(__ATOMIC_RELEASE, "agent");
            asm volatile("s_waitcnt vmcnt(0)" ::: "memory");
            const unsigned og = xb_add(&bar[XB_TOP], 1u);
            const unsigned tg = og / nx;
            if (og + 1u == (tg + 1u) * nx) xb_add(&bar[XB_TOPGEN], 1u);
            else XB_SPIN(xb_ld(&bar[XB_TOPGEN]) == tg, bar);
            __builtin_amdgcn_fence(__ATOMIC_ACQUIRE, "agent");
            xb_add(&bar[XB_XGEN(b.x)], 1u);
            asm volatile("s_waitcnt vmcnt(0)" ::: "memory");
        } else {
            XB_SPIN(xb_ld(&bar[XB_XGEN(b.x)]) == gen, bar);
            __builtin_amdgcn_fence(__ATOMIC_ACQUIRE, "agent");
            asm volatile("s_waitcnt vmcnt(0)" ::: "memory");
        }
    }
    __syncthreads();
}

__device__ __attribute__((noinline)) void sub_barrier(unsigned* word, unsigned n) {
    asm volatile("s_waitcnt vmcnt(0)" ::: "memory");
    __syncthreads();
    if (threadIdx.x == 0) {
        __builtin_amdgcn_fence(__ATOMIC_RELEASE, "agent");
        asm volatile("s_waitcnt vmcnt(0)" ::: "memory");
        (void)xb_add(word, 1u);
        unsigned sp = 0;
        while (xb_ld(word) < n) { __builtin_amdgcn_s_sleep(2); if (++sp > (1u << 24)) break; }
        __builtin_amdgcn_fence(__ATOMIC_ACQUIRE, "agent");
        asm volatile("s_waitcnt vmcnt(0)" ::: "memory");
    }
    __syncthreads();
}

__global__ __launch_bounds__(512) void mega(Params p) {
    extern __shared__ __attribute__((aligned(16))) unsigned char smem[];
    cg::grid_group grid = cg::this_grid();
    LAS unsigned char* lds = (LAS unsigned char*)smem; LAS float* lf = (LAS float*)smem;
    unsigned char* ws = p.ws;
    int zo = 0; asm volatile("" : "+s"(zo));
    bf16_t* H = (bf16_t*)(ws + OFF_H); bf16_t* P = (bf16_t*)(ws + OFF_P); float* SM = (float*)(ws + OFF_SM); bf16_t* VF = (bf16_t*)(ws + OFF_VF);
    const bf16_t* zrow = (const bf16_t*)(ws + OFF_Z);
    volatile LAS unsigned* xst = (volatile LAS unsigned*)(lds + LDS_BYTES - 16);
    if (threadIdx.x == 0) { xst[0] = 0u; xst[1] = 0u; }
    __syncthreads();
    const XcdBarrier xb = xcd_barrier_post((unsigned*)(ws + OFF_BAR), xst);
    float* X = p.out;
    bf16_t* ACT = P; float* FO = (float*)(ws + OFF_P + 176 * MiB);
    const int G = (int)gridDim.x, bid = (int)blockIdx.x;
    unsigned* subw = (unsigned*)(ws + OFF_BAR) + 3584;
    if (blockIdx.x == 0) for (int i = threadIdx.x; i < 1024; i += 512) ((unsigned*)(ws + OFF_Z))[i] = 0u;
    convert_weights(p, 0, lf, 0, 1408, G, bid);
    resnorm<0>(p.in[zo + I_X], nullptr, 0, nullptr, nullptr, p.in[zo + I_NG] + 0, H);
    grid.sync();
    for (int L = 0; L < 2; ++L) {
        asm volatile("" : "+s"(zo));
        const float* ng = p.in[zo + I_NG] + (size_t)L * 4 * DM;
        const float* xin = (L == 0) ? p.in[zo + I_X] : X;
        { Epi<EPI_B1> e{}; e.o16 = P; e.o32 = SM; e.vf = (L == 0) ? VF : nullptr; e.mu = p.in[zo + I_RMU] + L * 1696; e.stp = (bf16_t*)(ws + WB_R + 7 * MiB / 2); e.sts = (float*)(ws + WB_R + 5 * MiB);
          gemm_phase<Epi<EPI_B1>, false>(lds, H, DM, (const bf16_t*)(ws + WB_R), T, 1792, 1024, e, zrow, G, bid); }
        xcd_barrier(xb);
        b1_fixup(p, L, (const bf16_t*)(ws + WB_R + 7 * MiB / 2), (const float*)(ws + WB_R + 5 * MiB));
        xcd_barrier(xb);
        {
            const int NR = 64, NO = G - NR;
            if (bid < NR) {
                for (int item = bid; item < 64; item += NR) rwkv_item_old(p, L, item, lds, false);
            } else {
                const int oc = bid - NR;
                { Epi<EPI_B2> e{}; e.o16 = P; gemm_phase<Epi<EPI_B2>, false>(lds, H, DM, (const bf16_t*)(ws + WB_2), T, 3840, 1024, e, zrow, NO, oc); }
                sub_barrier(subw + (L * 2 + 0) * 64, (unsigned)NO);
                for (int item = oc; item < 192; item += NO) {
                    if (item < 64) gla_item(p, L, item, lf, false);
                    else if (item < 128) plain_item<1>(p, L, item - 64, lf, false);
                    else lru_item(p, L, item - 128, lf, false);
                }
                sub_barrier(subw + (L * 2 + 1) * 64, (unsigned)NO);
                ssd_post(p, L, NO, oc);
                convert_weights(p, L, lf, 1408, 5312, NO, oc);
                if (L == 0) convert_weights(p, 1, lf, 0, 1408, NO, oc);
            }
        }
        xcd_barrier(xb);
        bf16_t* U = (L == 0) ? (bf16_t*)p.out : (bf16_t*)(ws + OFF_SM);
        for (int q = 0; q < 4; ++q) {
            { Epi<EPI_U> e{}; e.o16 = U; gemm_phase<Epi<EPI_U>, false>(lds, P + (size_t)q * 8192 * LDP, LDP, (const bf16_t*)(ws + WB_B), 8192, 4096, 512, e, zrow, G, bid); }
            xcd_barrier(xb);
            { Epi<EPI_MERGE> e{}; e.o16 = P + (size_t)q * 8192 * LDP; e.uq = U; gemm_phase<Epi<EPI_MERGE>, false>(lds, H + (size_t)q * 8192 * DM, DM, (const bf16_t*)(ws + WB_G), 8192, 4096, 1024, e, zrow, G, bid); }
            xcd_barrier(xb);
        }
        { Epi<EPI_O> e{}; e.o16 = P; gemm_phase<Epi<EPI_O>, false>(lds, P + PC_MERGED, LDP, (const bf16_t*)(ws + WB_O), T, 1024, 1024, e, zrow, G, bid); }
        xcd_barrier(xb);
        resnorm<1>(xin, P + PC_O, LDP, ng + DM, X, ng + 2 * DM, H);
        xcd_barrier(xb);
        { Epi<EPI_FFN> e{}; e.o16 = ACT; gemm_phase<Epi<EPI_FFN>, false>(lds, H, DM, (const bf16_t*)(ws + WB_F), T, 5632, 1024, e, zrow, G, bid); }
        xcd_barrier(xb);
        { Epi<EPI_DOWN> e{}; e.o16 = (bf16_t*)FO; gemm_phase<Epi<EPI_DOWN>, false>(lds, ACT, FH, (const bf16_t*)(ws + WB_D), T, 1024, FH, e, zrow, G, bid); }
        xcd_barrier(xb);
        if (L == 0) {
            resnorm<1>(X, FO, DM, ng + 3 * DM, X, p.in[zo + I_NG] + 4 * DM, H);
            xcd_barrier(xb);
        } else {
            resnorm<1>(X, FO, DM, ng + 3 * DM, X, nullptr, nullptr);
        }
    }
}

extern "C" void kernel_launch(void* const* d_in, const int* in_sizes, int n_in, void* d_out, int out_size, void* d_ws, size_t ws_size, hipStream_t stream) {
    static int grid_blocks = 0;
    if (grid_blocks == 0) {
        if (n_in != N_INPUTS || out_size != T * DM || ws_size < WS_END) { fprintf(stderr, "kernel_launch: unexpected problem (n_in %d, out %d, ws %zu)\n", n_in, out_size, ws_size); grid_blocks = -1; return; }
        int dev = 0, cus = 0, per_cu = 0;
        (void)hipGetDevice(&dev); (void)hipDeviceGetAttribute(&cus, hipDeviceAttributeMultiprocessorCount, dev);
        if (hipFuncSetAttribute((const void*)mega, hipFuncAttributeMaxDynamicSharedMemorySize, LDS_BYTES) != hipSuccess) { fprintf(stderr, "kernel_launch: hipFuncSetAttribute failed\n"); grid_blocks = -1; return; }
        if (hipOccupancyMaxActiveBlocksPerMultiprocessor(&per_cu, (const void*)mega, 512, LDS_BYTES) != hipSuccess || per_cu < 1) { fprintf(stderr, "kernel_launch: occupancy query says %d\n", per_cu); per_cu = 1; }
        (void)hipGetLastError();
        grid_blocks = cus * 1;
        if (grid_blocks < 128) { fprintf(stderr, "kernel_launch: needs at least 128 CUs\n"); grid_blocks = -1; return; }
    }
    if (grid_blocks < 0) return;
    if (hipMemsetAsync((char*)d_ws + OFF_BAR, 0, 4096 * 4, stream) != hipSuccess) { fprintf(stderr, "kernel_launch: memset failed\n"); return; }
    Params p{};
    for (int i = 0; i < N_INPUTS; ++i) p.in[i] = (const float*)d_in[i];
    p.out = (float*)d_out; p.ws = (unsigned char*)d_ws;
    void* args[] = {&p};
    hipError_t e = hipLaunchCooperativeKernel((const void*)mega, dim3(grid_blocks), dim3(512), args, LDS_BYTES, stream);
    if (e != hipSuccess) fprintf(stderr, "cooperative launch failed: %s (grid %d)\n", hipGetErrorString(e), grid_blocks);
}
```

```cpp
#include <hip/hip_runtime.h>
#include <hip/hip_cooperative_groups.h>
#include <cstdio>
namespace cg = cooperative_groups;

#define LAS __attribute__((address_space(3)))
typedef unsigned short bf16_t;
typedef short bf16x8 __attribute__((ext_vector_type(8)));
typedef float f32x4 __attribute__((ext_vector_type(4)));
typedef unsigned u32x4 __attribute__((ext_vector_type(4)));
typedef unsigned u32x2 __attribute__((ext_vector_type(2)));

constexpr int NB = 8, SEQ = 4096, T = NB * SEQ, DM = 1024, NIN = 9656, FH = 2816, LDP = 5376;
constexpr int BM = 256, BK = 64, HALF = 128, HTB = HALF * BK * 2, STAGE_BYTES = 8 * HTB, NXCD = 8, WGM = 8;
constexpr int LDS_BYTES = 144 * 1024;
constexpr bool DRY_SKIP_SCAN = false;
constexpr bool GLA_SPLIT = true;
constexpr int DRY_MASK = 15;
constexpr int REP_GEMM = 1, REP_SCAN = 0, REP_SYNC = 1, REP_CONV = 1, REP_NORM = 1;
constexpr size_t MiB = 1u << 20;
constexpr size_t WB_R = 0, WB_2 = 7 * MiB, WB_G = WB_2 + 15 * MiB / 2, WB_B = WB_G + 8 * MiB, WB_O = WB_B + 4 * MiB, WB_F = WB_O + 2 * MiB, WB_D = WB_F + 11 * MiB;
constexpr size_t OFF_Z = 45 * MiB, OFF_H = 46 * MiB, OFF_P = 110 * MiB, OFF_SM = 446 * MiB, OFF_VF = 478 * MiB, OFF_BAR = 510 * MiB, OFF_BON = 510 * MiB + 65536, WS_END = OFF_BON + MiB;
constexpr int PC_Z = 0, PC_XBC = 512, PC_GQ = 1280, PC_GK = 1536, PC_GV = 1792, PC_GR = 2304, PC_LX = 2816, PC_LG = 3328, PC_RR = 3840, PC_RK = 4352, PC_RV = 4864;
constexpr int PC_MERGED = 1280, PC_O = 4352;

enum { I_X = 0, I_NG, I_WIN, I_WVRES, I_SCW, I_SCB, I_SDTB, I_SALOG, I_SD, I_SNG, I_GAW, I_GAB, I_GNG, I_LCW, I_LCB, I_LWA, I_LBA, I_LWX, I_LBX, I_LLAM,
       I_RMU, I_RW0, I_RWW2, I_RA0, I_RAW2, I_RV0, I_RVW2, I_RGW2, I_RKK, I_RKA, I_RRK, I_RLNG, I_RLNB, I_WBR, I_WOUT, I_FG, I_FU, I_FD, N_INPUTS };

struct Params { const float* in[N_INPUTS]; float* out; unsigned char* ws; };

__device__ __forceinline__ unsigned cvt_pk_bf16(float lo, float hi) { unsigned r; asm volatile("v_cvt_pk_bf16_f32 %0, %1, %2" : "=v"(r) : "v"(lo), "v"(hi)); return r; }
__device__ __forceinline__ float bf2f(bf16_t v) { return __uint_as_float((unsigned)v << 16); }
__device__ __forceinline__ float bflo(unsigned v) { return __uint_as_float(v << 16); }
__device__ __forceinline__ float bfhi(unsigned v) { return __uint_as_float(v & 0xffff0000u); }
__device__ __forceinline__ bf16_t f2bf(float v) { return (bf16_t)(cvt_pk_bf16(v, 0.f) & 0xffffu); }
__device__ __forceinline__ float sigmoidf_(float x) { return __builtin_amdgcn_rcpf(1.0f + __expf(-x)); }
__device__ __forceinline__ float siluf_(float x) { return x * sigmoidf_(x); }
__device__ __forceinline__ float softplusf_(float x) { return fmaxf(x, 0.f) + log1pf(__expf(-fabsf(x))); }
template <int CTRL> __device__ __forceinline__ float dpp_add(float x) { int v = __builtin_amdgcn_update_dpp(0, __float_as_int(x), CTRL, 0xF, 0xF, true); return x + __int_as_float(v); }
__device__ __forceinline__ float red4(float x) { x = dpp_add<0xB1>(x); x = dpp_add<0x4E>(x); return x; }
__device__ __forceinline__ float red8(float x) { x = red4(x); x = dpp_add<0x141>(x); return x; }
__device__ __forceinline__ float red16(float x) { x = red8(x); x = dpp_add<0x140>(x); return x; }
__device__ __forceinline__ float red32(float x) { x = red16(x); x += __shfl_xor(x, 16); return x; }
__device__ __forceinline__ float red64(float x) { x = red32(x); x += __shfl_xor(x, 32); return x; }
template <int N> __device__ __forceinline__ void red64n(float (&v)[N]) {
#pragma unroll
    for (int i = 0; i < N; ++i) v[i] = red16(v[i]);
    float t[N];
#pragma unroll
    for (int i = 0; i < N; ++i) t[i] = __shfl_xor(v[i], 16);
#pragma unroll
    for (int i = 0; i < N; ++i) v[i] += t[i];
#pragma unroll
    for (int i = 0; i < N; ++i) t[i] = __shfl_xor(v[i], 32);
#pragma unroll
    for (int i = 0; i < N; ++i) v[i] += t[i];
}

__device__ __forceinline__ int lds_byte(int r, int c) { const int st = (r >> 4) * 2 + (c >> 5), rr = r & 15, cc = c & 31, ob = rr * 64 + cc * 2; return st * 1024 + (ob ^ (((ob >> 9) & 1) << 5)); }
__device__ __forceinline__ void stage_rc(int b, int& R, int& C) { const int st = b / 1024, sb = b % 1024, swz = sb ^ (((sb >> 9) & 1) << 5); R = (st >> 1) * 16 + swz / 64; C = (st & 1) * 32 + (swz % 64) / 2; }
__device__ __forceinline__ int perm32(int rho) { const int n = rho >> 4, i = rho & 15; return 8 * (i >> 2) + 4 * n + (i & 3); }
struct Unit { int pm, pn; };
struct Order {
    int nM, nN, nwg, G, c;
    __device__ void init(int M, int N, int G_, int c_) { nM = M / BM; nN = N / BM; nwg = nM * nN; G = G_; c = c_; }
    __device__ bool next(int i, Unit& u) const {
        const long L = (long)i * G + c; if (L >= nwg) return false;
        int wgid = (int)L; { const int q = nwg / NXCD, r = nwg % NXCD, xcd = wgid % NXCD, off = wgid / NXCD; wgid = (xcd < r ? xcd * (q + 1) : r * (q + 1) + (xcd - r) * q) + off; }
        const int nig = WGM * nN, gid = wgid / nig, fm = gid * WGM, gsz = (nM - fm) < WGM ? (nM - fm) : WGM;
        u.pm = fm + ((wgid % nig) % gsz); u.pn = (wgid % nig) / gsz; return true;
    }
};

enum { EPI_B2 = 0, EPI_B1, EPI_U, EPI_MERGE, EPI_O, EPI_FFN, EPI_DOWN };
template <int MODE> struct Epi {
    static constexpr bool PERM = (MODE != EPI_MERGE);
    bf16_t* o16; float* o32; const bf16_t* uq; bf16_t* vf; const float* mu; bf16_t* stp; float* sts;
    __device__ __forceinline__ int a_col(int pn) const { if (MODE == EPI_U) { const int k = pn >> 2; return k == 0 ? PC_Z : (k == 1 ? PC_GR : (k == 2 ? PC_LG : PC_RR)); } return 0; }
    __device__ __forceinline__ void operator()(const f32x4 (&acc)[2][2][4][2], const Unit& u, int wr, int wc, int fr, int fq) const {
        const int row0 = u.pm * BM + wr * 64 + fr;
        if constexpr (MODE == EPI_B1) {
            const bool small = (u.pn == 6);
#pragma unroll
            for (int bj = 0; bj < 2; ++bj) {
                const int cb = u.pn * BM + bj * HALF + wc * 32 + 8 * fq;
                float mu8[8];
#pragma unroll
                for (int e = 0; e < 8; ++e) { const int sc = cb + e - 1536; mu8[e] = !small ? mu[cb + e] : ((sc >= 64 && sc < 224) ? mu[1536 + sc - 64] : 0.f); }
#pragma unroll
                for (int ai = 0; ai < 2; ++ai)
#pragma unroll
                    for (int m = 0; m < 4; ++m) { const size_t r = (size_t)(row0 + ai * HALF + m * 16); float o[8], raw[8];
#pragma unroll
                        for (int e = 0; e < 8; ++e) { const float cur = acc[ai][bj][m][e >> 2][e & 3]; raw[e] = cur;
                            const float p1 = __int_as_float(__builtin_amdgcn_update_dpp(0, __float_as_int(cur), 0x111, 0xF, 0xF, true));
                            float p0 = 0.f; if (m > 0) p0 = __int_as_float(__builtin_amdgcn_update_dpp(0, __float_as_int(acc[ai][bj][m > 0 ? m - 1 : 0][e >> 2][e & 3]), 0x121, 0xF, 0xF, true));
                            const float prev = (fr == 0) ? p0 : p1, lerp = cur + (prev - cur) * mu8[e];
                            o[e] = (fr == 0 && m == 0) ? cur : lerp; }
                        if (small) { float* rp = o32 + r * 256 + (cb - 1536); *(f32x4*)rp = (f32x4){o[0], o[1], o[2], o[3]}; *(f32x4*)(rp + 4) = (f32x4){o[4], o[5], o[6], o[7]}; }
                        else { u32x4 w; w.x = cvt_pk_bf16(o[0], o[1]); w.y = cvt_pk_bf16(o[2], o[3]); w.z = cvt_pk_bf16(o[4], o[5]); w.w = cvt_pk_bf16(o[6], o[7]);
                            *(u32x4*)(o16 + r * LDP + PC_RR + cb) = w; if (vf != nullptr && u.pn >= 4) *(u32x4*)(vf + r * 512 + (cb - 1024)) = w; }
                        if (m == 3 && fr == 15) { const size_t g = r >> 6;
                            if (small) { float* sp = sts + g * 256 + (cb - 1536); *(f32x4*)sp = (f32x4){raw[0], raw[1], raw[2], raw[3]}; *(f32x4*)(sp + 4) = (f32x4){raw[4], raw[5], raw[6], raw[7]}; }
                            else { u32x4 w; w.x = cvt_pk_bf16(raw[0], raw[1]); w.y = cvt_pk_bf16(raw[2], raw[3]); w.z = cvt_pk_bf16(raw[4], raw[5]); w.w = cvt_pk_bf16(raw[6], raw[7]); *(u32x4*)(stp + g * 1536 + cb) = w; } } }
            }
        } else if constexpr (MODE == EPI_B2 || MODE == EPI_O || MODE == EPI_U || MODE == EPI_DOWN) {
            const int ct = wc * 32 + 8 * fq;
            if (MODE == EPI_B1 && u.pn == 6) {
#pragma unroll
                for (int ai = 0; ai < 2; ++ai)
#pragma unroll
                    for (int m = 0; m < 4; ++m) { float* rowp = o32 + (size_t)(row0 + ai * HALF + m * 16) * 256 + ct;
#pragma unroll
                        for (int bj = 0; bj < 2; ++bj) { *(f32x4*)(rowp + bj * HALF) = acc[ai][bj][m][0]; *(f32x4*)(rowp + bj * HALF + 4) = acc[ai][bj][m][1]; } }
                return;
            }
            const int ld = (MODE == EPI_U) ? 4096 : (MODE == EPI_DOWN ? DM : LDP);
            const int colbase = (MODE == EPI_B2) ? 0 : (MODE == EPI_B1 ? PC_RR : (MODE == EPI_O ? PC_O : 0));
            const int col0 = colbase + u.pn * BM + ct;
            const bool dovf = (MODE == EPI_B1) && vf != nullptr && u.pn >= 4;
#pragma unroll
            for (int ai = 0; ai < 2; ++ai)
#pragma unroll
                for (int m = 0; m < 4; ++m) { const size_t r = (size_t)(row0 + ai * HALF + m * 16); bf16_t* rowp = o16 + r * ld + col0;
#pragma unroll
                    for (int bj = 0; bj < 2; ++bj) { const f32x4 v0 = acc[ai][bj][m][0], v1 = acc[ai][bj][m][1];
                        u32x4 w; w.x = cvt_pk_bf16(v0[0], v0[1]); w.y = cvt_pk_bf16(v0[2], v0[3]); w.z = cvt_pk_bf16(v1[0], v1[1]); w.w = cvt_pk_bf16(v1[2], v1[3]);
                        *(u32x4*)(rowp + bj * HALF) = w;
                        if (MODE == EPI_B1) { if (dovf) *(u32x4*)(vf + r * 512 + (u.pn - 4) * BM + ct + bj * HALF) = w; } } }
        } else if constexpr (MODE == EPI_FFN) {
            const int hc0 = u.pn * HALF + wc * 32 + 8 * fq;
#pragma unroll
            for (int ai = 0; ai < 2; ++ai)
#pragma unroll
                for (int m = 0; m < 4; ++m) { bf16_t* rowp = o16 + (size_t)(row0 + ai * HALF + m * 16) * FH + hc0; float a[8];
#pragma unroll
                    for (int n = 0; n < 2; ++n)
#pragma unroll
                        for (int j = 0; j < 4; ++j) a[n * 4 + j] = siluf_(acc[ai][0][m][n][j]) * acc[ai][1][m][n][j];
                    u32x4 w; w.x = cvt_pk_bf16(a[0], a[1]); w.y = cvt_pk_bf16(a[2], a[3]); w.z = cvt_pk_bf16(a[4], a[5]); w.w = cvt_pk_bf16(a[6], a[7]);
                    *(u32x4*)rowp = w; }
        } else {
            const int d0 = u.pn * 64 + wc * 16 + 4 * fq;
#pragma unroll
            for (int ai = 0; ai < 2; ++ai)
#pragma unroll
                for (int m = 0; m < 4; ++m) { const size_t r = (size_t)(row0 + ai * HALF + m * 16); const bf16_t* up = uq + r * 4096 + d0; float s[4] = {0.f, 0.f, 0.f, 0.f};
#pragma unroll
                    for (int bj = 0; bj < 2; ++bj)
#pragma unroll
                        for (int n = 0; n < 2; ++n) { const u32x2 uu = *(const u32x2*)(up + (2 * bj + n) * 1024); const f32x4 g = acc[ai][bj][m][n];
                            s[0] += sigmoidf_(g[0]) * bflo(uu.x); s[1] += sigmoidf_(g[1]) * bfhi(uu.x); s[2] += sigmoidf_(g[2]) * bflo(uu.y); s[3] += sigmoidf_(g[3]) * bfhi(uu.y); }
                    u32x2 w; w.x = cvt_pk_bf16(s[0], s[1]); w.y = cvt_pk_bf16(s[2], s[3]);
                    *(u32x2*)(o16 + r * LDP + PC_MERGED + d0) = w; }
        }
    }
};

template <class EpiT, bool SHIFT>
__device__ __forceinline__ void gemm_phase(LAS unsigned char* lds, const bf16_t* A, int lda, const bf16_t* Bt, int M, int N, int K, const EpiT& E, const bf16_t* zrow, int ordG, int ordC) {
    int tid_ = threadIdx.x; asm volatile("" : "+v"(tid_));
    const int tid = tid_, wid = __builtin_amdgcn_readfirstlane(tid >> 6), lane = tid & 63, wr = wid >> 2, wc = wid & 3, fr = lane & 15, fq = lane >> 4;
    const int nt = K / BK;
    Order S; S.init(M, N, ordG, ordC);
    unsigned voffA[2], voffB[2]; bool z0[2];
#pragma unroll
    for (int i = 0; i < 2; ++i) { int R, C; stage_rc(tid * 16 + i * 8192, R, C); const int Rb = EpiT::PERM ? ((R & ~31) + perm32(R & 31)) : R;
        voffA[i] = (unsigned)(R * lda + C) * 2u; voffB[i] = (unsigned)(Rb * K + C) * 2u; z0[i] = (R == 0); }
    const size_t kstep = (size_t)(BK * 2);
    const size_t hstepA = (size_t)HALF * lda * 2, tstepA = 2 * hstepA, hstepB = (size_t)HALF * K * 2, tstepB = 2 * hstepB;
    const size_t shiftsub = (size_t)lda * 2 + (size_t)K;
    const unsigned ldsw = (unsigned)wid * 1024u;
    const int aoff = lds_byte(wr * 64 + fr, fq * 8), boff = lds_byte(wc * 32 + fr, fq * 8);
#define PG8_SA(b, h) (((b) * 2 + (h)) * HTB)
#define PG8_SB(b, h) ((4 + (b) * 2 + (h)) * HTB)
#define PG8_STAGEB(bufoff, gbase) do { _Pragma("unroll") for (int _i = 0; _i < 2; ++_i) \
        __builtin_amdgcn_global_load_lds((const unsigned*)((const char*)(gbase) + voffB[_i]), (LAS unsigned*)(lds + (bufoff) + ldsw + _i * 8192), 16, 0, 0); } while (0)
#define PG8_STAGEA(bufoff, gbase, zf) do { _Pragma("unroll") for (int _i = 0; _i < 2; ++_i) { const char* _p = (const char*)(gbase) + voffA[_i]; \
        if (SHIFT) { if ((zf) && z0[_i]) _p = (const char*)zrow + lane * 16; } \
        __builtin_amdgcn_global_load_lds((const unsigned*)_p, (LAS unsigned*)(lds + (bufoff) + ldsw + _i * 8192), 16, 0, 0); } } while (0)
#define PG8_LDA(dst, b, h) do { _Pragma("unroll") for (int m = 0; m < 4; ++m) _Pragma("unroll") for (int k = 0; k < 2; ++k) dst[m][k] = *(const LAS bf16x8*)(lds + PG8_SA(b, h) + aoff + m * 2048 + k * 1024); } while (0)
#define PG8_LDB(dst, b, h) do { _Pragma("unroll") for (int n = 0; n < 2; ++n) _Pragma("unroll") for (int k = 0; k < 2; ++k) dst[n][k] = *(const LAS bf16x8*)(lds + PG8_SB(b, h) + boff + n * 2048 + k * 1024); } while (0)
#define PG8_MMA(ai, bj, At, Bt_) do { __builtin_amdgcn_s_setprio(1); _Pragma("unroll") for (int m = 0; m < 4; ++m) _Pragma("unroll") for (int n = 0; n < 2; ++n) _Pragma("unroll") for (int k = 0; k < 2; ++k) \
        acc[ai][bj][m][n] = __builtin_amdgcn_mfma_f32_16x16x32_bf16(Bt_[n][k], At[m][k], acc[ai][bj][m][n], 0, 0, 0); __builtin_amdgcn_s_setprio(0); } while (0)
#define PG8_WAIT_V(n) asm volatile("s_waitcnt vmcnt(" #n ")" ::: "memory")
#define PG8_WAIT_L(n) asm volatile("s_waitcnt lgkmcnt(" #n ")" ::: "memory")
#define PG8_BAR __builtin_amdgcn_s_barrier()
#define PG8_SCHED __builtin_amdgcn_sched_barrier(0)
#define PG8_AOFF(tau) ((size_t)(tau) * kstep - ((SHIFT && (tau) >= nt / 2) ? shiftsub : (size_t)0))
    Unit cur, nxt; int ui = 0;
    if (!S.next(0, cur)) return;
    f32x4 acc[2][2][4][2];
#pragma unroll
    for (int a = 0; a < 2; ++a)
#pragma unroll
        for (int b = 0; b < 2; ++b)
#pragma unroll
            for (int m = 0; m < 4; ++m)
#pragma unroll
                for (int n = 0; n < 2; ++n) acc[a][b][m][n] = (f32x4){0.f, 0.f, 0.f, 0.f};
    bf16x8 At[4][2], B0[2][2], B1[2][2];
    const char* cA = (const char*)(A + E.a_col(cur.pn)) + (size_t)cur.pm * tstepA; const char* cB = (const char*)Bt + (size_t)cur.pn * tstepB;
    PG8_STAGEB(PG8_SB(0, 0), cB); PG8_STAGEA(PG8_SA(0, 0), cA, false); PG8_STAGEB(PG8_SB(0, 1), cB + hstepB); PG8_STAGEA(PG8_SA(0, 1), cA + hstepA, false);
    if (wr == 1) PG8_BAR;
    PG8_WAIT_V(4); PG8_BAR;
    PG8_STAGEB(PG8_SB(1, 0), cB + kstep); PG8_STAGEA(PG8_SA(1, 0), cA + kstep, false); PG8_STAGEB(PG8_SB(1, 1), cB + hstepB + kstep);
    PG8_WAIT_V(6); PG8_BAR;
    for (;;) {
        const bool has_next = S.next(ui + 1, nxt);
        const char* nA = has_next ? (const char*)(A + E.a_col(nxt.pn)) + (size_t)nxt.pm * tstepA : cA; const char* nB = has_next ? (const char*)Bt + (size_t)nxt.pn * tstepB : cB;
        const bool seq0 = SHIFT && ((cur.pm & 15) == 0);
        for (int t = 0; t < nt; t += 2) {
            const bool last = (t == nt - 2);
            const char* a1 = cA + PG8_AOFF(t + 1);
            const char* a2 = last ? nA : cA + PG8_AOFF(t + 2); const char* b2 = last ? nB : cB + (size_t)(t + 2) * kstep;
            const char* a3 = a2 + kstep; const char* b3 = b2 + kstep;
            const bool zf = seq0 && !last && (t + 2 >= nt / 2);
            PG8_LDB(B0, 0, 0); PG8_SCHED; PG8_LDA(At, 0, 0); PG8_STAGEA(PG8_SA(1, 1), a1 + hstepA, false);
            PG8_WAIT_L(8); PG8_BAR; PG8_WAIT_L(0); PG8_MMA(0, 0, At, B0); PG8_BAR; PG8_SCHED;
            PG8_LDB(B1, 0, 1); PG8_STAGEB(PG8_SB(0, 0), b2);
            PG8_BAR; PG8_WAIT_L(0); PG8_MMA(0, 1, At, B1); PG8_BAR;
            PG8_LDA(At, 0, 1); PG8_STAGEA(PG8_SA(0, 0), a2, zf);
            PG8_BAR; PG8_WAIT_L(0); PG8_MMA(1, 0, At, B0); PG8_BAR; PG8_SCHED;
            PG8_STAGEB(PG8_SB(0, 1), b2 + hstepB);
            PG8_WAIT_V(6); PG8_BAR; PG8_MMA(1, 1, At, B1); PG8_BAR;
            PG8_LDB(B0, 1, 0); PG8_SCHED; PG8_LDA(At, 1, 0); PG8_STAGEA(PG8_SA(0, 1), a2 + hstepA, false);
            PG8_WAIT_L(8); PG8_BAR; PG8_WAIT_L(0); PG8_MMA(0, 0, At, B0); PG8_BAR; PG8_SCHED;
            PG8_LDB(B1, 1, 1); PG8_STAGEB(PG8_SB(1, 0), b3);
            PG8_BAR; PG8_WAIT_L(0); PG8_MMA(0, 1, At, B1); PG8_BAR;
            PG8_LDA(At, 1, 1); PG8_STAGEA(PG8_SA(1, 0), a3, zf);
            PG8_BAR; PG8_WAIT_L(0); PG8_MMA(1, 0, At, B0); PG8_BAR; PG8_SCHED;
            PG8_STAGEB(PG8_SB(1, 1), b3 + hstepB);
            PG8_WAIT_V(6); PG8_BAR; PG8_MMA(1, 1, At, B1); PG8_BAR;
        }
        E(acc, cur, wr, wc, fr, fq);
        if (!has_next) break;
#pragma unroll
        for (int a = 0; a < 2; ++a)
#pragma unroll
            for (int b = 0; b < 2; ++b)
#pragma unroll
                for (int m = 0; m < 4; ++m)
#pragma unroll
                    for (int n = 0; n < 2; ++n) acc[a][b][m][n] = (f32x4){0.f, 0.f, 0.f, 0.f};
        cur = nxt; cA = nA; cB = nB; ++ui;
    }
    PG8_WAIT_V(0);
    if (wr == 0) PG8_BAR;
    PG8_BAR;
#undef PG8_SA
#undef PG8_SB
#undef PG8_STAGEA
#undef PG8_STAGEB
#undef PG8_LDA
#undef PG8_LDB
#undef PG8_MMA
#undef PG8_WAIT_V
#undef PG8_WAIT_L
#undef PG8_BAR
#undef PG8_SCHED
#undef PG8_AOFF
}

__device__ __forceinline__ float wval(const Params& p, int zo, int L, int spec, int n, int k) {
    const float* win = p.in[zo + I_WIN] + (size_t)L * DM * NIN;
    if (spec == 0) {
        if (n < 1536) return win[(size_t)k * NIN + 3864 + n];
        const int s = n - 1536;
        if (s < 8) return win[(size_t)k * NIN + 1280 + s];
        if (s < 24) return win[(size_t)k * NIN + 2824 + (s - 8)];
        if (s < 56) return (L == 0) ? 0.f : p.in[zo + I_WVRES][((size_t)(L - 1) * DM + k) * 32 + (s - 24)];
        if (s < 64) return 0.f;
        if (s < 224) return win[(size_t)k * NIN + 5400 + (s - 64)];
        return 0.f;
    } else if (spec == 1) {
        const int col = n < 1280 ? n : (n < 2816 ? n + 8 : n + 24); return win[(size_t)k * NIN + col];
    } else if (spec == 2) {
        const int pn = n >> 8, ct = n & 255, bj = ct >> 7, wc = (ct >> 5) & 3, nn = (ct >> 4) & 1, r16 = ct & 15;
        return win[(size_t)k * NIN + 5560 + (2 * bj + nn) * 1024 + pn * 64 + wc * 16 + r16];
    } else if (spec == 3) {
        const int kb = n >> 10, d = n & 1023; return p.in[zo + I_WBR][(((size_t)L * 4 + kb) * 512 + k) * 1024 + d];
    } else if (spec == 4) {
        return p.in[zo + I_WOUT][((size_t)L * 1024 + k) * 1024 + n];
    } else if (spec == 5) {
        const int pn = n >> 8, ct = n & 255;
        return ct < 128 ? p.in[zo + I_FG][((size_t)L * 1024 + k) * FH + pn * 128 + ct] : p.in[zo + I_FU][((size_t)L * 1024 + k) * FH + pn * 128 + ct - 128];
    } else {
        return p.in[zo + I_FD][((size_t)L * FH + k) * 1024 + n];
    }
}
__device__ void convert_weights(const Params& p, int L, LAS float* lf, int tile0, int tile1, int ordG, int ordC) {
    int zo = 0; asm volatile("" : "+s"(zo));
    int tid_ = threadIdx.x; asm volatile("" : "+v"(tid_));
    const int tid = tid_;
    for (int tile = tile0 + ordC; tile < tile1; tile += ordG) {
        int spec, tl = tile, ktiles; size_t dofs; int K;
        if (tl < 448) { spec = 0; ktiles = 16; dofs = WB_R; K = 1024; }
        else if ((tl -= 448) < 960) { spec = 1; ktiles = 16; dofs = WB_2; K = 1024; }
        else if ((tl -= 960) < 1024) { spec = 2; ktiles = 16; dofs = WB_G; K = 1024; }
        else if ((tl -= 1024) < 512) { spec = 3; ktiles = 8; dofs = WB_B; K = 512; }
        else if ((tl -= 512) < 256) { spec = 4; ktiles = 16; dofs = WB_O; K = 1024; }
        else if ((tl -= 256) < 1408) { spec = 5; ktiles = 16; dofs = WB_F; K = 1024; }
        else { tl -= 1408; spec = 6; ktiles = 44; dofs = WB_D; K = FH; }
        const int n0 = (tl / ktiles) * 64, k0 = (tl % ktiles) * 64;
        bf16_t* dst = (bf16_t*)(p.ws + dofs);
#pragma unroll
        for (int i = 0; i < 8; ++i) { const int idx = tid + i * 512, kk = idx >> 6, nn = idx & 63; lf[kk * 65 + nn] = wval(p, zo, L, spec, n0 + nn, k0 + kk); }
        __syncthreads();
#pragma unroll
        for (int i = 0; i < 4; ++i) { const int idx = tid + i * 512, nn = idx >> 5, k2 = (idx & 31) * 2;
            *(unsigned*)(dst + (size_t)(n0 + nn) * K + k0 + k2) = cvt_pk_bf16(lf[k2 * 65 + nn], lf[(k2 + 1) * 65 + nn]); }
        __syncthreads();
    }
}

template <int DT>
__device__ void resnorm(const float* xin, const void* delta, int ldd, const float* gd, float* xout, const float* gn, bf16_t* H) {
    int tid_ = threadIdx.x; asm volatile("" : "+v"(tid_));
    const int wid = tid_ >> 6, lane = tid_ & 63;
    const int stride = gridDim.x * 8;
    int row = blockIdx.x * 8 + wid;
    f32x4 gdv[4], gnv[4];
#pragma unroll
    for (int j = 0; j < 4; ++j) { gdv[j] = (DT != 0) ? *(const f32x4*)(gd + (j * 64 + lane) * 4) : (f32x4){0.f, 0.f, 0.f, 0.f}; gnv[j] = gn ? *(const f32x4*)(gn + (j * 64 + lane) * 4) : (f32x4){0.f, 0.f, 0.f, 0.f}; }
    f32x4 nx[4], nd[4]; u32x2 nb[4];
#define RN_LOAD(r_) do { _Pragma("unroll") for (int j = 0; j < 4; ++j) { nx[j] = *(const f32x4*)(xin + (size_t)(r_) * DM + (j * 64 + lane) * 4); \
        if (DT == 1) nb[j] = *(const u32x2*)((const bf16_t*)delta + (size_t)(r_) * ldd + (j * 64 + lane) * 4); \
        if (DT == 2) nd[j] = *(const f32x4*)((const float*)delta + (size_t)(r_) * ldd + (j * 64 + lane) * 4); } } while (0)
    if (row < T) RN_LOAD(row);
    while (row < T) {
        f32x4 xv[4], dv[4];
#pragma unroll
        for (int j = 0; j < 4; ++j) { xv[j] = nx[j]; if (DT == 1) dv[j] = (f32x4){bflo(nb[j].x), bfhi(nb[j].x), bflo(nb[j].y), bfhi(nb[j].y)}; if (DT == 2) dv[j] = nd[j]; }
        const int nrow = row + stride;
        if (nrow < T) RN_LOAD(nrow);
        if (DT != 0) {
            float ss = 0.f;
#pragma unroll
            for (int j = 0; j < 4; ++j) ss += dv[j][0] * dv[j][0] + dv[j][1] * dv[j][1] + dv[j][2] * dv[j][2] + dv[j][3] * dv[j][3];
            ss = red64(ss); const float rstd = rsqrtf(ss * (1.0f / DM) + 1e-6f);
#pragma unroll
            for (int j = 0; j < 4; ++j) xv[j] += dv[j] * rstd * gdv[j];
        }
        if (xout) {
#pragma unroll
            for (int j = 0; j < 4; ++j) *(f32x4*)(xout + (size_t)row * DM + (j * 64 + lane) * 4) = xv[j];
        }
        if (gn) {
            float ss = 0.f;
#pragma unroll
            for (int j = 0; j < 4; ++j) ss += xv[j][0] * xv[j][0] + xv[j][1] * xv[j][1] + xv[j][2] * xv[j][2] + xv[j][3] * xv[j][3];
            ss = red64(ss); const float rstd = rsqrtf(ss * (1.0f / DM) + 1e-6f);
#pragma unroll
            for (int j = 0; j < 4; ++j) { const f32x4 h = xv[j] * rstd * gnv[j];
                u32x2 w; w.x = cvt_pk_bf16(h[0], h[1]); w.y = cvt_pk_bf16(h[2], h[3]); *(u32x2*)(H + (size_t)row * DM + (j * 64 + lane) * 4) = w; }
        }
        row = nrow;
    }
#undef RN_LOAD
}

constexpr int TC = 32;
typedef float f32x2 __attribute__((ext_vector_type(2)));
template <int NE, bool RW> struct StepOps { f32x4 w[NE / 4], k[NE / 4], r[NE / 4], a[RW ? NE / 4 : 1], b[RW ? NE / 4 : 1]; float v; };
template <int NE, bool RW>
__device__ __forceinline__ void step_load(StepOps<NE, RW>& o, const LAS float* base, const LAS float* opV, int vo) {
#pragma unroll
    for (int e = 0; e < NE / 4; ++e) { o.w[e] = *(const LAS f32x4*)(base + 4 * e); o.k[e] = *(const LAS f32x4*)(base + 2048 + 4 * e); o.r[e] = *(const LAS f32x4*)(base + 4096 + 4 * e);
        if (RW) { o.a[e] = *(const LAS f32x4*)(base + 6144 + 4 * e); o.b[e] = *(const LAS f32x4*)(base + 8192 + 4 * e); } }
    o.v = opV[vo];
}
#define LO2(q) ((f32x2){(q)[0], (q)[1]})
#define HI2(q) ((f32x2){(q)[2], (q)[3]})
template <int LPR, bool RW>
__device__ __forceinline__ float step_compute(f32x2 (&s)[32 / LPR], const StepOps<64 / LPR, RW>& o) {
    constexpr int NE = 64 / LPR;
    f32x2 tk[NE / 2];
    const f32x2 v2 = (f32x2){o.v, o.v};
#pragma unroll
    for (int e = 0; e < NE / 4; ++e) { tk[2 * e] = LO2(o.k[e]) * v2; tk[2 * e + 1] = HI2(o.k[e]) * v2; }
    if (RW) {
        f32x2 sa2 = (f32x2){0.f, 0.f}, sb2 = (f32x2){0.f, 0.f};
#pragma unroll
        for (int e = 0; e < NE / 4; ++e) { sa2 += s[2 * e] * LO2(o.a[e]); sb2 += s[2 * e + 1] * HI2(o.a[e]); }
        sa2 += sb2; float sa = sa2[0] + sa2[1]; sa = (LPR == 8) ? red8(sa) : red4(sa);
        const f32x2 sv = (f32x2){sa, sa};
#pragma unroll
        for (int e = 0; e < NE / 4; ++e) { tk[2 * e] += LO2(o.b[e]) * sv; tk[2 * e + 1] += HI2(o.b[e]) * sv; }
    }
    f32x2 y2 = (f32x2){0.f, 0.f}, z2 = (f32x2){0.f, 0.f};
#pragma unroll
    for (int e = 0; e < NE / 4; ++e) { s[2 * e] = s[2 * e] * LO2(o.w[e]) + tk[2 * e]; s[2 * e + 1] = s[2 * e + 1] * HI2(o.w[e]) + tk[2 * e + 1];
        y2 += s[2 * e] * LO2(o.r[e]); z2 += s[2 * e + 1] * HI2(o.r[e]); }
    y2 += z2; float y = y2[0] + y2[1]; y = (LPR == 8) ? red8(y) : red4(y);
    return y;
}
template <int LPR, bool RW>
__device__ __forceinline__ void scan_chunk(f32x2 (&s)[32 / LPR], const LAS float* opW, const LAS float* opK, const LAS float* opR, const LAS float* opA, const LAS float* opB,
                                           const LAS float* opV, LAS float* Y, int vstride, int row, int sub) {
    constexpr int NE = 64 / LPR;
    StepOps<NE, RW> o0, o1;
    unsigned bt = (unsigned)(size_t)(opW + sub * NE), bv = (unsigned)(size_t)(opV + row);
    step_load<NE, RW>(o0, (const LAS float*)(size_t)bt, (const LAS float*)(size_t)bv, 0);
#pragma unroll 1
    for (int t = 0; t < TC; t += 2) {
        asm volatile("" : "+v"(bt), "+v"(bv));
        const LAS float* b0 = (const LAS float*)(size_t)bt; const LAS float* v0 = (const LAS float*)(size_t)bv;
        step_load<NE, RW>(o1, b0 + 64, v0, vstride);
        const float y0 = step_compute<LPR, RW>(s, o0);
        step_load<NE, RW>(o0, b0 + 128, v0, 2 * vstride);
        const float y1 = step_compute<LPR, RW>(s, o1);
        if (sub == 0) { Y[t * vstride + row] = y0; Y[(t + 1) * vstride + row] = y1; }
        bt += 512; bv += 8 * vstride;
    }
}

__device__ void rwkv_item_old(const Params& p, int L, int item, LAS unsigned char* lds, bool dry) {
    int zo = 0; asm volatile("" : "+s"(zo));
    int tid_ = threadIdx.x; asm volatile("" : "+v"(tid_));
    const int b = item >> 3, h = item & 7, tid = tid_, wv = tid >> 6, lane = tid & 63, c = lane, hc = h * 64 + c;
    LAS bf16_t* WT = (LAS bf16_t*)lds;
    LAS bf16_t* LOSB = WT + 64 * 200;
    LAS float* AW = (LAS float*)(lds + 38400); LAS float* AA = AW + 2048; LAS float* AV = AA + 2048; LAS float* G = AV + 2048;
    LAS float* opW = G + 2048; LAS float* opK = opW + 2048; LAS float* opR = opK + 2048; LAS float* opA = opR + 2048; LAS float* opB = opA + 2048;
    LAS float* opV = opB + 2048; LAS float* Y = opV + 2048; LAS float* BON = Y + 2048; LAS float* G1 = BON + 32;
    bf16_t* P = (bf16_t*)(p.ws + OFF_P); const float* SM = (const float*)(p.ws + OFF_SM); const bf16_t* VF = (const bf16_t*)(p.ws + OFF_VF);
    __syncthreads();
    for (int i = tid; i < 192 * 64; i += 512) { const int j = i >> 6, cc = i & 63; float v;
        if (j < 32) v = p.in[zo + I_RWW2][((size_t)L * 32 + j) * 512 + h * 64 + cc];
        else if (j < 64) v = p.in[zo + I_RAW2][((size_t)L * 32 + (j - 32)) * 512 + h * 64 + cc];
        else if (j < 96) v = (L > 0) ? p.in[zo + I_RVW2][((size_t)(L - 1) * 32 + (j - 64)) * 512 + h * 64 + cc] : 0.f;
        else v = p.in[zo + I_RGW2][((size_t)L * 96 + (j - 96)) * 512 + h * 64 + cc];
        WT[cc * 200 + j] = f2bf(v); }
    const float w0 = p.in[zo + I_RW0][L * 512 + hc], a0 = p.in[zo + I_RA0][L * 512 + hc], v0 = (L > 0) ? p.in[zo + I_RV0][(L - 1) * 512 + hc] : 0.f;
    const float k_k = p.in[zo + I_RKK][L * 512 + hc], k_a = p.in[zo + I_RKA][L * 512 + hc], r_k = p.in[zo + I_RRK][L * 512 + hc], ln_g = p.in[zo + I_RLNG][L * 512 + hc], ln_b = p.in[zo + I_RLNB][L * 512 + hc];
    f32x2 s[4];
#pragma unroll
    for (int e = 0; e < 4; ++e) s[e] = (f32x2){0.f, 0.f};
    const int row = wv * 8 + (lane >> 3), sub = lane & 7;
    int smo[12];
#pragma unroll
    for (int i = 0; i < 12; ++i) { const int idx = tid + i * 512, t = idx / 192, j = idx % 192; smo[i] = t * 256 + (j < 64 ? 64 + j : (j < 96 ? j - 40 : j + 32)); }
    float nsm[12]; bf16_t nr[4], nk[4], nv[4], nf[4];
#define RWKV_LOAD_SM(chn) do { const size_t Rn = (size_t)b * SEQ + (size_t)(chn) * TC; \
        _Pragma("unroll") for (int i = 0; i < 12; ++i) nsm[i] = SM[Rn * 256 + smo[i]]; } while (0)
#define RWKV_LOAD(chn) do { const size_t Rn = (size_t)b * SEQ + (size_t)(chn) * TC; \
        _Pragma("unroll") for (int i = 0; i < 4; ++i) { const size_t R = Rn + wv * 4 + i; nr[i] = P[R * LDP + PC_RR + hc]; nk[i] = P[R * LDP + PC_RK + hc]; nv[i] = P[R * LDP + PC_RV + hc]; nf[i] = (L > 0) ? VF[R * 512 + hc] : (bf16_t)0; } } while (0)
#define RWKV_P0() do { _Pragma("unroll") for (int i = 0; i < 12; ++i) { const int idx = tid + i * 512, t = idx / 192, j = idx % 192; \
            const float v = nsm[i], e = __expf(j < 32 ? 2.0f * v : -v), rr = __builtin_amdgcn_rcpf(1.0f + e);     \
            LOSB[t * 200 + j] = f2bf(j < 32 ? 1.0f - 2.0f * rr : (j >= 96 ? rr : v)); } } while (0)
    RWKV_LOAD_SM(0); RWKV_P0(); RWKV_LOAD_SM(1); RWKV_LOAD(0);
    __syncthreads();
    for (int ch = 0; ch < SEQ / TC; ++ch) {
        const size_t R0 = (size_t)b * SEQ + (size_t)ch * TC;
        LAS float* Gc = (ch & 1) ? G1 : G;
        { const int mt = wv & 1, nt = wv >> 1; const int ao = (mt * 16 + (lane & 15)) * 200 + 8 * (lane >> 4), bo = (nt * 16 + (lane & 15)) * 200 + 8 * (lane >> 4);
            bf16x8 af[6], bfr[6];
#pragma unroll
            for (int ks = 0; ks < 6; ++ks) { af[ks] = *(const LAS bf16x8*)(LOSB + ao + ks * 32); bfr[ks] = *(const LAS bf16x8*)(WT + bo + ks * 32); }
            const f32x4 z4 = (f32x4){0.f, 0.f, 0.f, 0.f};
            const f32x4 cw = __builtin_amdgcn_mfma_f32_16x16x32_bf16(af[0], bfr[0], z4, 0, 0, 0);
            const f32x4 ca = __builtin_amdgcn_mfma_f32_16x16x32_bf16(af[1], bfr[1], z4, 0, 0, 0);
            const f32x4 cvv = __builtin_amdgcn_mfma_f32_16x16x32_bf16(af[2], bfr[2], z4, 0, 0, 0);
            f32x4 cg = __builtin_amdgcn_mfma_f32_16x16x32_bf16(af[3], bfr[3], z4, 0, 0, 0);
            cg = __builtin_amdgcn_mfma_f32_16x16x32_bf16(af[4], bfr[4], cg, 0, 0, 0);
            cg = __builtin_amdgcn_mfma_f32_16x16x32_bf16(af[5], bfr[5], cg, 0, 0, 0);
#pragma unroll
            for (int rg = 0; rg < 4; ++rg) { const int o = (mt * 16 + (lane >> 4) * 4 + rg) * 64 + nt * 16 + (lane & 15); AW[o] = cw[rg]; AA[o] = ca[rg]; AV[o] = cvv[rg]; Gc[o] = cg[rg]; } }
        __syncthreads();
        { float kkr[4], km[4], av_[4], vv[4], rr_[4], red[8];
#pragma unroll
            for (int i = 0; i < 4; ++i) { const int t = wv * 4 + i;
                av_[i] = sigmoidf_(a0 + AA[t * 64 + c]);
                const float k_ = bf2f(nk[i]); rr_[i] = bf2f(nr[i]); vv[i] = bf2f(nv[i]);
                if (L > 0) { const float vf = bf2f(nf[i]); vv[i] = vv[i] + (vf - vv[i]) * sigmoidf_(v0 + AV[t * 64 + c]); }
                kkr[i] = k_ * k_k; km[i] = k_ * (1.0f + (av_[i] - 1.0f) * k_a);
                red[i] = kkr[i] * kkr[i]; red[4 + i] = rr_[i] * km[i] * r_k; }
            red64n<8>(red);
#pragma unroll
            for (int i = 0; i < 4; ++i) { const int t = wv * 4 + i;
                const float wdec = __expf(-0.60653066f * sigmoidf_(w0 + AW[t * 64 + c]));
                const float kk = kkr[i] * rsqrtf(fmaxf(red[i], 1e-24f));
                opW[t * 64 + c] = wdec; opK[t * 64 + c] = km[i]; opR[t * 64 + c] = rr_[i]; opA[t * 64 + c] = -kk; opB[t * 64 + c] = kk * av_[i]; opV[t * 64 + c] = vv[i];
                if (lane == 0) BON[t] = red[4 + i]; } }
        if (ch + 1 < SEQ / TC) { RWKV_P0(); RWKV_LOAD(ch + 1); if (ch + 2 < SEQ / TC) RWKV_LOAD_SM(ch + 2); }
        __syncthreads();
        if (!(dry && DRY_SKIP_SCAN)) scan_chunk<8, true>(s, opW, opK, opR, opA, opB, opV, Y, 64, row, sub);
        __syncthreads();
        { float y[4], m[4], q[4];
#pragma unroll
            for (int i = 0; i < 4; ++i) { y[i] = Y[(wv * 4 + i) * 64 + c]; m[i] = y[i]; }
            red64n<4>(m);
#pragma unroll
            for (int i = 0; i < 4; ++i) { y[i] -= m[i] * (1.0f / 64.0f); q[i] = y[i] * y[i]; }
            red64n<4>(q);
#pragma unroll
            for (int i = 0; i < 4; ++i) { const int t = wv * 4 + i; const size_t R = R0 + t;
                float yn = y[i] * rsqrtf(q[i] * (1.0f / 64.0f) + 64e-5f) * ln_g + ln_b; yn += BON[t] * opV[t * 64 + c];
                if (!dry) P[R * LDP + PC_RR + hc] = f2bf(yn * Gc[t * 64 + c]); } }
    }
#undef RWKV_LOAD_SM
#undef RWKV_P0
#undef RWKV_LOAD
}


__device__ void gla_item(const Params& p, int L, int item, LAS float* lf, bool dry) {
    int zo = 0; asm volatile("" : "+s"(zo));
    int tid_ = threadIdx.x; asm volatile("" : "+v"(tid_));
    const int tid = tid_, wv = tid >> 6, lane = tid & 63, c = lane;
    LAS float* opW = lf; LAS float* opK = opW + 2048; LAS float* opR = opK + 2048; LAS float* opV = opR + 2048; LAS float* Y = opV + 2048; LAS float* X0 = Y + 2048; LAS float* X1 = X0 + 512;
    bf16_t* P = (bf16_t*)(p.ws + OFF_P); const float* SM = (const float*)(p.ws + OFF_SM);
    const int half = item & 1, bh = item >> 1, b = bh >> 2, h = bh & 3, vcol = PC_GV + h * 128 + half * 64;
    __syncthreads();
    for (int i = tid; i < 16 * 64; i += 512) X1[i] = p.in[zo + I_GAW][((size_t)L * 16 + (i >> 6)) * 256 + h * 64 + (i & 63)];
    const float ab = p.in[zo + I_GAB][L * 256 + h * 64 + c];
    f32x2 s[4];
#pragma unroll
    for (int e = 0; e < 4; ++e) s[e] = (f32x2){0.f, 0.f};
    const int row = wv * 8 + (lane >> 3), sub = lane & 7;
    float nlo; bf16_t nvv[4], nk[4], nq[4];
#define GLA_LOAD(chn) do { const size_t Rn = (size_t)b * SEQ + (size_t)(chn) * TC; nlo = SM[(Rn + (tid >> 4)) * 256 + 8 + (tid & 15)]; \
        _Pragma("unroll") for (int i = 0; i < 4; ++i) { const int idx = tid + i * 512; nvv[i] = P[(Rn + (idx >> 6)) * LDP + vcol + (idx & 63)]; } \
        _Pragma("unroll") for (int i = 0; i < 4; ++i) { const size_t R = Rn + wv * 4 + i; nk[i] = P[R * LDP + PC_GK + h * 64 + c]; nq[i] = P[R * LDP + PC_GQ + h * 64 + c]; } } while (0)
    GLA_LOAD(0);
    for (int ch = 0; ch < SEQ / TC; ++ch) {
        const size_t R0 = (size_t)b * SEQ + (size_t)ch * TC;
        X0[tid] = nlo;
#pragma unroll
        for (int i = 0; i < 4; ++i) opV[tid + i * 512] = bf2f(nvv[i]);
        bf16_t ck[4], cq[4];
#pragma unroll
        for (int i = 0; i < 4; ++i) { ck[i] = nk[i]; cq[i] = nq[i]; }
        if (ch + 1 < SEQ / TC) GLA_LOAD(ch + 1);
        __syncthreads();
#pragma unroll
        for (int i = 0; i < 4; ++i) { const int t = wv * 4 + i; float la = ab;
#pragma unroll
            for (int j = 0; j < 16; ++j) la += X0[t * 16 + j] * X1[j * 64 + c];
            opW[t * 64 + c] = __expf(__logf(sigmoidf_(la)) * (1.0f / 16.0f));
            opK[t * 64 + c] = bf2f(ck[i]); opR[t * 64 + c] = bf2f(cq[i]) * 0.125f; }
        __syncthreads();
        scan_chunk<8, false>(s, opW, opK, opR, opW, opW, opV, Y, 64, row, sub);
        __syncthreads();
        if (!dry) {
#pragma unroll
            for (int i = 0; i < 4; ++i) { const int t = wv * 4 + i; P[(R0 + t) * LDP + vcol + c] = f2bf(Y[t * 64 + c]); }
        }
    }
#undef GLA_LOAD
}

template <int MODE>
__device__ void plain_item(const Params& p, int L, int item, LAS float* lf, bool dry) {
    int zo = 0; asm volatile("" : "+s"(zo));
    int tid_ = threadIdx.x; asm volatile("" : "+v"(tid_));
    const int tid = tid_, wv = tid >> 6, lane = tid & 63, c = lane;
    constexpr int VS = (MODE == 0) ? 128 : 64;
    LAS float* opW = lf; LAS float* opK = opW + 2048; LAS float* opR = opK + 2048; LAS float* opV = opR + 2048; LAS float* Y = opV + TC * VS; LAS float* X0 = Y + TC * VS; LAS float* X1 = X0 + 2048;
    bf16_t* P = (bf16_t*)(p.ws + OFF_P); const float* SM = (const float*)(p.ws + OFF_SM);
    __syncthreads();
    if (MODE == 0) {
        const int b = item >> 2, h = item & 3;
        for (int i = tid; i < 16 * 64; i += 512) X1[i] = p.in[zo + I_GAW][((size_t)L * 16 + (i >> 6)) * 256 + h * 64 + (i & 63)];
        const float ab = p.in[zo + I_GAB][L * 256 + h * 64 + c], gn0 = p.in[zo + I_GNG][L * 128 + lane], gn1 = p.in[zo + I_GNG][L * 128 + 64 + lane];
        f32x2 s[8];
#pragma unroll
        for (int e = 0; e < 8; ++e) s[e] = (f32x2){0.f, 0.f};
        const int row = wv * 16 + (lane >> 2), sub = lane & 3;
        float nlo; bf16_t nvv[8], nk[4], nq[4], ng0[4], ng1[4];
#define GLA_LOAD(chn) do { const size_t Rn = (size_t)b * SEQ + (size_t)(chn) * TC; nlo = SM[(Rn + (tid >> 4)) * 256 + 8 + (tid & 15)]; \
        _Pragma("unroll") for (int i = 0; i < 8; ++i) { const int idx = tid + i * 512; nvv[i] = P[(Rn + (idx >> 7)) * LDP + PC_GV + h * 128 + (idx & 127)]; } \
        _Pragma("unroll") for (int i = 0; i < 4; ++i) { const size_t R = Rn + wv * 4 + i; nk[i] = P[R * LDP + PC_GK + h * 64 + c]; nq[i] = P[R * LDP + PC_GQ + h * 64 + c]; \
            ng0[i] = P[R * LDP + PC_GR + h * 128 + lane]; ng1[i] = P[R * LDP + PC_GR + h * 128 + 64 + lane]; } } while (0)
        GLA_LOAD(0);
        for (int ch = 0; ch < SEQ / TC; ++ch) {
            const size_t R0 = (size_t)b * SEQ + (size_t)ch * TC;
            X0[tid] = nlo;
#pragma unroll
            for (int i = 0; i < 8; ++i) opV[tid + i * 512] = bf2f(nvv[i]);
            bf16_t ck[4], cq[4], cg0[4], cg1[4];
#pragma unroll
            for (int i = 0; i < 4; ++i) { ck[i] = nk[i]; cq[i] = nq[i]; cg0[i] = ng0[i]; cg1[i] = ng1[i]; }
            if (ch + 1 < SEQ / TC) GLA_LOAD(ch + 1);
            __syncthreads();
#pragma unroll
            for (int i = 0; i < 4; ++i) { const int t = wv * 4 + i; float la = ab;
#pragma unroll
                for (int j = 0; j < 16; ++j) la += X0[t * 16 + j] * X1[j * 64 + c];
                opW[t * 64 + c] = __expf(__logf(sigmoidf_(la)) * (1.0f / 16.0f));
                opK[t * 64 + c] = bf2f(ck[i]); opR[t * 64 + c] = bf2f(cq[i]) * 0.125f; }
            __syncthreads();
            scan_chunk<4, false>(s, opW, opK, opR, opW, opW, opV, Y, 128, row, sub);
            __syncthreads();
#pragma unroll
            for (int i = 0; i < 4; ++i) { const int t = wv * 4 + i; const size_t R = R0 + t;
                const float y0 = Y[t * 128 + lane], y1 = Y[t * 128 + 64 + lane], ss = red64(y0 * y0 + y1 * y1), rstd = rsqrtf(ss * (1.0f / 128.0f) + 1e-6f);
                bf16_t* rp = P + R * LDP + PC_GR + h * 128;
                const float r0 = bf2f(cg0[i]), r1 = bf2f(cg1[i]);
                if (!dry) { rp[lane] = f2bf(y0 * rstd * gn0 * siluf_(r0)); rp[64 + lane] = f2bf(y1 * rstd * gn1 * siluf_(r1)); } }
        }
#undef GLA_LOAD
    } else {
        const int b = item >> 3, hh = item & 7, g = hh >> 2;
        const int chx = hh * 64 + c, chb = 512 + g * 64 + c, chc = 640 + g * 64 + c;
        const float* cw = p.in[zo + I_SCW] + (size_t)L * 4 * 768; const float* cb = p.in[zo + I_SCB] + (size_t)L * 768;
        float cwx[4], cwb[4], cwc[4];
#pragma unroll
        for (int k = 0; k < 4; ++k) { cwx[k] = cw[k * 768 + chx]; cwb[k] = cw[k * 768 + chb]; cwc[k] = cw[k * 768 + chc]; }
        const float cbx = cb[chx], cbb = cb[chb], cbc = cb[chc];
        const float dtb = p.in[zo + I_SDTB][L * 8 + hh], Aneg = -__expf(p.in[zo + I_SALOG][L * 8 + hh]), Dsk = p.in[zo + I_SD][L * 8 + hh];
        f32x2 s[4];
#pragma unroll
        for (int e = 0; e < 4; ++e) s[e] = (f32x2){0.f, 0.f};
        const int row = wv * 8 + (lane >> 3), sub = lane & 7;
        const int t0 = wv * 4;
        bf16_t nx[7], nb[7], nc[7], nz[4]; float ndt[4];
#define SSD_LOAD(chn) do { const int sp0 = (chn) * TC + t0; \
        _Pragma("unroll") for (int q = 0; q < 7; ++q) { const int sp = sp0 - 3 + q; const size_t R = (size_t)b * SEQ + sp; \
            if (sp >= 0) { nx[q] = P[R * LDP + PC_XBC + chx]; nb[q] = P[R * LDP + PC_XBC + chb]; nc[q] = P[R * LDP + PC_XBC + chc]; } else { nx[q] = 0; nb[q] = 0; nc[q] = 0; } } \
        _Pragma("unroll") for (int i = 0; i < 4; ++i) { const size_t R = (size_t)b * SEQ + sp0 + i; nz[i] = P[R * LDP + PC_Z + chx]; ndt[i] = SM[R * 256 + hh]; } } while (0)
        SSD_LOAD(0);
        for (int ch = 0; ch < SEQ / TC; ++ch) {
            const size_t R0 = (size_t)b * SEQ + (size_t)ch * TC;
            float rx[7], rb[7], rc[7], cz[4], cdt[4];
#pragma unroll
            for (int q = 0; q < 7; ++q) { rx[q] = bf2f(nx[q]); rb[q] = bf2f(nb[q]); rc[q] = bf2f(nc[q]); }
#pragma unroll
            for (int i = 0; i < 4; ++i) { cz[i] = bf2f(nz[i]); cdt[i] = ndt[i]; }
            if (ch + 1 < SEQ / TC) SSD_LOAD(ch + 1);
#pragma unroll
            for (int i = 0; i < 4; ++i) { const int t = t0 + i;
                float x = cbx, bm = cbb, cm = cbc;
#pragma unroll
                for (int k = 0; k < 4; ++k) { x += cwx[k] * rx[i + k]; bm += cwb[k] * rb[i + k]; cm += cwc[k] * rc[i + k]; }
                x = siluf_(x); bm = siluf_(bm); cm = siluf_(cm);
                const float dt = softplusf_(cdt[i] + dtb);
                opW[t * 64 + c] = __expf(dt * Aneg); opK[t * 64 + c] = bm; opR[t * 64 + c] = cm; opV[t * 64 + c] = dt * x; X0[t * 64 + c] = x; }
            __syncthreads();
            scan_chunk<8, false>(s, opW, opK, opR, opW, opW, opV, Y, 64, row, sub);
            __syncthreads();
#pragma unroll
            for (int i = 0; i < 4; ++i) { const int t = t0 + i; const size_t R = R0 + t;
                const float y = Y[t * 64 + c] + Dsk * X0[t * 64 + c];
                if (!dry) P[R * LDP + PC_Z + chx] = f2bf(y * siluf_(cz[i])); }
            __syncthreads();
        }
#undef SSD_LOAD
    }
}

__device__ void lru_item(const Params& p, int L, int item, LAS float* lf, bool dry) {
    int zo = 0; asm volatile("" : "+s"(zo));
    int tid_ = threadIdx.x; asm volatile("" : "+v"(tid_));
    const int b = item >> 3, blk = item & 7, tid = tid_, wv = tid >> 6, lane = tid & 63, c = lane, cbi = blk * 64 + c;
    LAS float* wa = lf; LAS float* wx = wa + 4096; LAS float* XB = wx + 4096; LAS float* A_ = XB + 2048; LAS float* U_ = A_ + 2048; LAS float* HS = U_ + 2048;
    bf16_t* P = (bf16_t*)(p.ws + OFF_P);
    __syncthreads();
    for (int i = tid; i < 4096; i += 512) { wa[i] = p.in[zo + I_LWA][((size_t)L * 8 + blk) * 4096 + i]; wx[i] = p.in[zo + I_LWX][((size_t)L * 8 + blk) * 4096 + i]; }
    float cwv[4];
#pragma unroll
    for (int k = 0; k < 4; ++k) cwv[k] = p.in[zo + I_LCW][((size_t)L * 4 + k) * 512 + cbi];
    const float cbv = p.in[zo + I_LCB][L * 512 + cbi], ba = p.in[zo + I_LBA][L * 512 + cbi], bx = p.in[zo + I_LBX][L * 512 + cbi];
    const float spl = softplusf_(-p.in[zo + I_LLAM][L * 512 + cbi]);
    float hstate = 0.f;
    const int t0 = wv * 4;
    bf16_t nx[7], ngt[4];
#define LRU_LOAD(chn) do { const int sp0 = (chn) * TC + t0; \
        _Pragma("unroll") for (int q = 0; q < 7; ++q) { const int sp = sp0 - 3 + q; nx[q] = (sp >= 0) ? P[((size_t)b * SEQ + sp) * LDP + PC_LX + cbi] : (bf16_t)0; } \
        _Pragma("unroll") for (int i = 0; i < 4; ++i) ngt[i] = P[((size_t)b * SEQ + sp0 + i) * LDP + PC_LG + cbi]; } while (0)
    LRU_LOAD(0);
    for (int ch = 0; ch < SEQ / TC; ++ch) {
        const size_t R0 = (size_t)b * SEQ + (size_t)ch * TC;
        float rx[7], cg[4];
#pragma unroll
        for (int q = 0; q < 7; ++q) rx[q] = bf2f(nx[q]);
#pragma unroll
        for (int i = 0; i < 4; ++i) cg[i] = bf2f(ngt[i]);
        if (ch + 1 < SEQ / TC) LRU_LOAD(ch + 1);
        float xb[4];
#pragma unroll
        for (int i = 0; i < 4; ++i) { float x = cbv;
#pragma unroll
            for (int k = 0; k < 4; ++k) x += cwv[k] * rx[i + k];
            xb[i] = x; XB[(t0 + i) * 64 + c] = x; }
        __syncthreads();
        float ar[4] = {ba, ba, ba, ba}, ai[4] = {bx, bx, bx, bx};
#pragma unroll 4
        for (int j4 = 0; j4 < 16; ++j4) {
            float wra[4], wrx[4];
#pragma unroll
            for (int e = 0; e < 4; ++e) { wra[e] = wa[(j4 * 4 + e) * 64 + c]; wrx[e] = wx[(j4 * 4 + e) * 64 + c]; }
#pragma unroll
            for (int i = 0; i < 4; ++i) { const f32x4 x4 = *(const LAS f32x4*)(XB + (t0 + i) * 64 + j4 * 4);
                ar[i] += x4[0] * wra[0] + x4[1] * wra[1] + x4[2] * wra[2] + x4[3] * wra[3]; ai[i] += x4[0] * wrx[0] + x4[1] * wrx[1] + x4[2] * wrx[2] + x4[3] * wrx[3]; }
        }
#pragma unroll
        for (int i = 0; i < 4; ++i) { const float r = sigmoidf_(ar[i]), ig = sigmoidf_(ai[i]), la = -8.0f * r * spl, a = __expf(la);
            const float u = sqrtf(fmaxf(1.0f - a * a, 0.f)) * (ig * xb[i]);
            A_[(t0 + i) * 64 + c] = a; U_[(t0 + i) * 64 + c] = u; }
        __syncthreads();
        if (wv == 0) {
#pragma unroll 8
            for (int t = 0; t < TC; ++t) { hstate = A_[t * 64 + c] * hstate + U_[t * 64 + c]; HS[t * 64 + c] = hstate; }
        }
        __syncthreads();
#pragma unroll
        for (int i = 0; i < 4; ++i) { const size_t R = R0 + t0 + i; const float g = cg[i];
            const float u2 = 1.5957691216f * (g + 0.044715f * g * g * g);
            if (!dry) P[R * LDP + PC_LG + cbi] = f2bf(HS[(t0 + i) * 64 + c] * g * sigmoidf_(u2)); }
    }
#undef LRU_LOAD
}

__device__ void ssd_post(const Params& p, int L, int ordG, int ordC) {
    int zo = 0; asm volatile("" : "+s"(zo));
    int tid_ = threadIdx.x; asm volatile("" : "+v"(tid_));
    const int wid = tid_ >> 6, lane = tid_ & 63;
    bf16_t* P = (bf16_t*)(p.ws + OFF_P);
    const f32x4 g0 = *(const f32x4*)(p.in[zo + I_SNG] + L * 512 + lane * 8), g1 = *(const f32x4*)(p.in[zo + I_SNG] + L * 512 + lane * 8 + 4);
    const f32x4 gg0 = *(const f32x4*)(p.in[zo + I_GNG] + L * 128 + (lane & 15) * 8), gg1 = *(const f32x4*)(p.in[zo + I_GNG] + L * 128 + (lane & 15) * 8 + 4);
    for (int row = ordC * 8 + wid; row < T; row += ordG * 8) {
        u32x4* pp = (u32x4*)(P + (size_t)row * LDP + PC_Z + lane * 8); const u32x4 w = *pp;
        float v[8] = {bflo(w.x), bfhi(w.x), bflo(w.y), bfhi(w.y), bflo(w.z), bfhi(w.z), bflo(w.w), bfhi(w.w)};
        float ss = 0.f;
#pragma unroll
        for (int j = 0; j < 8; ++j) ss += v[j] * v[j];
        ss = red32(ss); const float rstd = rsqrtf(ss * (1.0f / 256.0f) + 1e-6f);
        u32x4 o; o.x = cvt_pk_bf16(v[0] * rstd * g0[0], v[1] * rstd * g0[1]); o.y = cvt_pk_bf16(v[2] * rstd * g0[2], v[3] * rstd * g0[3]);
        o.z = cvt_pk_bf16(v[4] * rstd * g1[0], v[5] * rstd * g1[1]); o.w = cvt_pk_bf16(v[6] * rstd * g1[2], v[7] * rstd * g1[3]);
        *pp = o;
        if (!GLA_SPLIT) continue;
        u32x4* gp = (u32x4*)(P + (size_t)row * LDP + PC_GR + lane * 8); const u32x4 yw = *(const u32x4*)(P + (size_t)row * LDP + PC_GV + lane * 8), rw = *gp;
        float y[8] = {bflo(yw.x), bfhi(yw.x), bflo(yw.y), bfhi(yw.y), bflo(yw.z), bfhi(yw.z), bflo(yw.w), bfhi(yw.w)};
        float rg[8] = {bflo(rw.x), bfhi(rw.x), bflo(rw.y), bfhi(rw.y), bflo(rw.z), bfhi(rw.z), bflo(rw.w), bfhi(rw.w)};
        float s2 = 0.f;
#pragma unroll
        for (int j = 0; j < 8; ++j) s2 += y[j] * y[j];
        s2 = red16(s2); const float rs2 = rsqrtf(s2 * (1.0f / 128.0f) + 1e-6f);
        float og[8];
#pragma unroll
        for (int j = 0; j < 8; ++j) og[j] = y[j] * rs2 * (j < 4 ? gg0[j] : gg1[j - 4]) * siluf_(rg[j]);
        u32x4 o2; o2.x = cvt_pk_bf16(og[0], og[1]); o2.y = cvt_pk_bf16(og[2], og[3]); o2.z = cvt_pk_bf16(og[4], og[5]); o2.w = cvt_pk_bf16(og[6], og[7]);
        *gp = o2;
    }
}


__device__ __forceinline__ void b1_fixup(const Params& p, int L, const bf16_t* stp, const float* sts) {
    int zo = 0; asm volatile("" : "+s"(zo));
    int tid_ = threadIdx.x; asm volatile("" : "+v"(tid_));
    bf16_t* P = (bf16_t*)(p.ws + OFF_P); float* SM = (float*)(p.ws + OFF_SM); bf16_t* VF = (bf16_t*)(p.ws + OFF_VF);
    const float* mu = p.in[zo + I_RMU] + L * 1696;
    for (int idx = blockIdx.x * 512 + tid_; idx < 512 * 1792; idx += gridDim.x * 512) {
        const int g = idx / 1792, c = idx % 1792; const size_t R = (size_t)g * 64; const bool first = (R % SEQ) == 0;
        if (c < 1536) { const float cur = bf2f(P[R * LDP + PC_RR + c]), prev = first ? 0.f : bf2f(stp[(size_t)(g - 1) * 1536 + c]);
            const bf16_t o = f2bf(cur + (prev - cur) * mu[c]); P[R * LDP + PC_RR + c] = o; if (L == 0 && c >= 1024) VF[R * 512 + c - 1024] = o; }
        else { const int sc = c - 1536; const float m = (sc >= 64 && sc < 224) ? mu[1536 + sc - 64] : 0.f;
            const float cur = SM[R * 256 + sc], prev = first ? 0.f : sts[(size_t)(g - 1) * 256 + sc]; SM[R * 256 + sc] = cur + (prev - cur) * m; }
    }
}

#define XB_TMO      128
#define XB_XCNT(j)  (256  + 64 * (j))
#define XB_XSUB(j)  (1280 + 64 * (j))
#define XB_XGEN(j)  (2304 + 64 * (j))
#define XB_TOP      3328
#define XB_TOPGEN   3392
#define XCD_BAR_WORDS 3456
#define XB_SPIN_CAP (1u << 22)
__device__ __forceinline__ unsigned xb_ld(unsigned* p)              { return __hip_atomic_load(p, __ATOMIC_RELAXED, __HIP_MEMORY_SCOPE_AGENT); }
__device__ __forceinline__ unsigned xb_add(unsigned* p, unsigned v) { return __hip_atomic_fetch_add(p, v, __ATOMIC_RELAXED, __HIP_MEMORY_SCOPE_AGENT); }
__device__ __forceinline__ unsigned xb_xcc_id() { return (unsigned)__builtin_amdgcn_s_getreg((3 << 11) | 20) & 0xFu; }
#define XB_SPIN(cond, bar) do { unsigned _sp = 0; while (cond) { __builtin_amdgcn_s_sleep(1); \
    if ((++_sp & 255u) == 0u) { if (xb_ld(&(bar)[XB_TMO])) break; if (_sp > XB_SPIN_CAP) { atomicAdd(&(bar)[XB_TMO], 1u); break; } } } } while (0)
struct XcdBarrier { unsigned* bar; unsigned x; volatile LAS unsigned* st; };
__device__ __forceinline__ XcdBarrier xcd_barrier_post(unsigned* bar, volatile LAS unsigned* st) {
    XcdBarrier b; b.bar = bar; b.x = xb_xcc_id(); b.st = st;
    if (threadIdx.x == 0) (void)xb_add(&bar[XB_XCNT(b.x)], 1u);
    return b;
}
__device__ __forceinline__ void xcd_barrier_complete(unsigned* bar, unsigned x, unsigned& nloc, unsigned& nx) {
    const unsigned G = gridDim.x * gridDim.y * gridDim.z;
    unsigned sum, cnt, mine, sp = 0u;
    for (;;) {
        sum = 0u; cnt = 0u; mine = 0u;
#pragma unroll
        for (unsigned j = 0; j < 16; ++j) { const unsigned c = xb_ld(&bar[XB_XCNT(j)]); sum += c; cnt += (c > 0u) ? 1u : 0u; mine = (j == x) ? c : mine; }
        if (sum == G) break;
        __builtin_amdgcn_s_sleep(1);
        if ((++sp & 255u) == 0u) { if (xb_ld(&bar[XB_TMO])) break; if (sp > XB_SPIN_CAP) { atomicAdd(&bar[XB_TMO], 1u); break; } }
    }
    nloc = mine > 0u ? mine : 1u; nx = cnt > 0u ? cnt : 1u;
}
__device__ __attribute__((noinline)) void xcd_barrier(const XcdBarrier b) {
    asm volatile("s_waitcnt vmcnt(0)" ::: "memory");
    __syncthreads();
    if (threadIdx.x == 0) {
        unsigned* bar = b.bar;
        __builtin_amdgcn_s_waitcnt(0);
        unsigned nloc = b.st[0], nx = b.st[1];
        if (nloc == 0u) { xcd_barrier_complete(bar, b.x, nloc, nx); b.st[0] = nloc; b.st[1] = nx; }
        const unsigned old = xb_add(&bar[XB_XSUB(b.x)], 1u);
        const unsigned gen = old / nloc;
        if (old + 1u == (gen + 1u) * nloc) {
            __builtin_amdgcn_fence(__ATOMIC_RELEASE, "agent");
            asm volatile("s_waitcnt vmcnt(0)" ::: "memory");
            const unsigned og = xb_add(&bar[XB_TOP], 1u);
            const unsigned tg = og / nx;
            if (og + 1u == (tg + 1u) * nx) xb_add(&bar[XB_TOPGEN], 1u);
            else XB_SPIN(xb_ld(&bar[XB_TOPGEN]) == tg, bar);
            __builtin_amdgcn_fence(__ATOMIC_ACQUIRE, "agent");
            xb_add(&bar[XB_XGEN(b.x)], 1u);
            asm volatile("s_waitcnt vmcnt(0)" ::: "memory");
        } else {
            XB_SPIN(xb_ld(&bar[XB_XGEN(b.x)]) == gen, bar);
            __builtin_amdgcn_fence(__ATOMIC_ACQUIRE, "agent");
            asm volatile("s_waitcnt vmcnt(0)" ::: "memory");
        }
    }
    __syncthreads();
}

__device__ __attribute__((noinline)) void sub_barrier(unsigned* word, unsigned n) {
    asm volatile("s_waitcnt vmcnt(0)" ::: "memory");
    __syncthreads();
    if (threadIdx.x == 0) {
        __builtin_amdgcn_fence(__ATOMIC_RELEASE, "agent");
        asm volatile("s_waitcnt vmcnt(0)" ::: "memory");
        (void)xb_add(word, 1u);
        unsigned sp = 0;
        while (xb_ld(word) < n) { __builtin_amdgcn_s_sleep(2); if (++sp > (1u << 24)) break; }
        __builtin_amdgcn_fence(__ATOMIC_ACQUIRE, "agent");
        asm volatile("s_waitcnt vmcnt(0)" ::: "memory");
    }
    __syncthreads();
}

__global__ __launch_bounds__(512) void mega(Params p) {
    extern __shared__ __attribute__((aligned(16))) unsigned char smem[];
    cg::grid_group grid = cg::this_grid();
    LAS unsigned char* lds = (LAS unsigned char*)smem; LAS float* lf = (LAS float*)smem;
    unsigned char* ws = p.ws;
    int zo = 0; asm volatile("" : "+s"(zo));
    bf16_t* H = (bf16_t*)(ws + OFF_H); bf16_t* P = (bf16_t*)(ws + OFF_P); float* SM = (float*)(ws + OFF_SM); bf16_t* VF = (bf16_t*)(ws + OFF_VF);
    const bf16_t* zrow = (const bf16_t*)(ws + OFF_Z);
    volatile LAS unsigned* xst = (volatile LAS unsigned*)(lds + LDS_BYTES - 16);
    if (threadIdx.x == 0) { xst[0] = 0u; xst[1] = 0u; }
    __syncthreads();
    const XcdBarrier xb = xcd_barrier_post((unsigned*)(ws + OFF_BAR), xst);
    float* X = p.out;
    bf16_t* ACT = P; float* FO = (float*)(ws + OFF_P + 176 * MiB);
    const int G = (int)gridDim.x, bid = (int)blockIdx.x;
    unsigned* subw = (unsigned*)(ws + OFF_BAR) + 3584;
    if (blockIdx.x == 0) for (int i = threadIdx.x; i < 1024; i += 512) ((unsigned*)(ws + OFF_Z))[i] = 0u;
    convert_weights(p, 0, lf, 0, 1408, G, bid);
    resnorm<0>(p.in[zo + I_X], nullptr, 0, nullptr, nullptr, p.in[zo + I_NG] + 0, H);
    grid.sync();
    for (int L = 0; L < 2; ++L) {
        asm volatile("" : "+s"(zo));
        const float* ng = p.in[zo + I_NG] + (size_t)L * 4 * DM;
        const float* xin = (L == 0) ? p.in[zo + I_X] : X;
        { Epi<EPI_B1> e{}; e.o16 = P; e.o32 = SM; e.vf = (L == 0) ? VF : nullptr; e.mu = p.in[zo + I_RMU] + L * 1696; e.stp = (bf16_t*)(ws + WB_R + 7 * MiB / 2); e.sts = (float*)(ws + WB_R + 5 * MiB);
          gemm_phase<Epi<EPI_B1>, false>(lds, H, DM, (const bf16_t*)(ws + WB_R), T, 1792, 1024, e, zrow, G, bid); }
        xcd_barrier(xb);
        b1_fixup(p, L, (const bf16_t*)(ws + WB_R + 7 * MiB / 2), (const float*)(ws + WB_R + 5 * MiB));
        xcd_barrier(xb);
        {
            const int NR = 64, NO = G - NR;
            if (bid < NR) {
                for (int item = bid; item < 64; item += NR) rwkv_item_old(p, L, item, lds, false);
            } else {
                const int oc = bid - NR;
                { Epi<EPI_B2> e{}; e.o16 = P; gemm_phase<Epi<EPI_B2>, false>(lds, H, DM, (const bf16_t*)(ws + WB_2), T, 3840, 1024, e, zrow, NO, oc); }
                sub_barrier(subw + (L * 2 + 0) * 64, (unsigned)NO);
                for (int item = oc; item < 192; item += NO) {
                    if (item < 64) gla_item(p, L, item, lf, false);
                    else if (item < 128) plain_item<1>(p, L, item - 64, lf, false);
                    else lru_item(p, L, item - 128, lf, false);
                }
                sub_barrier(subw + (L * 2 + 1) * 64, (unsigned)NO);
                ssd_post(p, L, NO, oc);
                convert_weights(p, L, lf, 1408, 5312, NO, oc);
                if (L == 0) convert_weights(p, 1, lf, 0, 1408, NO, oc);
            }
        }
        xcd_barrier(xb);
        bf16_t* U = (L == 0) ? (bf16_t*)p.out : (bf16_t*)(ws + OFF_SM);
        for (int q = 0; q < 4; ++q) {
            { Epi<EPI_U> e{}; e.o16 = U; gemm_phase<Epi<EPI_U>, false>(lds, P + (size_t)q * 8192 * LDP, LDP, (const bf16_t*)(ws + WB_B), 8192, 4096, 512, e, zrow, G, bid); }
            xcd_barrier(xb);
            { Epi<EPI_MERGE> e{}; e.o16 = P + (size_t)q * 8192 * LDP; e.uq = U; gemm_phase<Epi<EPI_MERGE>, false>(lds, H + (size_t)q * 8192 * DM, DM, (const bf16_t*)(ws + WB_G), 8192, 4096, 1024, e, zrow, G, bid); }
            xcd_barrier(xb);
        }
        { Epi<EPI_O> e{}; e.o16 = P; gemm_phase<Epi<EPI_O>, false>(lds, P + PC_MERGED, LDP, (const bf16_t*)(ws + WB_O), T, 1024, 1024, e, zrow, G, bid); }
        xcd_barrier(xb);
        resnorm<1>(xin, P + PC_O, LDP, ng + DM, X, ng + 2 * DM, H);
        xcd_barrier(xb);
        { Epi<EPI_FFN> e{}; e.o16 = ACT; gemm_phase<Epi<EPI_FFN>, false>(lds, H, DM, (const bf16_t*)(ws + WB_F), T, 5632, 1024, e, zrow, G, bid); }
        xcd_barrier(xb);
        { Epi<EPI_DOWN> e{}; e.o16 = (bf16_t*)FO; gemm_phase<Epi<EPI_DOWN>, false>(lds, ACT, FH, (const bf16_t*)(ws + WB_D), T, 1024, FH, e, zrow, G, bid); }
        xcd_barrier(xb);
        if (L == 0) {
            resnorm<1>(X, FO, DM, ng + 3 * DM, X, p.in[zo + I_NG] + 4 * DM, H);
            xcd_barrier(xb);
        } else {
            resnorm<1>(X, FO, DM, ng + 3 * DM, X, nullptr, nullptr);
        }
    }
}

extern "C" void kernel_launch(void* const* d_in, const int* in_sizes, int n_in, void* d_out, int out_size, void* d_ws, size_t ws_size, hipStream_t stream) {
    static int grid_blocks = 0;
    if (grid_blocks == 0) {
        if (n_in != N_INPUTS || out_size != T * DM || ws_size < WS_END) { fprintf(stderr, "kernel_launch: unexpected problem (n_in %d, out %d, ws %zu)\n", n_in, out_size, ws_size); grid_blocks = -1; return; }
        int dev = 0, cus = 0, per_cu = 0;
        (void)hipGetDevice(&dev); (void)hipDeviceGetAttribute(&cus, hipDeviceAttributeMultiprocessorCount, dev);
        if (hipFuncSetAttribute((const void*)mega, hipFuncAttributeMaxDynamicSharedMemorySize, LDS_BYTES) != hipSuccess) { fprintf(stderr, "kernel_launch: hipFuncSetAttribute failed\n"); grid_blocks = -1; return; }
        if (hipOccupancyMaxActiveBlocksPerMultiprocessor(&per_cu, (const void*)mega, 512, LDS_BYTES) != hipSuccess || per_cu < 1) { fprintf(stderr, "kernel_launch: occupancy query says %d\n", per_cu); per_cu = 1; }
        (void)hipGetLastError();
        grid_blocks = cus * 1;
        if (grid_blocks < 128) { fprintf(stderr, "kernel_launch: needs at least 128 CUs\n"); grid_blocks = -1; return; }
    }
    if (grid_blocks < 0) return;
    if (hipMemsetAsync((char*)d_ws + OFF_BAR, 0, 4096 * 4, stream) != hipSuccess) { fprintf(stderr, "kernel_launch: memset failed\n"); return; }
    Params p{};
    for (int i = 0; i < N_INPUTS; ++i) p.in[i] = (const float*)d_in[i];
    p.out = (float*)d_out; p.ws = (unsigned char*)d_ws;
    void* args[] = {&p};
    hipError_t e = hipLaunchCooperativeKernel((const void*)mega, dim3(grid_blocks), dim3(512), args, LDS_BYTES, stream);
    if (e != hipSuccess) fprintf(stderr, "cooperative launch failed: %s (grid %d)\n", hipGetErrorString(e), grid_blocks);
}
```

```cpp
#include <hip/hip_runtime.h>
#include <hip/hip_cooperative_groups.h>
#include <cstdio>
namespace cg = cooperative_groups;

#define LAS __attribute__((address_space(3)))
typedef unsigned short bf16_t;
typedef short bf16x8 __attribute__((ext_vector_type(8)));
typedef float f32x4 __attribute__((ext_vector_type(4)));
typedef unsigned u32x4 __attribute__((ext_vector_type(4)));
typedef unsigned u32x2 __attribute__((ext_vector_type(2)));

constexpr int NB = 8, SEQ = 4096, T = NB * SEQ, DM = 1024, NIN = 9656, FH = 2816, LDP = 5376;
constexpr int BM = 256, BK = 64, HALF = 128, HTB = HALF * BK * 2, STAGE_BYTES = 8 * HTB, NXCD = 8, WGM = 8;
constexpr int LDS_BYTES = 144 * 1024;
constexpr bool DRY_SKIP_SCAN = false;
constexpr bool GLA_SPLIT = true;
constexpr int DRY_MASK = 15;
constexpr int REP_GEMM = 1, REP_SCAN = 0, REP_SYNC = 1, REP_CONV = 1, REP_NORM = 1;
constexpr size_t MiB = 1u << 20;
constexpr size_t WB_R = 0, WB_2 = 7 * MiB, WB_G = WB_2 + 15 * MiB / 2, WB_B = WB_G + 8 * MiB, WB_O = WB_B + 4 * MiB, WB_F = WB_O + 2 * MiB, WB_D = WB_F + 11 * MiB;
constexpr size_t OFF_Z = 45 * MiB, OFF_H = 46 * MiB, OFF_P = 110 * MiB, OFF_SM = 446 * MiB, OFF_VF = 478 * MiB, OFF_BAR = 510 * MiB, OFF_BON = 510 * MiB + 65536, WS_END = OFF_BON + MiB;
constexpr int PC_Z = 0, PC_XBC = 512, PC_GQ = 1280, PC_GK = 1536, PC_GV = 1792, PC_GR = 2304, PC_LX = 2816, PC_LG = 3328, PC_RR = 3840, PC_RK = 4352, PC_RV = 4864;
constexpr int PC_MERGED = 1280, PC_O = 4352;

enum { I_X = 0, I_NG, I_WIN, I_WVRES, I_SCW, I_SCB, I_SDTB, I_SALOG, I_SD, I_SNG, I_GAW, I_GAB, I_GNG, I_LCW, I_LCB, I_LWA, I_LBA, I_LWX, I_LBX, I_LLAM,
       I_RMU, I_RW0, I_RWW2, I_RA0, I_RAW2, I_RV0, I_RVW2, I_RGW2, I_RKK, I_RKA, I_RRK, I_RLNG, I_RLNB, I_WBR, I_WOUT, I_FG, I_FU, I_FD, N_INPUTS };

struct Params { const float* in[N_INPUTS]; float* out; unsigned char* ws; };

__device__ __forceinline__ unsigned cvt_pk_bf16(float lo, float hi) { unsigned r; asm volatile("v_cvt_pk_bf16_f32 %0, %1, %2" : "=v"(r) : "v"(lo), "v"(hi)); return r; }
__device__ __forceinline__ float bf2f(bf16_t v) { return __uint_as_float((unsigned)v << 16); }
__device__ __forceinline__ float bflo(unsigned v) { return __uint_as_float(v << 16); }
__device__ __forceinline__ float bfhi(unsigned v) { return __uint_as_float(v & 0xffff0000u); }
__device__ __forceinline__ bf16_t f2bf(float v) { return (bf16_t)(cvt_pk_bf16(v, 0.f) & 0xffffu); }
__device__ __forceinline__ float sigmoidf_(float x) { return __builtin_amdgcn_rcpf(1.0f + __expf(-x)); }
__device__ __forceinline__ float siluf_(float x) { return x * sigmoidf_(x); }
__device__ __forceinline__ float softplusf_(float x) { return fmaxf(x, 0.f) + log1pf(__expf(-fabsf(x))); }
template <int CTRL> __device__ __forceinline__ float dpp_add(float x) { int v = __builtin_amdgcn_update_dpp(0, __float_as_int(x), CTRL, 0xF, 0xF, true); return x + __int_as_float(v); }
__device__ __forceinline__ float red4(float x) { x = dpp_add<0xB1>(x); x = dpp_add<0x4E>(x); return x; }
__device__ __forceinline__ float red8(float x) { x = red4(x); x = dpp_add<0x141>(x); return x; }
__device__ __forceinline__ float red16(float x) { x = red8(x); x = dpp_add<0x140>(x); return x; }
__device__ __forceinline__ float red32(float x) { x = red16(x); x += __shfl_xor(x, 16); return x; }
__device__ __forceinline__ float red64(float x) { x = red32(x); x += __shfl_xor(x, 32); return x; }
template <int N> __device__ __forceinline__ void red64n(float (&v)[N]) {
#pragma unroll
    for (int i = 0; i < N; ++i) v[i] = red16(v[i]);
    float t[N];
#pragma unroll
    for (int i = 0; i < N; ++i) t[i] = __shfl_xor(v[i], 16);
#pragma unroll
    for (int i = 0; i < N; ++i) v[i] += t[i];
#pragma unroll
    for (int i = 0; i < N; ++i) t[i] = __shfl_xor(v[i], 32);
#pragma unroll
    for (int i = 0; i < N; ++i) v[i] += t[i];
}

__device__ __forceinline__ int lds_byte(int r, int c) { const int st = (r >> 4) * 2 + (c >> 5), rr = r & 15, cc = c & 31, ob = rr * 64 + cc * 2; return st * 1024 + (ob ^ (((ob >> 9) & 1) << 5)); }
__device__ __forceinline__ void stage_rc(int b, int& R, int& C) { const int st = b / 1024, sb = b % 1024, swz = sb ^ (((sb >> 9) & 1) << 5); R = (st >> 1) * 16 + swz / 64; C = (st & 1) * 32 + (swz % 64) / 2; }
__device__ __forceinline__ int perm32(int rho) { const int n = rho >> 4, i = rho & 15; return 8 * (i >> 2) + 4 * n + (i & 3); }
struct Unit { int pm, pn; };
struct Order {
    int nM, nN, nwg, G, c;
    __device__ void init(int M, int N, int G_, int c_) { nM = M / BM; nN = N / BM; nwg = nM * nN; G = G_; c = c_; }
    __device__ bool next(int i, Unit& u) const {
        const long L = (long)i * G + c; if (L >= nwg) return false;
        int wgid = (int)L; { const int q = nwg / NXCD, r = nwg % NXCD, xcd = wgid % NXCD, off = wgid / NXCD; wgid = (xcd < r ? xcd * (q + 1) : r * (q + 1) + (xcd - r) * q) + off; }
        const int nig = WGM * nN, gid = wgid / nig, fm = gid * WGM, gsz = (nM - fm) < WGM ? (nM - fm) : WGM;
        u.pm = fm + ((wgid % nig) % gsz); u.pn = (wgid % nig) / gsz; return true;
    }
};

enum { EPI_B2 = 0, EPI_B1, EPI_U, EPI_MERGE, EPI_O, EPI_FFN, EPI_DOWN };
template <int MODE> struct Epi {
    static constexpr bool PERM = (MODE != EPI_MERGE);
    bf16_t* o16; float* o32; const bf16_t* uq; bf16_t* vf; const float* mu; bf16_t* stp; float* sts;
    __device__ __forceinline__ int a_col(int pn) const { if (MODE == EPI_U) { const int k = pn >> 2; return k == 0 ? PC_Z : (k == 1 ? PC_GR : (k == 2 ? PC_LG : PC_RR)); } return 0; }
    __device__ __forceinline__ void operator()(const f32x4 (&acc)[2][2][4][2], const Unit& u, int wr, int wc, int fr, int fq) const {
        const int row0 = u.pm * BM + wr * 64 + fr;
        if constexpr (MODE == EPI_B1) {
            const bool small = (u.pn == 6);
#pragma unroll
            for (int bj = 0; bj < 2; ++bj) {
                const int cb = u.pn * BM + bj * HALF + wc * 32 + 8 * fq;
                float mu8[8];
#pragma unroll
                for (int e = 0; e < 8; ++e) { const int sc = cb + e - 1536; mu8[e] = !small ? mu[cb + e] : ((sc >= 64 && sc < 224) ? mu[1536 + sc - 64] : 0.f); }
#pragma unroll
                for (int ai = 0; ai < 2; ++ai)
#pragma unroll
                    for (int m = 0; m < 4; ++m) { const size_t r = (size_t)(row0 + ai * HALF + m * 16); float o[8], raw[8];
#pragma unroll
                        for (int e = 0; e < 8; ++e) { const float cur = acc[ai][bj][m][e >> 2][e & 3]; raw[e] = cur;
                            const float p1 = __int_as_float(__builtin_amdgcn_update_dpp(0, __float_as_int(cur), 0x111, 0xF, 0xF, true));
                            float p0 = 0.f; if (m > 0) p0 = __int_as_float(__builtin_amdgcn_update_dpp(0, __float_as_int(acc[ai][bj][m > 0 ? m - 1 : 0][e >> 2][e & 3]), 0x121, 0xF, 0xF, true));
                            const float prev = (fr == 0) ? p0 : p1, lerp = cur + (prev - cur) * mu8[e];
                            o[e] = (fr == 0 && m == 0) ? cur : lerp; }
                        if (small) { float* rp = o32 + r * 256 + (cb - 1536); *(f32x4*)rp = (f32x4){o[0], o[1], o[2], o[3]}; *(f32x4*)(rp + 4) = (f32x4){o[4], o[5], o[6], o[7]}; }
                        else { u32x4 w; w.x = cvt_pk_bf16(o[0], o[1]); w.y = cvt_pk_bf16(o[2], o[3]); w.z = cvt_pk_bf16(o[4], o[5]); w.w = cvt_pk_bf16(o[6], o[7]);
                            *(u32x4*)(o16 + r * LDP + PC_RR + cb) = w; if (vf != nullptr && u.pn >= 4) *(u32x4*)(vf + r * 512 + (cb - 1024)) = w; }
                        if (m == 3 && fr == 15) { const size_t g = r >> 6;
                            if (small) { float* sp = sts + g * 256 + (cb - 1536); *(f32x4*)sp = (f32x4){raw[0], raw[1], raw[2], raw[3]}; *(f32x4*)(sp + 4) = (f32x4){raw[4], raw[5], raw[6], raw[7]}; }
                            else { u32x4 w; w.x = cvt_pk_bf16(raw[0], raw[1]); w.y = cvt_pk_bf16(raw[2], raw[3]); w.z = cvt_pk_bf16(raw[4], raw[5]); w.w = cvt_pk_bf16(raw[6], raw[7]); *(u32x4*)(stp + g * 1536 + cb) = w; } } }
            }
        } else if constexpr (MODE == EPI_B2 || MODE == EPI_O || MODE == EPI_U || MODE == EPI_DOWN) {
            const int ct = wc * 32 + 8 * fq;
            if (MODE == EPI_B1 && u.pn == 6) {
#pragma unroll
                for (int ai = 0; ai < 2; ++ai)
#pragma unroll
                    for (int m = 0; m < 4; ++m) { float* rowp = o32 + (size_t)(row0 + ai * HALF + m * 16) * 256 + ct;
#pragma unroll
                        for (int bj = 0; bj < 2; ++bj) { *(f32x4*)(rowp + bj * HALF) = acc[ai][bj][m][0]; *(f32x4*)(rowp + bj * HALF + 4) = acc[ai][bj][m][1]; } }
                return;
            }
            const int ld = (MODE == EPI_U) ? 4096 : (MODE == EPI_DOWN ? DM : LDP);
            const int colbase = (MODE == EPI_B2) ? 0 : (MODE == EPI_B1 ? PC_RR : (MODE == EPI_O ? PC_O : 0));
            const int col0 = colbase + u.pn * BM + ct;
            const bool dovf = (MODE == EPI_B1) && vf != nullptr && u.pn >= 4;
#pragma unroll
            for (int ai = 0; ai < 2; ++ai)
#pragma unroll
                for (int m = 0; m < 4; ++m) { const size_t r = (size_t)(row0 + ai * HALF + m * 16); bf16_t* rowp = o16 + r * ld + col0;
#pragma unroll
                    for (int bj = 0; bj < 2; ++bj) { const f32x4 v0 = acc[ai][bj][m][0], v1 = acc[ai][bj][m][1];
                        u32x4 w; w.x = cvt_pk_bf16(v0[0], v0[1]); w.y = cvt_pk_bf16(v0[2], v0[3]); w.z = cvt_pk_bf16(v1[0], v1[1]); w.w = cvt_pk_bf16(v1[2], v1[3]);
                        *(u32x4*)(rowp + bj * HALF) = w;
                        if (MODE == EPI_B1) { if (dovf) *(u32x4*)(vf + r * 512 + (u.pn - 4) * BM + ct + bj * HALF) = w; } } }
        } else if constexpr (MODE == EPI_FFN) {
            const int hc0 = u.pn * HALF + wc * 32 + 8 * fq;
#pragma unroll
            for (int ai = 0; ai < 2; ++ai)
#pragma unroll
                for (int m = 0; m < 4; ++m) { bf16_t* rowp = o16 + (size_t)(row0 + ai * HALF + m * 16) * FH + hc0; float a[8];
#pragma unroll
                    for (int n = 0; n < 2; ++n)
#pragma unroll
                        for (int j = 0; j < 4; ++j) a[n * 4 + j] = siluf_(acc[ai][0][m][n][j]) * acc[ai][1][m][n][j];
                    u32x4 w; w.x = cvt_pk_bf16(a[0], a[1]); w.y = cvt_pk_bf16(a[2], a[3]); w.z = cvt_pk_bf16(a[4], a[5]); w.w = cvt_pk_bf16(a[6], a[7]);
                    *(u32x4*)rowp = w; }
        } else {
            const int d0 = u.pn * 64 + wc * 16 + 4 * fq;
#pragma unroll
            for (int ai = 0; ai < 2; ++ai)
#pragma unroll
                for (int m = 0; m < 4; ++m) { const size_t r = (size_t)(row0 + ai * HALF + m * 16); const bf16_t* up = uq + r * 4096 + d0; float s[4] = {0.f, 0.f, 0.f, 0.f};
#pragma unroll
                    for (int bj = 0; bj < 2; ++bj)
#pragma unroll
                        for (int n = 0; n < 2; ++n) { const u32x2 uu = *(const u32x2*)(up + (2 * bj + n) * 1024); const f32x4 g = acc[ai][bj][m][n];
                            s[0] += sigmoidf_(g[0]) * bflo(uu.x); s[1] += sigmoidf_(g[1]) * bfhi(uu.x); s[2] += sigmoidf_(g[2]) * bflo(uu.y); s[3] += sigmoidf_(g[3]) * bfhi(uu.y); }
                    u32x2 w; w.x = cvt_pk_bf16(s[0], s[1]); w.y = cvt_pk_bf16(s[2], s[3]);
                    *(u32x2*)(o16 + r * LDP + PC_MERGED + d0) = w; }
        }
    }
};

template <class EpiT, bool SHIFT>
__device__ __forceinline__ void gemm_phase(LAS unsigned char* lds, const bf16_t* A, int lda, const bf16_t* Bt, int M, int N, int K, const EpiT& E, const bf16_t* zrow, int ordG, int ordC) {
    int tid_ = threadIdx.x; asm volatile("" : "+v"(tid_));
    const int tid = tid_, wid = __builtin_amdgcn_readfirstlane(tid >> 6), lane = tid & 63, wr = wid >> 2, wc = wid & 3, fr = lane & 15, fq = lane >> 4;
    const int nt = K / BK;
    Order S; S.init(M, N, ordG, ordC);
    unsigned voffA[2], voffB[2]; bool z0[2];
#pragma unroll
    for (int i = 0; i < 2; ++i) { int R, C; stage_rc(tid * 16 + i * 8192, R, C); const int Rb = EpiT::PERM ? ((R & ~31) + perm32(R & 31)) : R;
        voffA[i] = (unsigned)(R * lda + C) * 2u; voffB[i] = (unsigned)(Rb * K + C) * 2u; z0[i] = (R == 0); }
    const size_t kstep = (size_t)(BK * 2);
    const size_t hstepA = (size_t)HALF * lda * 2, tstepA = 2 * hstepA, hstepB = (size_t)HALF * K * 2, tstepB = 2 * hstepB;
    const size_t shiftsub = (size_t)lda * 2 + (size_t)K;
    const unsigned ldsw = (unsigned)wid * 1024u;
    const int aoff = lds_byte(wr * 64 + fr, fq * 8), boff = lds_byte(wc * 32 + fr, fq * 8);
#define PG8_SA(b, h) (((b) * 2 + (h)) * HTB)
#define PG8_SB(b, h) ((4 + (b) * 2 + (h)) * HTB)
#define PG8_STAGEB(bufoff, gbase) do { _Pragma("unroll") for (int _i = 0; _i < 2; ++_i) \
        __builtin_amdgcn_global_load_lds((const unsigned*)((const char*)(gbase) + voffB[_i]), (LAS unsigned*)(lds + (bufoff) + ldsw + _i * 8192), 16, 0, 0); } while (0)
#define PG8_STAGEA(bufoff, gbase, zf) do { _Pragma("unroll") for (int _i = 0; _i < 2; ++_i) { const char* _p = (const char*)(gbase) + voffA[_i]; \
        if (SHIFT) { if ((zf) && z0[_i]) _p = (const char*)zrow + lane * 16; } \
        __builtin_amdgcn_global_load_lds((const unsigned*)_p, (LAS unsigned*)(lds + (bufoff) + ldsw + _i * 8192), 16, 0, 0); } } while (0)
#define PG8_LDA(dst, b, h) do { _Pragma("unroll") for (int m = 0; m < 4; ++m) _Pragma("unroll") for (int k = 0; k < 2; ++k) dst[m][k] = *(const LAS bf16x8*)(lds + PG8_SA(b, h) + aoff + m * 2048 + k * 1024); } while (0)
#define PG8_LDB(dst, b, h) do { _Pragma("unroll") for (int n = 0; n < 2; ++n) _Pragma("unroll") for (int k = 0; k < 2; ++k) dst[n][k] = *(const LAS bf16x8*)(lds + PG8_SB(b, h) + boff + n * 2048 + k * 1024); } while (0)
#define PG8_MMA(ai, bj, At, Bt_) do { __builtin_amdgcn_s_setprio(1); _Pragma("unroll") for (int m = 0; m < 4; ++m) _Pragma("unroll") for (int n = 0; n < 2; ++n) _Pragma("unroll") for (int k = 0; k < 2; ++k) \
        acc[ai][bj][m][n] = __builtin_amdgcn_mfma_f32_16x16x32_bf16(Bt_[n][k], At[m][k], acc[ai][bj][m][n], 0, 0, 0); __builtin_amdgcn_s_setprio(0); } while (0)
#define PG8_WAIT_V(n) asm volatile("s_waitcnt vmcnt(" #n ")" ::: "memory")
#define PG8_WAIT_L(n) asm volatile("s_waitcnt lgkmcnt(" #n ")" ::: "memory")
#define PG8_BAR __builtin_amdgcn_s_barrier()
#define PG8_SCHED __builtin_amdgcn_sched_barrier(0)
#define PG8_AOFF(tau) ((size_t)(tau) * kstep - ((SHIFT && (tau) >= nt / 2) ? shiftsub : (size_t)0))
    Unit cur, nxt; int ui = 0;
    if (!S.next(0, cur)) return;
    f32x4 acc[2][2][4][2];
#pragma unroll
    for (int a = 0; a < 2; ++a)
#pragma unroll
        for (int b = 0; b < 2; ++b)
#pragma unroll
            for (int m = 0; m < 4; ++m)
#pragma unroll
                for (int n = 0; n < 2; ++n) acc[a][b][m][n] = (f32x4){0.f, 0.f, 0.f, 0.f};
    bf16x8 At[4][2], B0[2][2], B1[2][2];
    const char* cA = (const char*)(A + E.a_col(cur.pn)) + (size_t)cur.pm * tstepA; const char* cB = (const char*)Bt + (size_t)cur.pn * tstepB;
    PG8_STAGEB(PG8_SB(0, 0), cB); PG8_STAGEA(PG8_SA(0, 0), cA, false); PG8_STAGEB(PG8_SB(0, 1), cB + hstepB); PG8_STAGEA(PG8_SA(0, 1), cA + hstepA, false);
    if (wr == 1) PG8_BAR;
    PG8_WAIT_V(4); PG8_BAR;
    PG8_STAGEB(PG8_SB(1, 0), cB + kstep); PG8_STAGEA(PG8_SA(1, 0), cA + kstep, false); PG8_STAGEB(PG8_SB(1, 1), cB + hstepB + kstep);
    PG8_WAIT_V(6); PG8_BAR;
    for (;;) {
        const bool has_next = S.next(ui + 1, nxt);
        const char* nA = has_next ? (const char*)(A + E.a_col(nxt.pn)) + (size_t)nxt.pm * tstepA : cA; const char* nB = has_next ? (const char*)Bt + (size_t)nxt.pn * tstepB : cB;
        const bool seq0 = SHIFT && ((cur.pm & 15) == 0);
        for (int t = 0; t < nt; t += 2) {
            const bool last = (t == nt - 2);
            const char* a1 = cA + PG8_AOFF(t + 1);
            const char* a2 = last ? nA : cA + PG8_AOFF(t + 2); const char* b2 = last ? nB : cB + (size_t)(t + 2) * kstep;
            const char* a3 = a2 + kstep; const char* b3 = b2 + kstep;
            const bool zf = seq0 && !last && (t + 2 >= nt / 2);
            PG8_LDB(B0, 0, 0); PG8_SCHED; PG8_LDA(At, 0, 0); PG8_STAGEA(PG8_SA(1, 1), a1 + hstepA, false);
            PG8_WAIT_L(8); PG8_BAR; PG8_WAIT_L(0); PG8_MMA(0, 0, At, B0); PG8_BAR; PG8_SCHED;
            PG8_LDB(B1, 0, 1); PG8_STAGEB(PG8_SB(0, 0), b2);
            PG8_BAR; PG8_WAIT_L(0); PG8_MMA(0, 1, At, B1); PG8_BAR;
            PG8_LDA(At, 0, 1); PG8_STAGEA(PG8_SA(0, 0), a2, zf);
            PG8_BAR; PG8_WAIT_L(0); PG8_MMA(1, 0, At, B0); PG8_BAR; PG8_SCHED;
            PG8_STAGEB(PG8_SB(0, 1), b2 + hstepB);
            PG8_WAIT_V(6); PG8_BAR; PG8_MMA(1, 1, At, B1); PG8_BAR;
            PG8_LDB(B0, 1, 0); PG8_SCHED; PG8_LDA(At, 1, 0); PG8_STAGEA(PG8_SA(0, 1), a2 + hstepA, false);
            PG8_WAIT_L(8); PG8_BAR; PG8_WAIT_L(0); PG8_MMA(0, 0, At, B0); PG8_BAR; PG8_SCHED;
            PG8_LDB(B1, 1, 1); PG8_STAGEB(PG8_SB(1, 0), b3);
            PG8_BAR; PG8_WAIT_L(0); PG8_MMA(0, 1, At, B1); PG8_BAR;
            PG8_LDA(At, 1, 1); PG8_STAGEA(PG8_SA(1, 0), a3, zf);
            PG8_BAR; PG8_WAIT_L(0); PG8_MMA(1, 0, At, B0); PG8_BAR; PG8_SCHED;
            PG8_STAGEB(PG8_SB(1, 1), b3 + hstepB);
            PG8_WAIT_V(6); PG8_BAR; PG8_MMA(1, 1, At, B1); PG8_BAR;
        }
        E(acc, cur, wr, wc, fr, fq);
        if (!has_next) break;
#pragma unroll
        for (int a = 0; a < 2; ++a)
#pragma unroll
            for (int b = 0; b < 2; ++b)
#pragma unroll
                for (int m = 0; m < 4; ++m)
#pragma unroll
                    for (int n = 0; n < 2; ++n) acc[a][b][m][n] = (f32x4){0.f, 0.f, 0.f, 0.f};
        cur = nxt; cA = nA; cB = nB; ++ui;
    }
    PG8_WAIT_V(0);
    if (wr == 0) PG8_BAR;
    PG8_BAR;
#undef PG8_SA
#undef PG8_SB
#undef PG8_STAGEA
#undef PG8_STAGEB
#undef PG8_LDA
#undef PG8_LDB
#undef PG8_MMA
#undef PG8_WAIT_V
#undef PG8_WAIT_L
#undef PG8_BAR
#undef PG8_SCHED
#undef PG8_AOFF
}

__device__ __forceinline__ float wval(const Params& p, int zo, int L, int spec, int n, int k) {
    const float* win = p.in[zo + I_WIN] + (size_t)L * DM * NIN;
    if (spec == 0) {
        if (n < 1536) return win[(size_t)k * NIN + 3864 + n];
        const int s = n - 1536;
        if (s < 8) return win[(size_t)k * NIN + 1280 + s];
        if (s < 24) return win[(size_t)k * NIN + 2824 + (s - 8)];
        if (s < 56) return (L == 0) ? 0.f : p.in[zo + I_WVRES][((size_t)(L - 1) * DM + k) * 32 + (s - 24)];
        if (s < 64) return 0.f;
        if (s < 224) return win[(size_t)k * NIN + 5400 + (s - 64)];
        return 0.f;
    } else if (spec == 1) {
        const int col = n < 1280 ? n : (n < 2816 ? n + 8 : n + 24); return win[(size_t)k * NIN + col];
    } else if (spec == 2) {
        const int pn = n >> 8, ct = n & 255, bj = ct >> 7, wc = (ct >> 5) & 3, nn = (ct >> 4) & 1, r16 = ct & 15;
        return win[(size_t)k * NIN + 5560 + (2 * bj + nn) * 1024 + pn * 64 + wc * 16 + r16];
    } else if (spec == 3) {
        const int kb = n >> 10, d = n & 1023; return p.in[zo + I_WBR][(((size_t)L * 4 + kb) * 512 + k) * 1024 + d];
    } else if (spec == 4) {
        return p.in[zo + I_WOUT][((size_t)L * 1024 + k) * 1024 + n];
    } else if (spec == 5) {
        const int pn = n >> 8, ct = n & 255;
        return ct < 128 ? p.in[zo + I_FG][((size_t)L * 1024 + k) * FH + pn * 128 + ct] : p.in[zo + I_FU][((size_t)L * 1024 + k) * FH + pn * 128 + ct - 128];
    } else {
        return p.in[zo + I_FD][((size_t)L * FH + k) * 1024 + n];
    }
}
__device__ void convert_weights(const Params& p, int L, LAS float* lf, int tile0, int tile1, int ordG, int ordC) {
    int zo = 0; asm volatile("" : "+s"(zo));
    int tid_ = threadIdx.x; asm volatile("" : "+v"(tid_));
    const int tid = tid_;
    for (int tile = tile0 + ordC; tile < tile1; tile += ordG) {
        int spec, tl = tile, ktiles; size_t dofs; int K;
        if (tl < 448) { spec = 0; ktiles = 16; dofs = WB_R; K = 1024; }
        else if ((tl -= 448) < 960) { spec = 1; ktiles = 16; dofs = WB_2; K = 1024; }
        else if ((tl -= 960) < 1024) { spec = 2; ktiles = 16; dofs = WB_G; K = 1024; }
        else if ((tl -= 1024) < 512) { spec = 3; ktiles = 8; dofs = WB_B; K = 512; }
        else if ((tl -= 512) < 256) { spec = 4; ktiles = 16; dofs = WB_O; K = 1024; }
        else if ((tl -= 256) < 1408) { spec = 5; ktiles = 16; dofs = WB_F; K = 1024; }
        else { tl -= 1408; spec = 6; ktiles = 44; dofs = WB_D; K = FH; }
        const int n0 = (tl / ktiles) * 64, k0 = (tl % ktiles) * 64;
        bf16_t* dst = (bf16_t*)(p.ws + dofs);
#pragma unroll
        for (int i = 0; i < 8; ++i) { const int idx = tid + i * 512, kk = idx >> 6, nn = idx & 63; lf[kk * 65 + nn] = wval(p, zo, L, spec, n0 + nn, k0 + kk); }
        __syncthreads();
#pragma unroll
        for (int i = 0; i < 4; ++i) { const int idx = tid + i * 512, nn = idx >> 5, k2 = (idx & 31) * 2;
            *(unsigned*)(dst + (size_t)(n0 + nn) * K + k0 + k2) = cvt_pk_bf16(lf[k2 * 65 + nn], lf[(k2 + 1) * 65 + nn]); }
        __syncthreads();
    }
}

template <int DT>
__device__ void resnorm(const float* xin, const void* delta, int ldd, const float* gd, float* xout, const float* gn, bf16_t* H) {
    int tid_ = threadIdx.x; asm volatile("" : "+v"(tid_));
    const int wid = tid_ >> 6, lane = tid_ & 63;
    const int stride = gridDim.x * 8;
    int row = blockIdx.x * 8 + wid;
    f32x4 gdv[4], gnv[4];
#pragma unroll
    for (int j = 0; j < 4; ++j) { gdv[j] = (DT != 0) ? *(const f32x4*)(gd + (j * 64 + lane) * 4) : (f32x4){0.f, 0.f, 0.f, 0.f}; gnv[j] = gn ? *(const f32x4*)(gn + (j * 64 + lane) * 4) : (f32x4){0.f, 0.f, 0.f, 0.f}; }
    f32x4 nx[4], nd[4]; u32x2 nb[4];
#define RN_LOAD(r_) do { _Pragma("unroll") for (int j = 0; j < 4; ++j) { nx[j] = *(const f32x4*)(xin + (size_t)(r_) * DM + (j * 64 + lane) * 4); \
        if (DT == 1) nb[j] = *(const u32x2*)((const bf16_t*)delta + (size_t)(r_) * ldd + (j * 64 + lane) * 4); \
        if (DT == 2) nd[j] = *(const f32x4*)((const float*)delta + (size_t)(r_) * ldd + (j * 64 + lane) * 4); } } while (0)
    if (row < T) RN_LOAD(row);
    while (row < T) {
        f32x4 xv[4], dv[4];
#pragma unroll
        for (int j = 0; j < 4; ++j) { xv[j] = nx[j]; if (DT == 1) dv[j] = (f32x4){bflo(nb[j].x), bfhi(nb[j].x), bflo(nb[j].y), bfhi(nb[j].y)}; if (DT == 2) dv[j] = nd[j]; }
        const int nrow = row + stride;
        if (nrow < T) RN_LOAD(nrow);
        if (DT != 0) {
            float ss = 0.f;
#pragma unroll
            for (int j = 0; j < 4; ++j) ss += dv[j][0] * dv[j][0] + dv[j][1] * dv[j][1] + dv[j][2] * dv[j][2] + dv[j][3] * dv[j][3];
            ss = red64(ss); const float rstd = rsqrtf(ss * (1.0f / DM) + 1e-6f);
#pragma unroll
            for (int j = 0; j < 4; ++j) xv[j] += dv[j] * rstd * gdv[j];
        }
        if (xout) {
#pragma unroll
            for (int j = 0; j < 4; ++j) *(f32x4*)(xout + (size_t)row * DM + (j * 64 + lane) * 4) = xv[j];
        }
        if (gn) {
            float ss = 0.f;
#pragma unroll
            for (int j = 0; j < 4; ++j) ss += xv[j][0] * xv[j][0] + xv[j][1] * xv[j][1] + xv[j][2] * xv[j][2] + xv[j][3] * xv[j][3];
            ss = red64(ss); const float rstd = rsqrtf(ss * (1.0f / DM) + 1e-6f);
#pragma unroll
            for (int j = 0; j < 4; ++j) { const f32x4 h = xv[j] * rstd * gnv[j];
                u32x2 w; w.x = cvt_pk_bf16(h[0], h[1]); w.y = cvt_pk_bf16(h[2], h[3]); *(u32x2*)(H + (size_t)row * DM + (j * 64 + lane) * 4) = w; }
        }
        row = nrow;
    }
#undef RN_LOAD
}

constexpr int TC = 32;
typedef float f32x2 __attribute__((ext_vector_type(2)));
template <int NE, bool RW> struct StepOps { f32x4 w[NE / 4], k[NE / 4], r[NE / 4], a[RW ? NE / 4 : 1], b[RW ? NE / 4 : 1]; float v; };
template <int NE, bool RW>
__device__ __forceinline__ void step_load(StepOps<NE, RW>& o, const LAS float* base, const LAS float* opV, int vo) {
#pragma unroll
    for (int e = 0; e < NE / 4; ++e) { o.w[e] = *(const LAS f32x4*)(base + 4 * e); o.k[e] = *(const LAS f32x4*)(base + 2048 + 4 * e); o.r[e] = *(const LAS f32x4*)(base + 4096 + 4 * e);
        if (RW) { o.a[e] = *(const LAS f32x4*)(base + 6144 + 4 * e); o.b[e] = *(const LAS f32x4*)(base + 8192 + 4 * e); } }
    o.v = opV[vo];
}
#define LO2(q) ((f32x2){(q)[0], (q)[1]})
#define HI2(q) ((f32x2){(q)[2], (q)[3]})
template <int LPR, bool RW>
__device__ __forceinline__ float step_compute(f32x2 (&s)[32 / LPR], const StepOps<64 / LPR, RW>& o) {
    constexpr int NE = 64 / LPR;
    f32x2 tk[NE / 2];
    const f32x2 v2 = (f32x2){o.v, o.v};
#pragma unroll
    for (int e = 0; e < NE / 4; ++e) { tk[2 * e] = LO2(o.k[e]) * v2; tk[2 * e + 1] = HI2(o.k[e]) * v2; }
    if (RW) {
        f32x2 sa2 = (f32x2){0.f, 0.f}, sb2 = (f32x2){0.f, 0.f};
#pragma unroll
        for (int e = 0; e < NE / 4; ++e) { sa2 += s[2 * e] * LO2(o.a[e]); sb2 += s[2 * e + 1] * HI2(o.a[e]); }
        sa2 += sb2; float sa = sa2[0] + sa2[1]; sa = (LPR == 8) ? red8(sa) : red4(sa);
        const f32x2 sv = (f32x2){sa, sa};
#pragma unroll
        for (int e = 0; e < NE / 4; ++e) { tk[2 * e] += LO2(o.b[e]) * sv; tk[2 * e + 1] += HI2(o.b[e]) * sv; }
    }
    f32x2 y2 = (f32x2){0.f, 0.f}, z2 = (f32x2){0.f, 0.f};
#pragma unroll
    for (int e = 0; e < NE / 4; ++e) { s[2 * e] = s[2 * e] * LO2(o.w[e]) + tk[2 * e]; s[2 * e + 1] = s[2 * e + 1] * HI2(o.w[e]) + tk[2 * e + 1];
        y2 += s[2 * e] * LO2(o.r[e]); z2 += s[2 * e + 1] * HI2(o.r[e]); }
    y2 += z2; float y = y2[0] + y2[1]; y = (LPR == 8) ? red8(y) : red4(y);
    return y;
}
template <int LPR, bool RW>
__device__ __forceinline__ void scan_chunk(f32x2 (&s)[32 / LPR], const LAS float* opW, const LAS float* opK, const LAS float* opR, const LAS float* opA, const LAS float* opB,
                                           const LAS float* opV, LAS float* Y, int vstride, int row, int sub) {
    constexpr int NE = 64 / LPR;
    StepOps<NE, RW> o0, o1;
    unsigned bt = (unsigned)(size_t)(opW + sub * NE), bv = (unsigned)(size_t)(opV + row);
    step_load<NE, RW>(o0, (const LAS float*)(size_t)bt, (const LAS float*)(size_t)bv, 0);
#pragma unroll 1
    for (int t = 0; t < TC; t += 2) {
        asm volatile("" : "+v"(bt), "+v"(bv));
        const LAS float* b0 = (const LAS float*)(size_t)bt; const LAS float* v0 = (const LAS float*)(size_t)bv;
        step_load<NE, RW>(o1, b0 + 64, v0, vstride);
        const float y0 = step_compute<LPR, RW>(s, o0);
        step_load<NE, RW>(o0, b0 + 128, v0, 2 * vstride);
        const float y1 = step_compute<LPR, RW>(s, o1);
        Y[t * vstride + row] = y0; Y[(t + 1) * vstride + row] = y1;
        bt += 512; bv += 8 * vstride;
    }
}

__device__ void rwkv_item_old(const Params& p, int L, int item, LAS unsigned char* lds, bool dry) {
    int zo = 0; asm volatile("" : "+s"(zo));
    int tid_ = threadIdx.x; asm volatile("" : "+v"(tid_));
    const int b = item >> 3, h = item & 7, tid = tid_, wv = tid >> 6, lane = tid & 63, c = lane, hc = h * 64 + c;
    LAS bf16_t* WT = (LAS bf16_t*)lds;
    LAS bf16_t* LOSB = WT + 64 * 200;
    LAS float* AW = (LAS float*)(lds + 38400); LAS float* AA = AW + 2048; LAS float* AV = AA + 2048; LAS float* G = AV + 2048;
    LAS float* opW = G + 2048; LAS float* opK = opW + 2048; LAS float* opR = opK + 2048; LAS float* opA = opR + 2048; LAS float* opB = opA + 2048;
    LAS float* opV = opB + 2048; LAS float* Y = opV + 2048; LAS float* BON = Y + 2048; LAS float* G1 = BON + 32;
    bf16_t* P = (bf16_t*)(p.ws + OFF_P); const float* SM = (const float*)(p.ws + OFF_SM); const bf16_t* VF = (const bf16_t*)(p.ws + OFF_VF);
    __syncthreads();
    for (int i = tid; i < 192 * 64; i += 512) { const int j = i >> 6, cc = i & 63; float v;
        if (j < 32) v = p.in[zo + I_RWW2][((size_t)L * 32 + j) * 512 + h * 64 + cc];
        else if (j < 64) v = p.in[zo + I_RAW2][((size_t)L * 32 + (j - 32)) * 512 + h * 64 + cc];
        else if (j < 96) v = (L > 0) ? p.in[zo + I_RVW2][((size_t)(L - 1) * 32 + (j - 64)) * 512 + h * 64 + cc] : 0.f;
        else v = p.in[zo + I_RGW2][((size_t)L * 96 + (j - 96)) * 512 + h * 64 + cc];
        WT[cc * 200 + j] = f2bf(v); }
    const float w0 = p.in[zo + I_RW0][L * 512 + hc], a0 = p.in[zo + I_RA0][L * 512 + hc], v0 = (L > 0) ? p.in[zo + I_RV0][(L - 1) * 512 + hc] : 0.f;
    const float k_k = p.in[zo + I_RKK][L * 512 + hc], k_a = p.in[zo + I_RKA][L * 512 + hc], r_k = p.in[zo + I_RRK][L * 512 + hc], ln_g = p.in[zo + I_RLNG][L * 512 + hc], ln_b = p.in[zo + I_RLNB][L * 512 + hc];
    f32x2 s[4];
#pragma unroll
    for (int e = 0; e < 4; ++e) s[e] = (f32x2){0.f, 0.f};
    const int row = wv * 8 + (lane >> 3), sub = lane & 7;
    int smo[12];
#pragma unroll
    for (int i = 0; i < 12; ++i) { const int idx = tid + i * 512, t = idx / 192, j = idx % 192; smo[i] = t * 256 + (j < 64 ? 64 + j : (j < 96 ? j - 40 : j + 32)); }
    float nsm[12]; bf16_t nr[4], nk[4], nv[4], nf[4];
#define RWKV_LOAD_SM(chn) do { const size_t Rn = (size_t)b * SEQ + (size_t)(chn) * TC; \
        _Pragma("unroll") for (int i = 0; i < 12; ++i) nsm[i] = SM[Rn * 256 + smo[i]]; } while (0)
#define RWKV_LOAD(chn) do { const size_t Rn = (size_t)b * SEQ + (size_t)(chn) * TC; \
        _Pragma("unroll") for (int i = 0; i < 4; ++i) { const size_t R = Rn + wv * 4 + i; nr[i] = P[R * LDP + PC_RR + hc]; nk[i] = P[R * LDP + PC_RK + hc]; nv[i] = P[R * LDP + PC_RV + hc]; nf[i] = (L > 0) ? VF[R * 512 + hc] : (bf16_t)0; } } while (0)
#define RWKV_P0() do { _Pragma("unroll") for (int i = 0; i < 12; ++i) { const int idx = tid + i * 512, t = idx / 192, j = idx % 192; \
            const float v = nsm[i], e = __expf(j < 32 ? 2.0f * v : -v), rr = __builtin_amdgcn_rcpf(1.0f + e);     \
            LOSB[t * 200 + j] = f2bf(j < 32 ? 1.0f - 2.0f * rr : (j >= 96 ? rr : v)); } } while (0)
    RWKV_LOAD_SM(0); RWKV_P0(); RWKV_LOAD_SM(1); RWKV_LOAD(0);
    __syncthreads();
    for (int ch = 0; ch < SEQ / TC; ++ch) {
        const size_t R0 = (size_t)b * SEQ + (size_t)ch * TC;
        LAS float* Gc = (ch & 1) ? G1 : G;
        { const int mt = wv & 1, nt = wv >> 1; const int ao = (mt * 16 + (lane & 15)) * 200 + 8 * (lane >> 4), bo = (nt * 16 + (lane & 15)) * 200 + 8 * (lane >> 4);
            bf16x8 af[6], bfr[6];
#pragma unroll
            for (int ks = 0; ks < 6; ++ks) { af[ks] = *(const LAS bf16x8*)(LOSB + ao + ks * 32); bfr[ks] = *(const LAS bf16x8*)(WT + bo + ks * 32); }
            const f32x4 z4 = (f32x4){0.f, 0.f, 0.f, 0.f};
            const f32x4 cw = __builtin_amdgcn_mfma_f32_16x16x32_bf16(af[0], bfr[0], z4, 0, 0, 0);
            const f32x4 ca = __builtin_amdgcn_mfma_f32_16x16x32_bf16(af[1], bfr[1], z4, 0, 0, 0);
            const f32x4 cvv = __builtin_amdgcn_mfma_f32_16x16x32_bf16(af[2], bfr[2], z4, 0, 0, 0);
            f32x4 cg = __builtin_amdgcn_mfma_f32_16x16x32_bf16(af[3], bfr[3], z4, 0, 0, 0);
            cg = __builtin_amdgcn_mfma_f32_16x16x32_bf16(af[4], bfr[4], cg, 0, 0, 0);
            cg = __builtin_amdgcn_mfma_f32_16x16x32_bf16(af[5], bfr[5], cg, 0, 0, 0);
#pragma unroll
            for (int rg = 0; rg < 4; ++rg) { const int o = (mt * 16 + (lane >> 4) * 4 + rg) * 64 + nt * 16 + (lane & 15); AW[o] = cw[rg]; AA[o] = ca[rg]; AV[o] = cvv[rg]; Gc[o] = cg[rg]; } }
        __syncthreads();
        { float kkr[4], km[4], av_[4], vv[4], rr_[4], red[8];
#pragma unroll
            for (int i = 0; i < 4; ++i) { const int t = wv * 4 + i;
                av_[i] = sigmoidf_(a0 + AA[t * 64 + c]);
                const float k_ = bf2f(nk[i]); rr_[i] = bf2f(nr[i]); vv[i] = bf2f(nv[i]);
                if (L > 0) { const float vf = bf2f(nf[i]); vv[i] = vv[i] + (vf - vv[i]) * sigmoidf_(v0 + AV[t * 64 + c]); }
                kkr[i] = k_ * k_k; km[i] = k_ * (1.0f + (av_[i] - 1.0f) * k_a);
                red[i] = kkr[i] * kkr[i]; red[4 + i] = rr_[i] * km[i] * r_k; }
            red64n<8>(red);
#pragma unroll
            for (int i = 0; i < 4; ++i) { const int t = wv * 4 + i;
                const float wdec = __expf(-0.60653066f * sigmoidf_(w0 + AW[t * 64 + c]));
                const float kk = kkr[i] * rsqrtf(fmaxf(red[i], 1e-24f));
                opW[t * 64 + c] = wdec; opK[t * 64 + c] = km[i]; opR[t * 64 + c] = rr_[i]; opA[t * 64 + c] = -kk; opB[t * 64 + c] = kk * av_[i]; opV[t * 64 + c] = vv[i];
                if (lane == 0) BON[t] = red[4 + i]; } }
        if (ch + 1 < SEQ / TC) { RWKV_P0(); RWKV_LOAD(ch + 1); if (ch + 2 < SEQ / TC) RWKV_LOAD_SM(ch + 2); }
        __syncthreads();
        if (!(dry && DRY_SKIP_SCAN)) scan_chunk<8, true>(s, opW, opK, opR, opA, opB, opV, Y, 64, row, sub);
        __syncthreads();
        { float y[4], m[4], q[4];
#pragma unroll
            for (int i = 0; i < 4; ++i) { y[i] = Y[(wv * 4 + i) * 64 + c]; m[i] = y[i]; }
            red64n<4>(m);
#pragma unroll
            for (int i = 0; i < 4; ++i) { y[i] -= m[i] * (1.0f / 64.0f); q[i] = y[i] * y[i]; }
            red64n<4>(q);
#pragma unroll
            for (int i = 0; i < 4; ++i) { const int t = wv * 4 + i; const size_t R = R0 + t;
                float yn = y[i] * rsqrtf(q[i] * (1.0f / 64.0f) + 64e-5f) * ln_g + ln_b; yn += BON[t] * opV[t * 64 + c];
                if (!dry) P[R * LDP + PC_RR + hc] = f2bf(yn * Gc[t * 64 + c]); } }
    }
#undef RWKV_LOAD_SM
#undef RWKV_P0
#undef RWKV_LOAD
}


__device__ void gla_item(const Params& p, int L, int item, LAS float* lf, bool dry) {
    int zo = 0; asm volatile("" : "+s"(zo));
    int tid_ = threadIdx.x; asm volatile("" : "+v"(tid_));
    const int tid = tid_, wv = tid >> 6, lane = tid & 63, c = lane;
    LAS float* opW = lf; LAS float* opK = opW + 2048; LAS float* opR = opK + 2048; LAS float* opV = opR + 2048; LAS float* Y = opV + 2048; LAS float* X0 = Y + 2048; LAS float* X1 = X0 + 512;
    bf16_t* P = (bf16_t*)(p.ws + OFF_P); const float* SM = (const float*)(p.ws + OFF_SM);
    const int half = item & 1, bh = item >> 1, b = bh >> 2, h = bh & 3, vcol = PC_GV + h * 128 + half * 64;
    __syncthreads();
    for (int i = tid; i < 16 * 64; i += 512) X1[i] = p.in[zo + I_GAW][((size_t)L * 16 + (i >> 6)) * 256 + h * 64 + (i & 63)];
    const float ab = p.in[zo + I_GAB][L * 256 + h * 64 + c];
    f32x2 s[4];
#pragma unroll
    for (int e = 0; e < 4; ++e) s[e] = (f32x2){0.f, 0.f};
    const int row = wv * 8 + (lane >> 3), sub = lane & 7;
    float nlo; bf16_t nvv[4], nk[4], nq[4];
#define GLA_LOAD(chn) do { const size_t Rn = (size_t)b * SEQ + (size_t)(chn) * TC; nlo = SM[(Rn + (tid >> 4)) * 256 + 8 + (tid & 15)]; \
        _Pragma("unroll") for (int i = 0; i < 4; ++i) { const int idx = tid + i * 512; nvv[i] = P[(Rn + (idx >> 6)) * LDP + vcol + (idx & 63)]; } \
        _Pragma("unroll") for (int i = 0; i < 4; ++i) { const size_t R = Rn + wv * 4 + i; nk[i] = P[R * LDP + PC_GK + h * 64 + c]; nq[i] = P[R * LDP + PC_GQ + h * 64 + c]; } } while (0)
    GLA_LOAD(0);
    for (int ch = 0; ch < SEQ / TC; ++ch) {
        const size_t R0 = (size_t)b * SEQ + (size_t)ch * TC;
        X0[tid] = nlo;
#pragma unroll
        for (int i = 0; i < 4; ++i) opV[tid + i * 512] = bf2f(nvv[i]);
        bf16_t ck[4], cq[4];
#pragma unroll
        for (int i = 0; i < 4; ++i) { ck[i] = nk[i]; cq[i] = nq[i]; }
        if (ch + 1 < SEQ / TC) GLA_LOAD(ch + 1);
        __syncthreads();
#pragma unroll
        for (int i = 0; i < 4; ++i) { const int t = wv * 4 + i; float la = ab;
#pragma unroll
            for (int j = 0; j < 16; ++j) la += X0[t * 16 + j] * X1[j * 64 + c];
            opW[t * 64 + c] = __expf(__logf(sigmoidf_(la)) * (1.0f / 16.0f));
            opK[t * 64 + c] = bf2f(ck[i]); opR[t * 64 + c] = bf2f(cq[i]) * 0.125f; }
        __syncthreads();
        scan_chunk<8, false>(s, opW, opK, opR, opW, opW, opV, Y, 64, row, sub);
        __syncthreads();
        if (!dry) {
#pragma unroll
            for (int i = 0; i < 4; ++i) { const int t = wv * 4 + i; P[(R0 + t) * LDP + vcol + c] = f2bf(Y[t * 64 + c]); }
        }
    }
#undef GLA_LOAD
}

template <int MODE>
__device__ void plain_item(const Params& p, int L, int item, LAS float* lf, bool dry) {
    int zo = 0; asm volatile("" : "+s"(zo));
    int tid_ = threadIdx.x; asm volatile("" : "+v"(tid_));
    const int tid = tid_, wv = tid >> 6, lane = tid & 63, c = lane;
    constexpr int VS = (MODE == 0) ? 128 : 64;
    LAS float* opW = lf; LAS float* opK = opW + 2048; LAS float* opR = opK + 2048; LAS float* opV = opR + 2048; LAS float* Y = opV + TC * VS; LAS float* X0 = Y + TC * VS; LAS float* X1 = X0 + 2048;
    bf16_t* P = (bf16_t*)(p.ws + OFF_P); const float* SM = (const float*)(p.ws + OFF_SM);
    __syncthreads();
    if (MODE == 0) {
        const int b = item >> 2, h = item & 3;
        for (int i = tid; i < 16 * 64; i += 512) X1[i] = p.in[zo + I_GAW][((size_t)L * 16 + (i >> 6)) * 256 + h * 64 + (i & 63)];
        const float ab = p.in[zo + I_GAB][L * 256 + h * 64 + c], gn0 = p.in[zo + I_GNG][L * 128 + lane], gn1 = p.in[zo + I_GNG][L * 128 + 64 + lane];
        f32x2 s[8];
#pragma unroll
        for (int e = 0; e < 8; ++e) s[e] = (f32x2){0.f, 0.f};
        const int row = wv * 16 + (lane >> 2), sub = lane & 3;
        float nlo; bf16_t nvv[8], nk[4], nq[4], ng0[4], ng1[4];
#define GLA_LOAD(chn) do { const size_t Rn = (size_t)b * SEQ + (size_t)(chn) * TC; nlo = SM[(Rn + (tid >> 4)) * 256 + 8 + (tid & 15)]; \
        _Pragma("unroll") for (int i = 0; i < 8; ++i) { const int idx = tid + i * 512; nvv[i] = P[(Rn + (idx >> 7)) * LDP + PC_GV + h * 128 + (idx & 127)]; } \
        _Pragma("unroll") for (int i = 0; i < 4; ++i) { const size_t R = Rn + wv * 4 + i; nk[i] = P[R * LDP + PC_GK + h * 64 + c]; nq[i] = P[R * LDP + PC_GQ + h * 64 + c]; \
            ng0[i] = P[R * LDP + PC_GR + h * 128 + lane]; ng1[i] = P[R * LDP + PC_GR + h * 128 + 64 + lane]; } } while (0)
        GLA_LOAD(0);
        for (int ch = 0; ch < SEQ / TC; ++ch) {
            const size_t R0 = (size_t)b * SEQ + (size_t)ch * TC;
            X0[tid] = nlo;
#pragma unroll
            for (int i = 0; i < 8; ++i) opV[tid + i * 512] = bf2f(nvv[i]);
            bf16_t ck[4], cq[4], cg0[4], cg1[4];
#pragma unroll
            for (int i = 0; i < 4; ++i) { ck[i] = nk[i]; cq[i] = nq[i]; cg0[i] = ng0[i]; cg1[i] = ng1[i]; }
            if (ch + 1 < SEQ / TC) GLA_LOAD(ch + 1);
            __syncthreads();
#pragma unroll
            for (int i = 0; i < 4; ++i) { const int t = wv * 4 + i; float la = ab;
#pragma unroll
                for (int j = 0; j < 16; ++j) la += X0[t * 16 + j] * X1[j * 64 + c];
                opW[t * 64 + c] = __expf(__logf(sigmoidf_(la)) * (1.0f / 16.0f));
                opK[t * 64 + c] = bf2f(ck[i]); opR[t * 64 + c] = bf2f(cq[i]) * 0.125f; }
            __syncthreads();
            scan_chunk<4, false>(s, opW, opK, opR, opW, opW, opV, Y, 128, row, sub);
            __syncthreads();
#pragma unroll
            for (int i = 0; i < 4; ++i) { const int t = wv * 4 + i; const size_t R = R0 + t;
                const float y0 = Y[t * 128 + lane], y1 = Y[t * 128 + 64 + lane], ss = red64(y0 * y0 + y1 * y1), rstd = rsqrtf(ss * (1.0f / 128.0f) + 1e-6f);
                bf16_t* rp = P + R * LDP + PC_GR + h * 128;
                const float r0 = bf2f(cg0[i]), r1 = bf2f(cg1[i]);
                if (!dry) { rp[lane] = f2bf(y0 * rstd * gn0 * siluf_(r0)); rp[64 + lane] = f2bf(y1 * rstd * gn1 * siluf_(r1)); } }
        }
#undef GLA_LOAD
    } else {
        const int b = item >> 3, hh = item & 7, g = hh >> 2;
        const int chx = hh * 64 + c, chb = 512 + g * 64 + c, chc = 640 + g * 64 + c;
        const float* cw = p.in[zo + I_SCW] + (size_t)L * 4 * 768; const float* cb = p.in[zo + I_SCB] + (size_t)L * 768;
        float cwx[4], cwb[4], cwc[4];
#pragma unroll
        for (int k = 0; k < 4; ++k) { cwx[k] = cw[k * 768 + chx]; cwb[k] = cw[k * 768 + chb]; cwc[k] = cw[k * 768 + chc]; }
        const float cbx = cb[chx], cbb = cb[chb], cbc = cb[chc];
        const float dtb = p.in[zo + I_SDTB][L * 8 + hh], Aneg = -__expf(p.in[zo + I_SALOG][L * 8 + hh]), Dsk = p.in[zo + I_SD][L * 8 + hh];
        f32x2 s[4];
#pragma unroll
        for (int e = 0; e < 4; ++e) s[e] = (f32x2){0.f, 0.f};
        const int row = wv * 8 + (lane >> 3), sub = lane & 7;
        const int t0 = wv * 4;
        bf16_t nx[7], nb[7], nc[7], nz[4]; float ndt[4];
#define SSD_LOAD(chn) do { const int sp0 = (chn) * TC + t0; \
        _Pragma("unroll") for (int q = 0; q < 7; ++q) { const int sp = sp0 - 3 + q; const size_t R = (size_t)b * SEQ + sp; \
            if (sp >= 0) { nx[q] = P[R * LDP + PC_XBC + chx]; nb[q] = P[R * LDP + PC_XBC + chb]; nc[q] = P[R * LDP + PC_XBC + chc]; } else { nx[q] = 0; nb[q] = 0; nc[q] = 0; } } \
        _Pragma("unroll") for (int i = 0; i < 4; ++i) { const size_t R = (size_t)b * SEQ + sp0 + i; nz[i] = P[R * LDP + PC_Z + chx]; ndt[i] = SM[R * 256 + hh]; } } while (0)
        SSD_LOAD(0);
        for (int ch = 0; ch < SEQ / TC; ++ch) {
            const size_t R0 = (size_t)b * SEQ + (size_t)ch * TC;
            float rx[7], rb[7], rc[7], cz[4], cdt[4];
#pragma unroll
            for (int q = 0; q < 7; ++q) { rx[q] = bf2f(nx[q]); rb[q] = bf2f(nb[q]); rc[q] = bf2f(nc[q]); }
#pragma unroll
            for (int i = 0; i < 4; ++i) { cz[i] = bf2f(nz[i]); cdt[i] = ndt[i]; }
            if (ch + 1 < SEQ / TC) SSD_LOAD(ch + 1);
#pragma unroll
            for (int i = 0; i < 4; ++i) { const int t = t0 + i;
                float x = cbx, bm = cbb, cm = cbc;
#pragma unroll
                for (int k = 0; k < 4; ++k) { x += cwx[k] * rx[i + k]; bm += cwb[k] * rb[i + k]; cm += cwc[k] * rc[i + k]; }
                x = siluf_(x); bm = siluf_(bm); cm = siluf_(cm);
                const float dt = softplusf_(cdt[i] + dtb);
                opW[t * 64 + c] = __expf(dt * Aneg); opK[t * 64 + c] = bm; opR[t * 64 + c] = cm; opV[t * 64 + c] = dt * x; X0[t * 64 + c] = x; }
            __syncthreads();
            scan_chunk<8, false>(s, opW, opK, opR, opW, opW, opV, Y, 64, row, sub);
            __syncthreads();
#pragma unroll
            for (int i = 0; i < 4; ++i) { const int t = t0 + i; const size_t R = R0 + t;
                const float y = Y[t * 64 + c] + Dsk * X0[t * 64 + c];
                if (!dry) P[R * LDP + PC_Z + chx] = f2bf(y * siluf_(cz[i])); }
            __syncthreads();
        }
#undef SSD_LOAD
    }
}

__device__ void lru_item(const Params& p, int L, int item, LAS float* lf, bool dry) {
    int zo = 0; asm volatile("" : "+s"(zo));
    int tid_ = threadIdx.x; asm volatile("" : "+v"(tid_));
    const int b = item >> 3, blk = item & 7, tid = tid_, wv = tid >> 6, lane = tid & 63, c = lane, cbi = blk * 64 + c;
    LAS float* wa = lf; LAS float* wx = wa + 4096; LAS float* XB = wx + 4096; LAS float* A_ = XB + 2048; LAS float* U_ = A_ + 2048; LAS float* HS = U_ + 2048;
    bf16_t* P = (bf16_t*)(p.ws + OFF_P);
    __syncthreads();
    for (int i = tid; i < 4096; i += 512) { wa[i] = p.in[zo + I_LWA][((size_t)L * 8 + blk) * 4096 + i]; wx[i] = p.in[zo + I_LWX][((size_t)L * 8 + blk) * 4096 + i]; }
    float cwv[4];
#pragma unroll
    for (int k = 0; k < 4; ++k) cwv[k] = p.in[zo + I_LCW][((size_t)L * 4 + k) * 512 + cbi];
    const float cbv = p.in[zo + I_LCB][L * 512 + cbi], ba = p.in[zo + I_LBA][L * 512 + cbi], bx = p.in[zo + I_LBX][L * 512 + cbi];
    const float spl = softplusf_(-p.in[zo + I_LLAM][L * 512 + cbi]);
    float hstate = 0.f;
    const int t0 = wv * 4;
    bf16_t nx[7], ngt[4];
#define LRU_LOAD(chn) do { const int sp0 = (chn) * TC + t0; \
        _Pragma("unroll") for (int q = 0; q < 7; ++q) { const int sp = sp0 - 3 + q; nx[q] = (sp >= 0) ? P[((size_t)b * SEQ + sp) * LDP + PC_LX + cbi] : (bf16_t)0; } \
        _Pragma("unroll") for (int i = 0; i < 4; ++i) ngt[i] = P[((size_t)b * SEQ + sp0 + i) * LDP + PC_LG + cbi]; } while (0)
    LRU_LOAD(0);
    for (int ch = 0; ch < SEQ / TC; ++ch) {
        const size_t R0 = (size_t)b * SEQ + (size_t)ch * TC;
        float rx[7], cg[4];
#pragma unroll
        for (int q = 0; q < 7; ++q) rx[q] = bf2f(nx[q]);
#pragma unroll
        for (int i = 0; i < 4; ++i) cg[i] = bf2f(ngt[i]);
        if (ch + 1 < SEQ / TC) LRU_LOAD(ch + 1);
        float xb[4];
#pragma unroll
        for (int i = 0; i < 4; ++i) { float x = cbv;
#pragma unroll
            for (int k = 0; k < 4; ++k) x += cwv[k] * rx[i + k];
            xb[i] = x; XB[(t0 + i) * 64 + c] = x; }
        __syncthreads();
        float ar[4] = {ba, ba, ba, ba}, ai[4] = {bx, bx, bx, bx};
#pragma unroll 4
        for (int j4 = 0; j4 < 16; ++j4) {
            float wra[4], wrx[4];
#pragma unroll
            for (int e = 0; e < 4; ++e) { wra[e] = wa[(j4 * 4 + e) * 64 + c]; wrx[e] = wx[(j4 * 4 + e) * 64 + c]; }
#pragma unroll
            for (int i = 0; i < 4; ++i) { const f32x4 x4 = *(const LAS f32x4*)(XB + (t0 + i) * 64 + j4 * 4);
                ar[i] += x4[0] * wra[0] + x4[1] * wra[1] + x4[2] * wra[2] + x4[3] * wra[3]; ai[i] += x4[0] * wrx[0] + x4[1] * wrx[1] + x4[2] * wrx[2] + x4[3] * wrx[3]; }
        }
#pragma unroll
        for (int i = 0; i < 4; ++i) { const float r = sigmoidf_(ar[i]), ig = sigmoidf_(ai[i]), la = -8.0f * r * spl, a = __expf(la);
            const float u = sqrtf(fmaxf(1.0f - a * a, 0.f)) * (ig * xb[i]);
            A_[(t0 + i) * 64 + c] = a; U_[(t0 + i) * 64 + c] = u; }
        __syncthreads();
        if (wv == 0) {
#pragma unroll 8
            for (int t = 0; t < TC; ++t) { hstate = A_[t * 64 + c] * hstate + U_[t * 64 + c]; HS[t * 64 + c] = hstate; }
        }
        __syncthreads();
#pragma unroll
        for (int i = 0; i < 4; ++i) { const size_t R = R0 + t0 + i; const float g = cg[i];
            const float u2 = 1.5957691216f * (g + 0.044715f * g * g * g);
            if (!dry) P[R * LDP + PC_LG + cbi] = f2bf(HS[(t0 + i) * 64 + c] * g * sigmoidf_(u2)); }
    }
#undef LRU_LOAD
}

__device__ void ssd_post(const Params& p, int L, int ordG, int ordC) {
    int zo = 0; asm volatile("" : "+s"(zo));
    int tid_ = threadIdx.x; asm volatile("" : "+v"(tid_));
    const int wid = tid_ >> 6, lane = tid_ & 63;
    bf16_t* P = (bf16_t*)(p.ws + OFF_P);
    const f32x4 g0 = *(const f32x4*)(p.in[zo + I_SNG] + L * 512 + lane * 8), g1 = *(const f32x4*)(p.in[zo + I_SNG] + L * 512 + lane * 8 + 4);
    const f32x4 gg0 = *(const f32x4*)(p.in[zo + I_GNG] + L * 128 + (lane & 15) * 8), gg1 = *(const f32x4*)(p.in[zo + I_GNG] + L * 128 + (lane & 15) * 8 + 4);
    for (int row = ordC * 8 + wid; row < T; row += ordG * 8) {
        u32x4* pp = (u32x4*)(P + (size_t)row * LDP + PC_Z + lane * 8); const u32x4 w = *pp;
        float v[8] = {bflo(w.x), bfhi(w.x), bflo(w.y), bfhi(w.y), bflo(w.z), bfhi(w.z), bflo(w.w), bfhi(w.w)};
        float ss = 0.f;
#pragma unroll
        for (int j = 0; j < 8; ++j) ss += v[j] * v[j];
        ss = red32(ss); const float rstd = rsqrtf(ss * (1.0f / 256.0f) + 1e-6f);
        u32x4 o; o.x = cvt_pk_bf16(v[0] * rstd * g0[0], v[1] * rstd * g0[1]); o.y = cvt_pk_bf16(v[2] * rstd * g0[2], v[3] * rstd * g0[3]);
        o.z = cvt_pk_bf16(v[4] * rstd * g1[0], v[5] * rstd * g1[1]); o.w = cvt_pk_bf16(v[6] * rstd * g1[2], v[7] * rstd * g1[3]);
        *pp = o;
        if (!GLA_SPLIT) continue;
        u32x4* gp = (u32x4*)(P + (size_t)row * LDP + PC_GR + lane * 8); const u32x4 yw = *(const u32x4*)(P + (size_t)row * LDP + PC_GV + lane * 8), rw = *gp;
        float y[8] = {bflo(yw.x), bfhi(yw.x), bflo(yw.y), bfhi(yw.y), bflo(yw.z), bfhi(yw.z), bflo(yw.w), bfhi(yw.w)};
        float rg[8] = {bflo(rw.x), bfhi(rw.x), bflo(rw.y), bfhi(rw.y), bflo(rw.z), bfhi(rw.z), bflo(rw.w), bfhi(rw.w)};
        float s2 = 0.f;
#pragma unroll
        for (int j = 0; j < 8; ++j) s2 += y[j] * y[j];
        s2 = red16(s2); const float rs2 = rsqrtf(s2 * (1.0f / 128.0f) + 1e-6f);
        float og[8];
#pragma unroll
        for (int j = 0; j < 8; ++j) og[j] = y[j] * rs2 * (j < 4 ? gg0[j] : gg1[j - 4]) * siluf_(rg[j]);
        u32x4 o2; o2.x = cvt_pk_bf16(og[0], og[1]); o2.y = cvt_pk_bf16(og[2], og[3]); o2.z = cvt_pk_bf16(og[4], og[5]); o2.w = cvt_pk_bf16(og[6], og[7]);
        *gp = o2;
    }
}


__device__ __forceinline__ void b1_fixup(const Params& p, int L, const bf16_t* stp, const float* sts) {
    int zo = 0; asm volatile("" : "+s"(zo));
    int tid_ = threadIdx.x; asm volatile("" : "+v"(tid_));
    bf16_t* P = (bf16_t*)(p.ws + OFF_P); float* SM = (float*)(p.ws + OFF_SM); bf16_t* VF = (bf16_t*)(p.ws + OFF_VF);
    const float* mu = p.in[zo + I_RMU] + L * 1696;
    for (int idx = blockIdx.x * 512 + tid_; idx < 512 * 1792; idx += gridDim.x * 512) {
        const int g = idx / 1792, c = idx % 1792; const size_t R = (size_t)g * 64; const bool first = (R % SEQ) == 0;
        if (c < 1536) { const float cur = bf2f(P[R * LDP + PC_RR + c]), prev = first ? 0.f : bf2f(stp[(size_t)(g - 1) * 1536 + c]);
            const bf16_t o = f2bf(cur + (prev - cur) * mu[c]); P[R * LDP + PC_RR + c] = o; if (L == 0 && c >= 1024) VF[R * 512 + c - 1024] = o; }
        else { const int sc = c - 1536; const float m = (sc >= 64 && sc < 224) ? mu[1536 + sc - 64] : 0.f;
            const float cur = SM[R * 256 + sc], prev = first ? 0.f : sts[(size_t)(g - 1) * 256 + sc]; SM[R * 256 + sc] = cur + (prev - cur) * m; }
    }
}

#define XB_TMO      128
#define XB_XCNT(j)  (256  + 64 * (j))
#define XB_XSUB(j)  (1280 + 64 * (j))
#define XB_XGEN(j)  (2304 + 64 * (j))
#define XB_TOP      3328
#define XB_TOPGEN   3392
#define XCD_BAR_WORDS 3456
#define XB_SPIN_CAP (1u << 22)
__device__ __forceinline__ unsigned xb_ld(unsigned* p)              { return __hip_atomic_load(p, __ATOMIC_RELAXED, __HIP_MEMORY_SCOPE_AGENT); }
__device__ __forceinline__ unsigned xb_add(unsigned* p, unsigned v) { return __hip_atomic_fetch_add(p, v, __ATOMIC_RELAXED, __HIP_MEMORY_SCOPE_AGENT); }
__device__ __forceinline__ unsigned xb_xcc_id() { return (unsigned)__builtin_amdgcn_s_getreg((3 << 11) | 20) & 0xFu; }
#define XB_SPIN(cond, bar) do { unsigned _sp = 0; while (cond) { __builtin_amdgcn_s_sleep(1); \
    if ((++_sp & 255u) == 0u) { if (xb_ld(&(bar)[XB_TMO])) break; if (_sp > XB_SPIN_CAP) { atomicAdd(&(bar)[XB_TMO], 1u); break; } } } } while (0)
struct XcdBarrier { unsigned* bar; unsigned x; volatile LAS unsigned* st; };
__device__ __forceinline__ XcdBarrier xcd_barrier_post(unsigned* bar, volatile LAS unsigned* st) {
    XcdBarrier b; b.bar = bar; b.x = xb_xcc_id(); b.st = st;
    if (threadIdx.x == 0) (void)xb_add(&bar[XB_XCNT(b.x)], 1u);
    return b;
}
__device__ __forceinline__ void xcd_barrier_complete(unsigned* bar, unsigned x, unsigned& nloc, unsigned& nx) {
    const unsigned G = gridDim.x * gridDim.y * gridDim.z;
    unsigned sum, cnt, mine, sp = 0u;
    for (;;) {
        sum = 0u; cnt = 0u; mine = 0u;
#pragma unroll
        for (unsigned j = 0; j < 16; ++j) { const unsigned c = xb_ld(&bar[XB_XCNT(j)]); sum += c; cnt += (c > 0u) ? 1u : 0u; mine = (j == x) ? c : mine; }
        if (sum == G) break;
        __builtin_amdgcn_s_sleep(1);
        if ((++sp & 255u) == 0u) { if (xb_ld(&bar[XB_TMO])) break; if (sp > XB_SPIN_CAP) { atomicAdd(&bar[XB_TMO], 1u); break; } }
    }
    nloc = mine > 0u ? mine : 1u; nx = cnt > 0u ? cnt : 1u;
}
__device__ __attribute__((noinline)) void xcd_barrier(const XcdBarrier b) {
    asm volatile("s_waitcnt vmcnt(0)" ::: "memory");
    __syncthreads();
    if (threadIdx.x == 0) {
        unsigned* bar = b.bar;
        __builtin_amdgcn_s_waitcnt(0);
        unsigned nloc = b.st[0], nx = b.st[1];
        if (nloc == 0u) { xcd_barrier_complete(bar, b.x, nloc, nx); b.st[0] = nloc; b.st[1] = nx; }
        const unsigned old = xb_add(&bar[XB_XSUB(b.x)], 1u);
        const unsigned gen = old / nloc;
        if (old + 1u == (gen + 1u) * nloc) {
            __builtin_amdgcn_fence(__ATOMIC_RELEASE, "agent");
            asm volatile("s_waitcnt vmcnt(0)" ::: "memory");
            const unsigned og = xb_add(&bar[XB_TOP], 1u);
            const unsigned tg = og / nx;
            if (og + 1u == (tg + 1u) * nx) xb_add(&bar[XB_TOPGEN], 1u);
            else XB_SPIN(xb_ld(&bar[XB_TOPGEN]) == tg, bar);
            __builtin_amdgcn_fence(__ATOMIC_ACQUIRE, "agent");
            xb_add(&bar[XB_XGEN(b.x)], 1u);
            asm volatile("s_waitcnt vmcnt(0)" ::: "memory");
        } else {
            XB_SPIN(xb_ld(&bar[XB_XGEN(b.x)]) == gen, bar);
            __builtin_amdgcn_fence(__ATOMIC_ACQUIRE, "agent");
            asm volatile("s_waitcnt vmcnt(0)" ::: "memory");
        }
    }
    __syncthreads();
}

__device__ __attribute__((noinline)) void sub_barrier(unsigned* word, unsigned n) {
    asm volatile("s_waitcnt vmcnt(0)" ::: "memory");
    __syncthreads();
    if (threadIdx.x == 0) {
        __builtin_amdgcn_fence(__ATOMIC_RELEASE, "agent");
        asm volatile("s_waitcnt vmcnt(0)" ::: "memory");
        (void)xb_add(word, 1u);
        unsigned sp = 0;
        while (xb_ld(word) < n) { __builtin_amdgcn_s_sleep(2); if (++sp > (1u << 24)) break; }
        __builtin_amdgcn_fence(__ATOMIC_ACQUIRE, "agent");
        asm volatile("s_waitcnt vmcnt(0)" ::: "memory");
    }
    __syncthreads();
}

__global__ __launch_bounds__(512) void mega(Params p) {
    extern __shared__ __attribute__((aligned(16))) unsigned char smem[];
    cg::grid_group grid = cg::this_grid();
    LAS unsigned char* lds = (LAS unsigned char*)smem; LAS float* lf = (LAS float*)smem;
    unsigned char* ws = p.ws;
    int zo = 0; asm volatile("" : "+s"(zo));
    bf16_t* H = (bf16_t*)(ws + OFF_H); bf16_t* P = (bf16_t*)(ws + OFF_P); float* SM = (float*)(ws + OFF_SM); bf16_t* VF = (bf16_t*)(ws + OFF_VF);
    const bf16_t* zrow = (const bf16_t*)(ws + OFF_Z);
    volatile LAS unsigned* xst = (volatile LAS unsigned*)(lds + LDS_BYTES - 16);
    if (threadIdx.x == 0) { xst[0] = 0u; xst[1] = 0u; }
    __syncthreads();
    const XcdBarrier xb = xcd_barrier_post((unsigned*)(ws + OFF_BAR), xst);
    float* X = p.out;
    bf16_t* ACT = P; float* FO = (float*)(ws + OFF_P + 176 * MiB);
    const int G = (int)gridDim.x, bid = (int)blockIdx.x;
    unsigned* subw = (unsigned*)(ws + OFF_BAR) + 3584;
    if (blockIdx.x == 0) for (int i = threadIdx.x; i < 1024; i += 512) ((unsigned*)(ws + OFF_Z))[i] = 0u;
    convert_weights(p, 0, lf, 0, 1408, G, bid);
    resnorm<0>(p.in[zo + I_X], nullptr, 0, nullptr, nullptr, p.in[zo + I_NG] + 0, H);
    grid.sync();
    for (int L = 0; L < 2; ++L) {
        asm volatile("" : "+s"(zo));
        const float* ng = p.in[zo + I_NG] + (size_t)L * 4 * DM;
        const float* xin = (L == 0) ? p.in[zo + I_X] : X;
        { Epi<EPI_B1> e{}; e.o16 = P; e.o32 = SM; e.vf = (L == 0) ? VF : nullptr; e.mu = p.in[zo + I_RMU] + L * 1696; e.stp = (bf16_t*)(ws + WB_R + 7 * MiB / 2); e.sts = (float*)(ws + WB_R + 5 * MiB);
          gemm_phase<Epi<EPI_B1>, false>(lds, H, DM, (const bf16_t*)(ws + WB_R), T, 1792, 1024, e, zrow, G, bid); }
        xcd_barrier(xb);
        b1_fixup(p, L, (const bf16_t*)(ws + WB_R + 7 * MiB / 2), (const float*)(ws + WB_R + 5 * MiB));
        xcd_barrier(xb);
        {
            const int NR = 64, NO = G - NR;
            if (bid < NR) {
                for (int item = bid; item < 64; item += NR) rwkv_item_old(p, L, item, lds, false);
            } else {
                const int oc = bid - NR;
                { Epi<EPI_B2> e{}; e.o16 = P; gemm_phase<Epi<EPI_B2>, false>(lds, H, DM, (const bf16_t*)(ws + WB_2), T, 3840, 1024, e, zrow, NO, oc); }
                sub_barrier(subw + (L * 2 + 0) * 64, (unsigned)NO);
                for (int item = oc; item < 192; item += NO) {
                    if (item < 64) gla_item(p, L, item, lf, false);
                    else if (item < 128) plain_item<1>(p, L, item - 64, lf, false);
                    else lru_item(p, L, item - 128, lf, false);
                }
                sub_barrier(subw + (L * 2 + 1) * 64, (unsigned)NO);
                ssd_post(p, L, NO, oc);
                convert_weights(p, L, lf, 1408, 5312, NO, oc);
                if (L == 0) convert_weights(p, 1, lf, 0, 1408, NO, oc);
            }
        }
        xcd_barrier(xb);
        bf16_t* U = (L == 0) ? (bf16_t*)p.out : (bf16_t*)(ws + OFF_SM);
        for (int q = 0; q < 4; ++q) {
            { Epi<EPI_U> e{}; e.o16 = U; gemm_phase<Epi<EPI_U>, false>(lds, P + (size_t)q * 8192 * LDP, LDP, (const bf16_t*)(ws + WB_B), 8192, 4096, 512, e, zrow, G, bid); }
            xcd_barrier(xb);
            { Epi<EPI_MERGE> e{}; e.o16 = P + (size_t)q * 8192 * LDP; e.uq = U; gemm_phase<Epi<EPI_MERGE>, false>(lds, H + (size_t)q * 8192 * DM, DM, (const bf16_t*)(ws + WB_G), 8192, 4096, 1024, e, zrow, G, bid); }
            xcd_barrier(xb);
        }
        { Epi<EPI_O> e{}; e.o16 = P; gemm_phase<Epi<EPI_O>, false>(lds, P + PC_MERGED, LDP, (const bf16_t*)(ws + WB_O), T, 1024, 1024, e, zrow, G, bid); }
        xcd_barrier(xb);
        resnorm<1>(xin, P + PC_O, LDP, ng + DM, X, ng + 2 * DM, H);
        xcd_barrier(xb);
        { Epi<EPI_FFN> e{}; e.o16 = ACT; gemm_phase<Epi<EPI_FFN>, false>(lds, H, DM, (const bf16_t*)(ws + WB_F), T, 5632, 1024, e, zrow, G, bid); }
        xcd_barrier(xb);
        { Epi<EPI_DOWN> e{}; e.o16 = (bf16_t*)FO; gemm_phase<Epi<EPI_DOWN>, false>(lds, ACT, FH, (const bf16_t*)(ws + WB_D), T, 1024, FH, e, zrow, G, bid); }
        xcd_barrier(xb);
        if (L == 0) {
            resnorm<1>(X, FO, DM, ng + 3 * DM, X, p.in[zo + I_NG] + 4 * DM, H);
            xcd_barrier(xb);
        } else {
            resnorm<1>(X, FO, DM, ng + 3 * DM, X, nullptr, nullptr);
        }
    }
}

extern "C" void kernel_launch(void* const* d_in, const int* in_sizes, int n_in, void* d_out, int out_size, void* d_ws, size_t ws_size, hipStream_t stream) {
    static int grid_blocks = 0;
    if (grid_blocks == 0) {
        if (n_in != N_INPUTS || out_size != T * DM || ws_size < WS_END) { fprintf(stderr, "kernel_launch: unexpected problem (n_in %d, out %d, ws %zu)\n", n_in, out_size, ws_size); grid_blocks = -1; return; }
        int dev = 0, cus = 0, per_cu = 0;
        (void)hipGetDevice(&dev); (void)hipDeviceGetAttribute(&cus, hipDeviceAttributeMultiprocessorCount, dev);
        if (hipFuncSetAttribute((const void*)mega, hipFuncAttributeMaxDynamicSharedMemorySize, LDS_BYTES) != hipSuccess) { fprintf(stderr, "kernel_launch: hipFuncSetAttribute failed\n"); grid_blocks = -1; return; }
        if (hipOccupancyMaxActiveBlocksPerMultiprocessor(&per_cu, (const void*)mega, 512, LDS_BYTES) != hipSuccess || per_cu < 1) { fprintf(stderr, "kernel_launch: occupancy query says %d\n", per_cu); per_cu = 1; }
        (void)hipGetLastError();
        grid_blocks = cus * 1;
        if (grid_blocks < 128) { fprintf(stderr, "kernel_launch: needs at least 128 CUs\n"); grid_blocks = -1; return; }
    }
    if (grid_blocks < 0) return;
    if (hipMemsetAsync((char*)d_ws + OFF_BAR, 0, 4096 * 4, stream) != hipSuccess) { fprintf(stderr, "kernel_launch: memset failed\n"); return; }
    Params p{};
    for (int i = 0; i < N_INPUTS; ++i) p.in[i] = (const float*)d_in[i];
    p.out = (float*)d_out; p.ws = (unsigned char*)d_ws;
    void* args[] = {&p};
    hipError_t e = hipLaunchCooperativeKernel((const void*)mega, dim3(grid_blocks), dim3(512), args, LDS_BYTES, stream);
    if (e != hipSuccess) fprintf(stderr, "cooperative launch failed: %s (grid %d)\n", hipGetErrorString(e), grid_blocks);
}
```

```cpp
#include <hip/hip_runtime.h>
#include <hip/hip_cooperative_groups.h>
#include <cstdio>
namespace cg = cooperative_groups;

#define LAS __attribute__((address_space(3)))
typedef unsigned short bf16_t;
typedef short bf16x8 __attribute__((ext_vector_type(8)));
typedef float f32x4 __attribute__((ext_vector_type(4)));
typedef unsigned u32x4 __attribute__((ext_vector_type(4)));
typedef unsigned u32x2 __attribute__((ext_vector_type(2)));

constexpr int NB = 8, SEQ = 4096, T = NB * SEQ, DM = 1024, NIN = 9656, FH = 2816, LDP = 5376;
constexpr int BM = 256, BK = 64, HALF = 128, HTB = HALF * BK * 2, STAGE_BYTES = 8 * HTB, NXCD = 8, WGM = 8;
constexpr int LDS_BYTES = 144 * 1024;
constexpr bool DRY_SKIP_SCAN = false;
constexpr bool GLA_SPLIT = true;
constexpr int DRY_MASK = 15;
constexpr int REP_GEMM = 1, REP_SCAN = 0, REP_SYNC = 1, REP_CONV = 1, REP_NORM = 1;
constexpr size_t MiB = 1u << 20;
constexpr size_t WB_R = 0, WB_2 = 7 * MiB, WB_G = WB_2 + 15 * MiB / 2, WB_B = WB_G + 8 * MiB, WB_O = WB_B + 4 * MiB, WB_F = WB_O + 2 * MiB, WB_D = WB_F + 11 * MiB;
constexpr size_t OFF_Z = 45 * MiB, OFF_H = 46 * MiB, OFF_P = 110 * MiB, OFF_SM = 446 * MiB, OFF_VF = 478 * MiB, OFF_BAR = 510 * MiB, OFF_BON = 510 * MiB + 65536, WS_END = OFF_BON + MiB;
constexpr int PC_Z = 0, PC_XBC = 512, PC_GQ = 1280, PC_GK = 1536, PC_GV = 1792, PC_GR = 2304, PC_LX = 2816, PC_LG = 3328, PC_RR = 3840, PC_RK = 4352, PC_RV = 4864;
constexpr int PC_MERGED = 1280, PC_O = 4352;

enum { I_X = 0, I_NG, I_WIN, I_WVRES, I_SCW, I_SCB, I_SDTB, I_SALOG, I_SD, I_SNG, I_GAW, I_GAB, I_GNG, I_LCW, I_LCB, I_LWA, I_LBA, I_LWX, I_LBX, I_LLAM,
       I_RMU, I_RW0, I_RWW2, I_RA0, I_RAW2, I_RV0, I_RVW2, I_RGW2, I_RKK, I_RKA, I_RRK, I_RLNG, I_RLNB, I_WBR, I_WOUT, I_FG, I_FU, I_FD, N_INPUTS };

struct Params { const float* in[N_INPUTS]; float* out; unsigned char* ws; };

__device__ __forceinline__ unsigned cvt_pk_bf16(float lo, float hi) { unsigned r; asm volatile("v_cvt_pk_bf16_f32 %0, %1, %2" : "=v"(r) : "v"(lo), "v"(hi)); return r; }
__device__ __forceinline__ float bf2f(bf16_t v) { return __uint_as_float((unsigned)v << 16); }
__device__ __forceinline__ float bflo(unsigned v) { return __uint_as_float(v << 16); }
__device__ __forceinline__ float bfhi(unsigned v) { return __uint_as_float(v & 0xffff0000u); }
__device__ __forceinline__ bf16_t f2bf(float v) { return (bf16_t)(cvt_pk_bf16(v, 0.f) & 0xffffu); }
__device__ __forceinline__ float sigmoidf_(float x) { return __builtin_amdgcn_rcpf(1.0f + __expf(-x)); }
__device__ __forceinline__ float siluf_(float x) { return x * sigmoidf_(x); }
__device__ __forceinline__ float softplusf_(float x) { return fmaxf(x, 0.f) + log1pf(__expf(-fabsf(x))); }
template <int CTRL> __device__ __forceinline__ float dpp_add(float x) { int v = __builtin_amdgcn_update_dpp(0, __float_as_int(x), CTRL, 0xF, 0xF, true); return x + __int_as_float(v); }
__device__ __forceinline__ float red4(float x) { x = dpp_add<0xB1>(x); x = dpp_add<0x4E>(x); return x; }
__device__ __forceinline__ float red8(float x) { x = red4(x); x = dpp_add<0x141>(x); return x; }
__device__ __forceinline__ float red16(float x) { x = red8(x); x = dpp_add<0x140>(x); return x; }
__device__ __forceinline__ float red32(float x) { x = red16(x); x += __shfl_xor(x, 16); return x; }
__device__ __forceinline__ float red64(float x) { x = red32(x); x += __shfl_xor(x, 32); return x; }
template <int N> __device__ __forceinline__ void red64n(float (&v)[N]) {
#pragma unroll
    for (int i = 0; i < N; ++i) v[i] = red16(v[i]);
    float t[N];
#pragma unroll
    for (int i = 0; i < N; ++i) t[i] = __shfl_xor(v[i], 16);
#pragma unroll
    for (int i = 0; i < N; ++i) v[i] += t[i];
#pragma unroll
    for (int i = 0; i < N; ++i) t[i] = __shfl_xor(v[i], 32);
#pragma unroll
    for (int i = 0; i < N; ++i) v[i] += t[i];
}

__device__ __forceinline__ int lds_byte(int r, int c) { const int st = (r >> 4) * 2 + (c >> 5), rr = r & 15, cc = c & 31, ob = rr * 64 + cc * 2; return st * 1024 + (ob ^ (((ob >> 9) & 1) << 5)); }
__device__ __forceinline__ void stage_rc(int b, int& R, int& C) { const int st = b / 1024, sb = b % 1024, swz = sb ^ (((sb >> 9) & 1) << 5); R = (st >> 1) * 16 + swz / 64; C = (st & 1) * 32 + (swz % 64) / 2; }
__device__ __forceinline__ int perm32(int rho) { const int n = rho >> 4, i = rho & 15; return 8 * (i >> 2) + 4 * n + (i & 3); }
struct Unit { int pm, pn; };
struct Order {
    int nM, nN, nwg, G, c;
    __device__ void init(int M, int N, int G_, int c_) { nM = M / BM; nN = N / BM; nwg = nM * nN; G = G_; c = c_; }
    __device__ bool next(int i, Unit& u) const {
        const long L = (long)i * G + c; if (L >= nwg) return false;
        int wgid = (int)L; { const int q = nwg / NXCD, r = nwg % NXCD, xcd = wgid % NXCD, off = wgid / NXCD; wgid = (xcd < r ? xcd * (q + 1) : r * (q + 1) + (xcd - r) * q) + off; }
        const int nig = WGM * nN, gid = wgid / nig, fm = gid * WGM, gsz = (nM - fm) < WGM ? (nM - fm) : WGM;
        u.pm = fm + ((wgid % nig) % gsz); u.pn = (wgid % nig) / gsz; return true;
    }
};

enum { EPI_B2 = 0, EPI_B1, EPI_U, EPI_MERGE, EPI_O, EPI_FFN, EPI_DOWN };
template <int MODE> struct Epi {
    static constexpr bool PERM = (MODE != EPI_MERGE);
    bf16_t* o16; float* o32; const bf16_t* uq; bf16_t* vf; const float* mu; bf16_t* stp; float* sts;
    __device__ __forceinline__ int a_col(int pn) const { if (MODE == EPI_U) { const int k = pn >> 2; return k == 0 ? PC_Z : (k == 1 ? PC_GR : (k == 2 ? PC_LG : PC_RR)); } return 0; }
    __device__ __forceinline__ void operator()(const f32x4 (&acc)[2][2][4][2], const Unit& u, int wr, int wc, int fr, int fq) const {
        const int row0 = u.pm * BM + wr * 64 + fr;
        if constexpr (MODE == EPI_B1) {
            const bool small = (u.pn == 6);
#pragma unroll
            for (int bj = 0; bj < 2; ++bj) {
                const int cb = u.pn * BM + bj * HALF + wc * 32 + 8 * fq;
                float mu8[8];
#pragma unroll
                for (int e = 0; e < 8; ++e) { const int sc = cb + e - 1536; mu8[e] = !small ? mu[cb + e] : ((sc >= 64 && sc < 224) ? mu[1536 + sc - 64] : 0.f); }
#pragma unroll
                for (int ai = 0; ai < 2; ++ai)
#pragma unroll
                    for (int m = 0; m < 4; ++m) { const size_t r = (size_t)(row0 + ai * HALF + m * 16); float o[8], raw[8];
#pragma unroll
                        for (int e = 0; e < 8; ++e) { const float cur = acc[ai][bj][m][e >> 2][e & 3]; raw[e] = cur;
                            const float p1 = __int_as_float(__builtin_amdgcn_update_dpp(0, __float_as_int(cur), 0x111, 0xF, 0xF, true));
                            float p0 = 0.f; if (m > 0) p0 = __int_as_float(__builtin_amdgcn_update_dpp(0, __float_as_int(acc[ai][bj][m > 0 ? m - 1 : 0][e >> 2][e & 3]), 0x121, 0xF, 0xF, true));
                            const float prev = (fr == 0) ? p0 : p1, lerp = cur + (prev - cur) * mu8[e];
                            o[e] = (fr == 0 && m == 0) ? cur : lerp; }
                        if (small) { float* rp = o32 + r * 256 + (cb - 1536); *(f32x4*)rp = (f32x4){o[0], o[1], o[2], o[3]}; *(f32x4*)(rp + 4) = (f32x4){o[4], o[5], o[6], o[7]}; }
                        else { u32x4 w; w.x = cvt_pk_bf16(o[0], o[1]); w.y = cvt_pk_bf16(o[2], o[3]); w.z = cvt_pk_bf16(o[4], o[5]); w.w = cvt_pk_bf16(o[6], o[7]);
                            *(u32x4*)(o16 + r * LDP + PC_RR + cb) = w; if (vf != nullptr && u.pn >= 4) *(u32x4*)(vf + r * 512 + (cb - 1024)) = w; }
                        if (m == 3 && fr == 15) { const size_t g = r >> 6;
                            if (small) { float* sp = sts + g * 256 + (cb - 1536); *(f32x4*)sp = (f32x4){raw[0], raw[1], raw[2], raw[3]}; *(f32x4*)(sp + 4) = (f32x4){raw[4], raw[5], raw[6], raw[7]}; }
                            else { u32x4 w; w.x = cvt_pk_bf16(raw[0], raw[1]); w.y = cvt_pk_bf16(raw[2], raw[3]); w.z = cvt_pk_bf16(raw[4], raw[5]); w.w = cvt_pk_bf16(raw[6], raw[7]); *(u32x4*)(stp + g * 1536 + cb) = w; } } }
            }
        } else if constexpr (MODE == EPI_B2 || MODE == EPI_O || MODE == EPI_U || MODE == EPI_DOWN) {
            const int ct = wc * 32 + 8 * fq;
            if (MODE == EPI_B1 && u.pn == 6) {
#pragma unroll
                for (int ai = 0; ai < 2; ++ai)
#pragma unroll
                    for (int m = 0; m < 4; ++m) { float* rowp = o32 + (size_t)(row0 + ai * HALF + m * 16) * 256 + ct;
#pragma unroll
                        for (int bj = 0; bj < 2; ++bj) { *(f32x4*)(rowp + bj * HALF) = acc[ai][bj][m][0]; *(f32x4*)(rowp + bj * HALF + 4) = acc[ai][bj][m][1]; } }
                return;
            }
            const int ld = (MODE == EPI_U) ? 4096 : (MODE == EPI_DOWN ? DM : LDP);
            const int colbase = (MODE == EPI_B2) ? 0 : (MODE == EPI_B1 ? PC_RR : (MODE == EPI_O ? PC_O : 0));
            const int col0 = colbase + u.pn * BM + ct;
            const bool dovf = (MODE == EPI_B1) && vf != nullptr && u.pn >= 4;
#pragma unroll
            for (int ai = 0; ai < 2; ++ai)
#pragma unroll
                for (int m = 0; m < 4; ++m) { const size_t r = (size_t)(row0 + ai * HALF + m * 16); bf16_t* rowp = o16 + r * ld + col0;
#pragma unroll
                    for (int bj = 0; bj < 2; ++bj) { const f32x4 v0 = acc[ai][bj][m][0], v1 = acc[ai][bj][m][1];
                        u32x4 w; w.x = cvt_pk_bf16(v0[0], v0[1]); w.y = cvt_pk_bf16(v0[2], v0[3]); w.z = cvt_pk_bf16(v1[0], v1[1]); w.w = cvt_pk_bf16(v1[2], v1[3]);
                        *(u32x4*)(rowp + bj * HALF) = w;
                        if (MODE == EPI_B1) { if (dovf) *(u32x4*)(vf + r * 512 + (u.pn - 4) * BM + ct + bj * HALF) = w; } } }
        } else if constexpr (MODE == EPI_FFN) {
            const int hc0 = u.pn * HALF + wc * 32 + 8 * fq;
#pragma unroll
            for (int ai = 0; ai < 2; ++ai)
#pragma unroll
                for (int m = 0; m < 4; ++m) { bf16_t* rowp = o16 + (size_t)(row0 + ai * HALF + m * 16) * FH + hc0; float a[8];
#pragma unroll
                    for (int n = 0; n < 2; ++n)
#pragma unroll
                        for (int j = 0; j < 4; ++j) a[n * 4 + j] = siluf_(acc[ai][0][m][n][j]) * acc[ai][1][m][n][j];
                    u32x4 w; w.x = cvt_pk_bf16(a[0], a[1]); w.y = cvt_pk_bf16(a[2], a[3]); w.z = cvt_pk_bf16(a[4], a[5]); w.w = cvt_pk_bf16(a[6], a[7]);
                    *(u32x4*)rowp = w; }
        } else {
            const int d0 = u.pn * 64 + wc * 16 + 4 * fq;
#pragma unroll
            for (int ai = 0; ai < 2; ++ai)
#pragma unroll
                for (int m = 0; m < 4; ++m) { const size_t r = (size_t)(row0 + ai * HALF + m * 16); const bf16_t* up = uq + r * 4096 + d0; float s[4] = {0.f, 0.f, 0.f, 0.f};
#pragma unroll
                    for (int bj = 0; bj < 2; ++bj)
#pragma unroll
                        for (int n = 0; n < 2; ++n) { const u32x2 uu = *(const u32x2*)(up + (2 * bj + n) * 1024); const f32x4 g = acc[ai][bj][m][n];
                            s[0] += sigmoidf_(g[0]) * bflo(uu.x); s[1] += sigmoidf_(g[1]) * bfhi(uu.x); s[2] += sigmoidf_(g[2]) * bflo(uu.y); s[3] += sigmoidf_(g[3]) * bfhi(uu.y); }
                    u32x2 w; w.x = cvt_pk_bf16(s[0], s[1]); w.y = cvt_pk_bf16(s[2], s[3]);
                    *(u32x2*)(o16 + r * LDP + PC_MERGED + d0) = w; }
        }
    }
};

template <class EpiT, bool SHIFT>
__device__ __forceinline__ void gemm_phase(LAS unsigned char* lds, const bf16_t* A, int lda, const bf16_t* Bt, int M, int N, int K, const EpiT& E, const bf16_t* zrow, int ordG, int ordC) {
    int tid_ = threadIdx.x; asm volatile("" : "+v"(tid_));
    const int tid = tid_, wid = __builtin_amdgcn_readfirstlane(tid >> 6), lane = tid & 63, wr = wid >> 2, wc = wid & 3, fr = lane & 15, fq = lane >> 4;
    const int nt = K / BK;
    Order S; S.init(M, N, ordG, ordC);
    unsigned voffA[2], voffB[2]; bool z0[2];
#pragma unroll
    for (int i = 0; i < 2; ++i) { int R, C; stage_rc(tid * 16 + i * 8192, R, C); const int Rb = EpiT::PERM ? ((R & ~31) + perm32(R & 31)) : R;
        voffA[i] = (unsigned)(R * lda + C) * 2u; voffB[i] = (unsigned)(Rb * K + C) * 2u; z0[i] = (R == 0); }
    const size_t kstep = (size_t)(BK * 2);
    const size_t hstepA = (size_t)HALF * lda * 2, tstepA = 2 * hstepA, hstepB = (size_t)HALF * K * 2, tstepB = 2 * hstepB;
    const size_t shiftsub = (size_t)lda * 2 + (size_t)K;
    const unsigned ldsw = (unsigned)wid * 1024u;
    const int aoff = lds_byte(wr * 64 + fr, fq * 8), boff = lds_byte(wc * 32 + fr, fq * 8);
#define PG8_SA(b, h) (((b) * 2 + (h)) * HTB)
#define PG8_SB(b, h) ((4 + (b) * 2 + (h)) * HTB)
#define PG8_STAGEB(bufoff, gbase) do { _Pragma("unroll") for (int _i = 0; _i < 2; ++_i) \
        __builtin_amdgcn_global_load_lds((const unsigned*)((const char*)(gbase) + voffB[_i]), (LAS unsigned*)(lds + (bufoff) + ldsw + _i * 8192), 16, 0, 0); } while (0)
#define PG8_STAGEA(bufoff, gbase, zf) do { _Pragma("unroll") for (int _i = 0; _i < 2; ++_i) { const char* _p = (const char*)(gbase) + voffA[_i]; \
        if (SHIFT) { if ((zf) && z0[_i]) _p = (const char*)zrow + lane * 16; } \
        __builtin_amdgcn_global_load_lds((const unsigned*)_p, (LAS unsigned*)(lds + (bufoff) + ldsw + _i * 8192), 16, 0, 0); } } while (0)
#define PG8_LDA(dst, b, h) do { _Pragma("unroll") for (int m = 0; m < 4; ++m) _Pragma("unroll") for (int k = 0; k < 2; ++k) dst[m][k] = *(const LAS bf16x8*)(lds + PG8_SA(b, h) + aoff + m * 2048 + k * 1024); } while (0)
#define PG8_LDB(dst, b, h) do { _Pragma("unroll") for (int n = 0; n < 2; ++n) _Pragma("unroll") for (int k = 0; k < 2; ++k) dst[n][k] = *(const LAS bf16x8*)(lds + PG8_SB(b, h) + boff + n * 2048 + k * 1024); } while (0)
#define PG8_MMA(ai, bj, At, Bt_) do { __builtin_amdgcn_s_setprio(1); _Pragma("unroll") for (int m = 0; m < 4; ++m) _Pragma("unroll") for (int n = 0; n < 2; ++n) _Pragma("unroll") for (int k = 0; k < 2; ++k) \
        acc[ai][bj][m][n] = __builtin_amdgcn_mfma_f32_16x16x32_bf16(Bt_[n][k], At[m][k], acc[ai][bj][m][n], 0, 0, 0); __builtin_amdgcn_s_setprio(0); } while (0)
#define PG8_WAIT_V(n) asm volatile("s_waitcnt vmcnt(" #n ")" ::: "memory")
#define PG8_WAIT_L(n) asm volatile("s_waitcnt lgkmcnt(" #n ")" ::: "memory")
#define PG8_BAR __builtin_amdgcn_s_barrier()
#define PG8_SCHED __builtin_amdgcn_sched_barrier(0)
#define PG8_AOFF(tau) ((size_t)(tau) * kstep - ((SHIFT && (tau) >= nt / 2) ? shiftsub : (size_t)0))
    Unit cur, nxt; int ui = 0;
    if (!S.next(0, cur)) return;
    f32x4 acc[2][2][4][2];
#pragma unroll
    for (int a = 0; a < 2; ++a)
#pragma unroll
        for (int b = 0; b < 2; ++b)
#pragma unroll
            for (int m = 0; m < 4; ++m)
#pragma unroll
                for (int n = 0; n < 2; ++n) acc[a][b][m][n] = (f32x4){0.f, 0.f, 0.f, 0.f};
    bf16x8 At[4][2], B0[2][2], B1[2][2];
    const char* cA = (const char*)(A + E.a_col(cur.pn)) + (size_t)cur.pm * tstepA; const char* cB = (const char*)Bt + (size_t)cur.pn * tstepB;
    PG8_STAGEB(PG8_SB(0, 0), cB); PG8_STAGEA(PG8_SA(0, 0), cA, false); PG8_STAGEB(PG8_SB(0, 1), cB + hstepB); PG8_STAGEA(PG8_SA(0, 1), cA + hstepA, false);
    if (wr == 1) PG8_BAR;
    PG8_WAIT_V(4); PG8_BAR;
    PG8_STAGEB(PG8_SB(1, 0), cB + kstep); PG8_STAGEA(PG8_SA(1, 0), cA + kstep, false); PG8_STAGEB(PG8_SB(1, 1), cB + hstepB + kstep);
    PG8_WAIT_V(6); PG8_BAR;
    for (;;) {
        const bool has_next = S.next(ui + 1, nxt);
        const char* nA = has_next ? (const char*)(A + E.a_col(nxt.pn)) + (size_t)nxt.pm * tstepA : cA; const char* nB = has_next ? (const char*)Bt + (size_t)nxt.pn * tstepB : cB;
        const bool seq0 = SHIFT && ((cur.pm & 15) == 0);
        for (int t = 0; t < nt; t += 2) {
            const bool last = (t == nt - 2);
            const char* a1 = cA + PG8_AOFF(t + 1);
            const char* a2 = last ? nA : cA + PG8_AOFF(t + 2); const char* b2 = last ? nB : cB + (size_t)(t + 2) * kstep;
            const char* a3 = a2 + kstep; const char* b3 = b2 + kstep;
            const bool zf = seq0 && !last && (t + 2 >= nt / 2);
            PG8_LDB(B0, 0, 0); PG8_SCHED; PG8_LDA(At, 0, 0); PG8_STAGEA(PG8_SA(1, 1), a1 + hstepA, false);
            PG8_WAIT_L(8); PG8_BAR; PG8_WAIT_L(0); PG8_MMA(0, 0, At, B0); PG8_BAR; PG8_SCHED;
            PG8_LDB(B1, 0, 1); PG8_STAGEB(PG8_SB(0, 0), b2);
            PG8_BAR; PG8_WAIT_L(0); PG8_MMA(0, 1, At, B1); PG8_BAR;
            PG8_LDA(At, 0, 1); PG8_STAGEA(PG8_SA(0, 0), a2, zf);
            PG8_BAR; PG8_WAIT_L(0); PG8_MMA(1, 0, At, B0); PG8_BAR; PG8_SCHED;
            PG8_STAGEB(PG8_SB(0, 1), b2 + hstepB);
            PG8_WAIT_V(6); PG8_BAR; PG8_MMA(1, 1, At, B1); PG8_BAR;
            PG8_LDB(B0, 1, 0); PG8_SCHED; PG8_LDA(At, 1, 0); PG8_STAGEA(PG8_SA(0, 1), a2 + hstepA, false);
            PG8_WAIT_L(8); PG8_BAR; PG8_WAIT_L(0); PG8_MMA(0, 0, At, B0); PG8_BAR; PG8_SCHED;
            PG8_LDB(B1, 1, 1); PG8_STAGEB(PG8_SB(1, 0), b3);
            PG8_BAR; PG8_WAIT_L(0); PG8_MMA(0, 1, At, B1); PG8_BAR;
            PG8_LDA(At, 1, 1); PG8_STAGEA(PG8_SA(1, 0), a3, zf);
            PG8_BAR; PG8_WAIT_L(0); PG8_MMA(1, 0, At, B0); PG8_BAR; PG8_SCHED;
            PG8_STAGEB(PG8_SB(1, 1), b3 + hstepB);
            PG8_WAIT_V(6); PG8_BAR; PG8_MMA(1, 1, At, B1); PG8_BAR;
        }
        E(acc, cur, wr, wc, fr, fq);
        if (!has_next) break;
#pragma unroll
        for (int a = 0; a < 2; ++a)
#pragma unroll
            for (int b = 0; b < 2; ++b)
#pragma unroll
                for (int m = 0; m < 4; ++m)
#pragma unroll
                    for (int n = 0; n < 2; ++n) acc[a][b][m][n] = (f32x4){0.f, 0.f, 0.f, 0.f};
        cur = nxt; cA = nA; cB = nB; ++ui;
    }
    PG8_WAIT_V(0);
    if (wr == 0) PG8_BAR;
    PG8_BAR;
#undef PG8_SA
#undef PG8_SB
#undef PG8_STAGEA
#undef PG8_STAGEB
#undef PG8_LDA
#undef PG8_LDB
#undef PG8_MMA
#undef PG8_WAIT_V
#undef PG8_WAIT_L
#undef PG8_BAR
#undef PG8_SCHED
#undef PG8_AOFF
}

__device__ __forceinline__ float wval(const Params& p, int zo, int L, int spec, int n, int k) {
    const float* win = p.in[zo + I_WIN] + (size_t)L * DM * NIN;
    if (spec == 0) {
        if (n < 1536) return win[(size_t)k * NIN + 3864 + n];
        const int s = n - 1536;
        if (s < 8) return win[(size_t)k * NIN + 1280 + s];
        if (s < 24) return win[(size_t)k * NIN + 2824 + (s - 8)];
        if (s < 56) return (L == 0) ? 0.f : p.in[zo + I_WVRES][((size_t)(L - 1) * DM + k) * 32 + (s - 24)];
        if (s < 64) return 0.f;
        if (s < 224) return win[(size_t)k * NIN + 5400 + (s - 64)];
        return 0.f;
    } else if (spec == 1) {
        const int col = n < 1280 ? n : (n < 2816 ? n + 8 : n + 24); return win[(size_t)k * NIN + col];
    } else if (spec == 2) {
        const int pn = n >> 8, ct = n & 255, bj = ct >> 7, wc = (ct >> 5) & 3, nn = (ct >> 4) & 1, r16 = ct & 15;
        return win[(size_t)k * NIN + 5560 + (2 * bj + nn) * 1024 + pn * 64 + wc * 16 + r16];
    } else if (spec == 3) {
        const int kb = n >> 10, d = n & 1023; return p.in[zo + I_WBR][(((size_t)L * 4 + kb) * 512 + k) * 1024 + d];
    } else if (spec == 4) {
        return p.in[zo + I_WOUT][((size_t)L * 1024 + k) * 1024 + n];
    } else if (spec == 5) {
        const int pn = n >> 8, ct = n & 255;
        return ct < 128 ? p.in[zo + I_FG][((size_t)L * 1024 + k) * FH + pn * 128 + ct] : p.in[zo + I_FU][((size_t)L * 1024 + k) * FH + pn * 128 + ct - 128];
    } else {
        return p.in[zo + I_FD][((size_t)L * FH + k) * 1024 + n];
    }
}
__device__ void convert_weights(const Params& p, int L, LAS float* lf, int tile0, int tile1, int ordG, int ordC) {
    int zo = 0; asm volatile("" : "+s"(zo));
    int tid_ = threadIdx.x; asm volatile("" : "+v"(tid_));
    const int tid = tid_;
    for (int tile = tile0 + ordC; tile < tile1; tile += ordG) {
        int spec, tl = tile, ktiles; size_t dofs; int K;
        if (tl < 448) { spec = 0; ktiles = 16; dofs = WB_R; K = 1024; }
        else if ((tl -= 448) < 960) { spec = 1; ktiles = 16; dofs = WB_2; K = 1024; }
        else if ((tl -= 960) < 1024) { spec = 2; ktiles = 16; dofs = WB_G; K = 1024; }
        else if ((tl -= 1024) < 512) { spec = 3; ktiles = 8; dofs = WB_B; K = 512; }
        else if ((tl -= 512) < 256) { spec = 4; ktiles = 16; dofs = WB_O; K = 1024; }
        else if ((tl -= 256) < 1408) { spec = 5; ktiles = 16; dofs = WB_F; K = 1024; }
        else { tl -= 1408; spec = 6; ktiles = 44; dofs = WB_D; K = FH; }
        const int n0 = (tl / ktiles) * 64, k0 = (tl % ktiles) * 64;
        bf16_t* dst = (bf16_t*)(p.ws + dofs);
#pragma unroll
        for (int i = 0; i < 8; ++i) { const int idx = tid + i * 512, kk = idx >> 6, nn = idx & 63; lf[kk * 65 + nn] = wval(p, zo, L, spec, n0 + nn, k0 + kk); }
        __syncthreads();
#pragma unroll
        for (int i = 0; i < 4; ++i) { const int idx = tid + i * 512, nn = idx >> 5, k2 = (idx & 31) * 2;
            *(unsigned*)(dst + (size_t)(n0 + nn) * K + k0 + k2) = cvt_pk_bf16(lf[k2 * 65 + nn], lf[(k2 + 1) * 65 + nn]); }
        __syncthreads();
    }
}

template <int DT>
__device__ void resnorm(const float* xin, const void* delta, int ldd, const float* gd, float* xout, const float* gn, bf16_t* H) {
    int tid_ = threadIdx.x; asm volatile("" : "+v"(tid_));
    const int wid = tid_ >> 6, lane = tid_ & 63;
    const int stride = gridDim.x * 8;
    int row = blockIdx.x * 8 + wid;
    f32x4 gdv[4], gnv[4];
#pragma unroll
    for (int j = 0; j < 4; ++j) { gdv[j] = (DT != 0) ? *(const f32x4*)(gd + (j * 64 + lane) * 4) : (f32x4){0.f, 0.f, 0.f, 0.f}; gnv[j] = gn ? *(const f32x4*)(gn + (j * 64 + lane) * 4) : (f32x4){0.f, 0.f, 0.f, 0.f}; }
    f32x4 nx[4], nd[4]; u32x2 nb[4];
#define RN_LOAD(r_) do { _Pragma("unroll") for (int j = 0; j < 4; ++j) { nx[j] = *(const f32x4*)(xin + (size_t)(r_) * DM + (j * 64 + lane) * 4); \
        if (DT == 1) nb[j] = *(const u32x2*)((const bf16_t*)delta + (size_t)(r_) * ldd + (j * 64 + lane) * 4); \
        if (DT == 2) nd[j] = *(const f32x4*)((const float*)delta + (size_t)(r_) * ldd + (j * 64 + lane) * 4); } } while (0)
    if (row < T) RN_LOAD(row);
    while (row < T) {
        f32x4 xv[4], dv[4];
#pragma unroll
        for (int j = 0; j < 4; ++j) { xv[j] = nx[j]; if (DT == 1) dv[j] = (f32x4){bflo(nb[j].x), bfhi(nb[j].x), bflo(nb[j].y), bfhi(nb[j].y)}; if (DT == 2) dv[j] = nd[j]; }
        const int nrow = row + stride;
        if (nrow < T) RN_LOAD(nrow);
        if (DT != 0) {
            float ss = 0.f;
#pragma unroll
            for (int j = 0; j < 4; ++j) ss += dv[j][0] * dv[j][0] + dv[j][1] * dv[j][1] + dv[j][2] * dv[j][2] + dv[j][3] * dv[j][3];
            ss = red64(ss); const float rstd = rsqrtf(ss * (1.0f / DM) + 1e-6f);
#pragma unroll
            for (int j = 0; j < 4; ++j) xv[j] += dv[j] * rstd * gdv[j];
        }
        if (xout) {
#pragma unroll
            for (int j = 0; j < 4; ++j) *(f32x4*)(xout + (size_t)row * DM + (j * 64 + lane) * 4) = xv[j];
        }
        if (gn) {
            float ss = 0.f;
#pragma unroll
            for (int j = 0; j < 4; ++j) ss += xv[j][0] * xv[j][0] + xv[j][1] * xv[j][1] + xv[j][2] * xv[j][2] + xv[j][3] * xv[j][3];
            ss = red64(ss); const float rstd = rsqrtf(ss * (1.0f / DM) + 1e-6f);
#pragma unroll
            for (int j = 0; j < 4; ++j) { const f32x4 h = xv[j] * rstd * gnv[j];
                u32x2 w; w.x = cvt_pk_bf16(h[0], h[1]); w.y = cvt_pk_bf16(h[2], h[3]); *(u32x2*)(H + (size_t)row * DM + (j * 64 + lane) * 4) = w; }
        }
        row = nrow;
    }
#undef RN_LOAD
}

constexpr int TC = 32;
typedef float f32x2 __attribute__((ext_vector_type(2)));
template <int NE, bool RW> struct StepOps { f32x4 w[NE / 4], k[NE / 4], r[NE / 4], a[RW ? NE / 4 : 1], b[RW ? NE / 4 : 1]; float v; };
template <int NE, bool RW>
__device__ __forceinline__ void step_load(StepOps<NE, RW>& o, const LAS float* base, const LAS float* opV, int vo) {
#pragma unroll
    for (int e = 0; e < NE / 4; ++e) { o.w[e] = *(const LAS f32x4*)(base + 4 * e); o.k[e] = *(const LAS f32x4*)(base + 2048 + 4 * e); o.r[e] = *(const LAS f32x4*)(base + 4096 + 4 * e);
        if (RW) { o.a[e] = *(const LAS f32x4*)(base + 6144 + 4 * e); o.b[e] = *(const LAS f32x4*)(base + 8192 + 4 * e); } }
    o.v = opV[vo];
}
#define LO2(q) ((f32x2){(q)[0], (q)[1]})
#define HI2(q) ((f32x2){(q)[2], (q)[3]})
template <int LPR, bool RW>
__device__ __forceinline__ float step_compute(f32x2 (&s)[32 / LPR], const StepOps<64 / LPR, RW>& o) {
    constexpr int NE = 64 / LPR;
    f32x2 tk[NE / 2];
    const f32x2 v2 = (f32x2){o.v, o.v};
#pragma unroll
    for (int e = 0; e < NE / 4; ++e) { tk[2 * e] = LO2(o.k[e]) * v2; tk[2 * e + 1] = HI2(o.k[e]) * v2; }
    if (RW) {
        f32x2 sa2 = (f32x2){0.f, 0.f}, sb2 = (f32x2){0.f, 0.f};
#pragma unroll
        for (int e = 0; e < NE / 4; ++e) { sa2 += s[2 * e] * LO2(o.a[e]); sb2 += s[2 * e + 1] * HI2(o.a[e]); }
        sa2 += sb2; float sa = sa2[0] + sa2[1]; sa = (LPR == 8) ? red8(sa) : red4(sa);
        const f32x2 sv = (f32x2){sa, sa};
#pragma unroll
        for (int e = 0; e < NE / 4; ++e) { tk[2 * e] += LO2(o.b[e]) * sv; tk[2 * e + 1] += HI2(o.b[e]) * sv; }
    }
    f32x2 y2 = (f32x2){0.f, 0.f}, z2 = (f32x2){0.f, 0.f};
#pragma unroll
    for (int e = 0; e < NE / 4; ++e) { s[2 * e] = s[2 * e] * LO2(o.w[e]) + tk[2 * e]; s[2 * e + 1] = s[2 * e + 1] * HI2(o.w[e]) + tk[2 * e + 1];
        y2 += s[2 * e] * LO2(o.r[e]); z2 += s[2 * e + 1] * HI2(o.r[e]); }
    y2 += z2; float y = y2[0] + y2[1]; y = (LPR == 8) ? red8(y) : red4(y);
    return y;
}
template <int LPR, bool RW>
__device__ __forceinline__ void scan_chunk(f32x2 (&s)[32 / LPR], const LAS float* opW, const LAS float* opK, const LAS float* opR, const LAS float* opA, const LAS float* opB,
                                           const LAS float* opV, LAS float* Y, int vstride, int row, int sub) {
    constexpr int NE = 64 / LPR;
    StepOps<NE, RW> o0, o1;
    unsigned bt = (unsigned)(size_t)(opW + sub * NE), bv = (unsigned)(size_t)(opV + row), by = (unsigned)(size_t)(Y + row);
    step_load<NE, RW>(o0, (const LAS float*)(size_t)bt, (const LAS float*)(size_t)bv, 0);
#pragma unroll 1
    for (int t = 0; t < TC; t += 2) {
        asm volatile("" : "+v"(bt), "+v"(bv), "+v"(by));
        const LAS float* b0 = (const LAS float*)(size_t)bt; const LAS float* v0 = (const LAS float*)(size_t)bv;
        step_load<NE, RW>(o1, b0 + 64, v0, vstride);
        const float y0 = step_compute<LPR, RW>(s, o0);
        step_load<NE, RW>(o0, b0 + 128, v0, 2 * vstride);
        const float y1 = step_compute<LPR, RW>(s, o1);
        { LAS float* yp = (LAS float*)(size_t)by; yp[0] = y0; yp[vstride] = y1; }
        bt += 512; bv += 8 * vstride; by += 8 * vstride;
    }
}

__device__ void rwkv_item_old(const Params& p, int L, int item, LAS unsigned char* lds, bool dry) {
    int zo = 0; asm volatile("" : "+s"(zo));
    int tid_ = threadIdx.x; asm volatile("" : "+v"(tid_));
    const int b = item >> 3, h = item & 7, tid = tid_, wv = tid >> 6, lane = tid & 63, c = lane, hc = h * 64 + c;
    LAS bf16_t* WT = (LAS bf16_t*)lds;
    LAS bf16_t* LOSB = WT + 64 * 200;
    LAS float* AW = (LAS float*)(lds + 38400); LAS float* AA = AW + 2048; LAS float* AV = AA + 2048; LAS float* G = AV + 2048;
    LAS float* opW = G + 2048; LAS float* opK = opW + 2048; LAS float* opR = opK + 2048; LAS float* opA = opR + 2048; LAS float* opB = opA + 2048;
    LAS float* opV = opB + 2048; LAS float* Y = opV + 2048; LAS float* BON = Y + 2048; LAS float* G1 = BON + 32;
    bf16_t* P = (bf16_t*)(p.ws + OFF_P); const float* SM = (const float*)(p.ws + OFF_SM); const bf16_t* VF = (const bf16_t*)(p.ws + OFF_VF);
    __syncthreads();
    for (int i = tid; i < 192 * 64; i += 512) { const int j = i >> 6, cc = i & 63; float v;
        if (j < 32) v = p.in[zo + I_RWW2][((size_t)L * 32 + j) * 512 + h * 64 + cc];
        else if (j < 64) v = p.in[zo + I_RAW2][((size_t)L * 32 + (j - 32)) * 512 + h * 64 + cc];
        else if (j < 96) v = (L > 0) ? p.in[zo + I_RVW2][((size_t)(L - 1) * 32 + (j - 64)) * 512 + h * 64 + cc] : 0.f;
        else v = p.in[zo + I_RGW2][((size_t)L * 96 + (j - 96)) * 512 + h * 64 + cc];
        WT[cc * 200 + j] = f2bf(v); }
    const float w0 = p.in[zo + I_RW0][L * 512 + hc], a0 = p.in[zo + I_RA0][L * 512 + hc], v0 = (L > 0) ? p.in[zo + I_RV0][(L - 1) * 512 + hc] : 0.f;
    const float k_k = p.in[zo + I_RKK][L * 512 + hc], k_a = p.in[zo + I_RKA][L * 512 + hc], r_k = p.in[zo + I_RRK][L * 512 + hc], ln_g = p.in[zo + I_RLNG][L * 512 + hc], ln_b = p.in[zo + I_RLNB][L * 512 + hc];
    f32x2 s[4];
#pragma unroll
    for (int e = 0; e < 4; ++e) s[e] = (f32x2){0.f, 0.f};
    const int row = wv * 8 + (lane >> 3), sub = lane & 7;
    int smo[12];
#pragma unroll
    for (int i = 0; i < 12; ++i) { const int idx = tid + i * 512, t = idx / 192, j = idx % 192; smo[i] = t * 256 + (j < 64 ? 64 + j : (j < 96 ? j - 40 : j + 32)); }
    float nsm[12]; bf16_t nr[4], nk[4], nv[4], nf[4];
#define RWKV_LOAD_SM(chn) do { const size_t Rn = (size_t)b * SEQ + (size_t)(chn) * TC; \
        _Pragma("unroll") for (int i = 0; i < 12; ++i) nsm[i] = SM[Rn * 256 + smo[i]]; } while (0)
#define RWKV_LOAD(chn) do { const size_t Rn = (size_t)b * SEQ + (size_t)(chn) * TC; \
        _Pragma("unroll") for (int i = 0; i < 4; ++i) { const size_t R = Rn + wv * 4 + i; nr[i] = P[R * LDP + PC_RR + hc]; nk[i] = P[R * LDP + PC_RK + hc]; nv[i] = P[R * LDP + PC_RV + hc]; nf[i] = (L > 0) ? VF[R * 512 + hc] : (bf16_t)0; } } while (0)
#define RWKV_P0() do { _Pragma("unroll") for (int i = 0; i < 12; ++i) { const int idx = tid + i * 512, t = idx / 192, j = idx % 192; \
            const float v = nsm[i], e = __expf(j < 32 ? 2.0f * v : -v), rr = __builtin_amdgcn_rcpf(1.0f + e);     \
            LOSB[t * 200 + j] = f2bf(j < 32 ? 1.0f - 2.0f * rr : (j >= 96 ? rr : v)); } } while (0)
    RWKV_LOAD_SM(0); RWKV_P0(); RWKV_LOAD_SM(1); RWKV_LOAD(0);
    __syncthreads();
    for (int ch = 0; ch < SEQ / TC; ++ch) {
        const size_t R0 = (size_t)b * SEQ + (size_t)ch * TC;
        LAS float* Gc = (ch & 1) ? G1 : G;
        { const int mt = wv & 1, nt = wv >> 1; const int ao = (mt * 16 + (lane & 15)) * 200 + 8 * (lane >> 4), bo = (nt * 16 + (lane & 15)) * 200 + 8 * (lane >> 4);
            bf16x8 af[6], bfr[6];
#pragma unroll
            for (int ks = 0; ks < 6; ++ks) { af[ks] = *(const LAS bf16x8*)(LOSB + ao + ks * 32); bfr[ks] = *(const LAS bf16x8*)(WT + bo + ks * 32); }
            const f32x4 z4 = (f32x4){0.f, 0.f, 0.f, 0.f};
            const f32x4 cw = __builtin_amdgcn_mfma_f32_16x16x32_bf16(af[0], bfr[0], z4, 0, 0, 0);
            const f32x4 ca = __builtin_amdgcn_mfma_f32_16x16x32_bf16(af[1], bfr[1], z4, 0, 0, 0);
            const f32x4 cvv = __builtin_amdgcn_mfma_f32_16x16x32_bf16(af[2], bfr[2], z4, 0, 0, 0);
            f32x4 cg = __builtin_amdgcn_mfma_f32_16x16x32_bf16(af[3], bfr[3], z4, 0, 0, 0);
            cg = __builtin_amdgcn_mfma_f32_16x16x32_bf16(af[4], bfr[4], cg, 0, 0, 0);
            cg = __builtin_amdgcn_mfma_f32_16x16x32_bf16(af[5], bfr[5], cg, 0, 0, 0);
#pragma unroll
            for (int rg = 0; rg < 4; ++rg) { const int o = (mt * 16 + (lane >> 4) * 4 + rg) * 64 + nt * 16 + (lane & 15); AW[o] = cw[rg]; AA[o] = ca[rg]; AV[o] = cvv[rg]; Gc[o] = cg[rg]; } }
        __syncthreads();
        { float kkr[4], km[4], av_[4], vv[4], rr_[4], red[8];
#pragma unroll
            for (int i = 0; i < 4; ++i) { const int t = wv * 4 + i;
                av_[i] = sigmoidf_(a0 + AA[t * 64 + c]);
                const float k_ = bf2f(nk[i]); rr_[i] = bf2f(nr[i]); vv[i] = bf2f(nv[i]);
                if (L > 0) { const float vf = bf2f(nf[i]); vv[i] = vv[i] + (vf - vv[i]) * sigmoidf_(v0 + AV[t * 64 + c]); }
                kkr[i] = k_ * k_k; km[i] = k_ * (1.0f + (av_[i] - 1.0f) * k_a);
                red[i] = kkr[i] * kkr[i]; red[4 + i] = rr_[i] * km[i] * r_k; }
            red64n<8>(red);
#pragma unroll
            for (int i = 0; i < 4; ++i) { const int t = wv * 4 + i;
                const float wdec = __expf(-0.60653066f * sigmoidf_(w0 + AW[t * 64 + c]));
                const float kk = kkr[i] * rsqrtf(fmaxf(red[i], 1e-24f));
                opW[t * 64 + c] = wdec; opK[t * 64 + c] = km[i]; opR[t * 64 + c] = rr_[i]; opA[t * 64 + c] = -kk; opB[t * 64 + c] = kk * av_[i]; opV[t * 64 + c] = vv[i];
                if (lane == 0) BON[t] = red[4 + i]; } }
        if (ch + 1 < SEQ / TC) { RWKV_P0(); RWKV_LOAD(ch + 1); if (ch + 2 < SEQ / TC) RWKV_LOAD_SM(ch + 2); }
        __syncthreads();
        if (!(dry && DRY_SKIP_SCAN)) scan_chunk<8, true>(s, opW, opK, opR, opA, opB, opV, Y, 64, row, sub);
        __syncthreads();
        { float y[4], m[4], q[4];
#pragma unroll
            for (int i = 0; i < 4; ++i) { y[i] = Y[(wv * 4 + i) * 64 + c]; m[i] = y[i]; }
            red64n<4>(m);
#pragma unroll
            for (int i = 0; i < 4; ++i) { y[i] -= m[i] * (1.0f / 64.0f); q[i] = y[i] * y[i]; }
            red64n<4>(q);
#pragma unroll
            for (int i = 0; i < 4; ++i) { const int t = wv * 4 + i; const size_t R = R0 + t;
                float yn = y[i] * rsqrtf(q[i] * (1.0f / 64.0f) + 64e-5f) * ln_g + ln_b; yn += BON[t] * opV[t * 64 + c];
                if (!dry) P[R * LDP + PC_RR + hc] = f2bf(yn * Gc[t * 64 + c]); } }
    }
#undef RWKV_LOAD_SM
#undef RWKV_P0
#undef RWKV_LOAD
}


__device__ void gla_item(const Params& p, int L, int item, LAS float* lf, bool dry) {
    int zo = 0; asm volatile("" : "+s"(zo));
    int tid_ = threadIdx.x; asm volatile("" : "+v"(tid_));
    const int tid = tid_, wv = tid >> 6, lane = tid & 63, c = lane;
    LAS float* opW = lf; LAS float* opK = opW + 2048; LAS float* opR = opK + 2048; LAS float* opV = opR + 2048; LAS float* Y = opV + 2048; LAS float* X0 = Y + 2048; LAS float* X1 = X0 + 512;
    bf16_t* P = (bf16_t*)(p.ws + OFF_P); const float* SM = (const float*)(p.ws + OFF_SM);
    const int half = item & 1, bh = item >> 1, b = bh >> 2, h = bh & 3, vcol = PC_GV + h * 128 + half * 64;
    __syncthreads();
    for (int i = tid; i < 16 * 64; i += 512) X1[i] = p.in[zo + I_GAW][((size_t)L * 16 + (i >> 6)) * 256 + h * 64 + (i & 63)];
    const float ab = p.in[zo + I_GAB][L * 256 + h * 64 + c];
    f32x2 s[4];
#pragma unroll
    for (int e = 0; e < 4; ++e) s[e] = (f32x2){0.f, 0.f};
    const int row = wv * 8 + (lane >> 3), sub = lane & 7;
    float nlo; bf16_t nvv[4], nk[4], nq[4];
#define GLA_LOAD(chn) do { const size_t Rn = (size_t)b * SEQ + (size_t)(chn) * TC; nlo = SM[(Rn + (tid >> 4)) * 256 + 8 + (tid & 15)]; \
        _Pragma("unroll") for (int i = 0; i < 4; ++i) { const int idx = tid + i * 512; nvv[i] = P[(Rn + (idx >> 6)) * LDP + vcol + (idx & 63)]; } \
        _Pragma("unroll") for (int i = 0; i < 4; ++i) { const size_t R = Rn + wv * 4 + i; nk[i] = P[R * LDP + PC_GK + h * 64 + c]; nq[i] = P[R * LDP + PC_GQ + h * 64 + c]; } } while (0)
    GLA_LOAD(0);
    for (int ch = 0; ch < SEQ / TC; ++ch) {
        const size_t R0 = (size_t)b * SEQ + (size_t)ch * TC;
        X0[tid] = nlo;
#pragma unroll
        for (int i = 0; i < 4; ++i) opV[tid + i * 512] = bf2f(nvv[i]);
        bf16_t ck[4], cq[4];
#pragma unroll
        for (int i = 0; i < 4; ++i) { ck[i] = nk[i]; cq[i] = nq[i]; }
        if (ch + 1 < SEQ / TC) GLA_LOAD(ch + 1);
        __syncthreads();
#pragma unroll
        for (int i = 0; i < 4; ++i) { const int t = wv * 4 + i; float la = ab;
#pragma unroll
            for (int j = 0; j < 16; ++j) la += X0[t * 16 + j] * X1[j * 64 + c];
            opW[t * 64 + c] = __expf(__logf(sigmoidf_(la)) * (1.0f / 16.0f));
            opK[t * 64 + c] = bf2f(ck[i]); opR[t * 64 + c] = bf2f(cq[i]) * 0.125f; }
        __syncthreads();
        scan_chunk<8, false>(s, opW, opK, opR, opW, opW, opV, Y, 64, row, sub);
        __syncthreads();
        if (!dry) {
#pragma unroll
            for (int i = 0; i < 4; ++i) { const int t = wv * 4 + i; P[(R0 + t) * LDP + vcol + c] = f2bf(Y[t * 64 + c]); }
        }
    }
#undef GLA_LOAD
}

template <int MODE>
__device__ void plain_item(const Params& p, int L, int item, LAS float* lf, bool dry) {
    int zo = 0; asm volatile("" : "+s"(zo));
    int tid_ = threadIdx.x; asm volatile("" : "+v"(tid_));
    const int tid = tid_, wv = tid >> 6, lane = tid & 63, c = lane;
    constexpr int VS = (MODE == 0) ? 128 : 64;
    LAS float* opW = lf; LAS float* opK = opW + 2048; LAS float* opR = opK + 2048; LAS float* opV = opR + 2048; LAS float* Y = opV + TC * VS; LAS float* X0 = Y + TC * VS; LAS float* X1 = X0 + 2048;
    bf16_t* P = (bf16_t*)(p.ws + OFF_P); const float* SM = (const float*)(p.ws + OFF_SM);
    __syncthreads();
    if (MODE == 0) {
        const int b = item >> 2, h = item & 3;
        for (int i = tid; i < 16 * 64; i += 512) X1[i] = p.in[zo + I_GAW][((size_t)L * 16 + (i >> 6)) * 256 + h * 64 + (i & 63)];
        const float ab = p.in[zo + I_GAB][L * 256 + h * 64 + c], gn0 = p.in[zo + I_GNG][L * 128 + lane], gn1 = p.in[zo + I_GNG][L * 128 + 64 + lane];
        f32x2 s[8];
#pragma unroll
        for (int e = 0; e < 8; ++e) s[e] = (f32x2){0.f, 0.f};
        const int row = wv * 16 + (lane >> 2), sub = lane & 3;
        float nlo; bf16_t nvv[8], nk[4], nq[4], ng0[4], ng1[4];
#define GLA_LOAD(chn) do { const size_t Rn = (size_t)b * SEQ + (size_t)(chn) * TC; nlo = SM[(Rn + (tid >> 4)) * 256 + 8 + (tid & 15)]; \
        _Pragma("unroll") for (int i = 0; i < 8; ++i) { const int idx = tid + i * 512; nvv[i] = P[(Rn + (idx >> 7)) * LDP + PC_GV + h * 128 + (idx & 127)]; } \
        _Pragma("unroll") for (int i = 0; i < 4; ++i) { const size_t R = Rn + wv * 4 + i; nk[i] = P[R * LDP + PC_GK + h * 64 + c]; nq[i] = P[R * LDP + PC_GQ + h * 64 + c]; \
            ng0[i] = P[R * LDP + PC_GR + h * 128 + lane]; ng1[i] = P[R * LDP + PC_GR + h * 128 + 64 + lane]; } } while (0)
        GLA_LOAD(0);
        for (int ch = 0; ch < SEQ / TC; ++ch) {
            const size_t R0 = (size_t)b * SEQ + (size_t)ch * TC;
            X0[tid] = nlo;
#pragma unroll
            for (int i = 0; i < 8; ++i) opV[tid + i * 512] = bf2f(nvv[i]);
            bf16_t ck[4], cq[4], cg0[4], cg1[4];
#pragma unroll
            for (int i = 0; i < 4; ++i) { ck[i] = nk[i]; cq[i] = nq[i]; cg0[i] = ng0[i]; cg1[i] = ng1[i]; }
            if (ch + 1 < SEQ / TC) GLA_LOAD(ch + 1);
            __syncthreads();
#pragma unroll
            for (int i = 0; i < 4; ++i) { const int t = wv * 4 + i; float la = ab;
#pragma unroll
                for (int j = 0; j < 16; ++j) la += X0[t * 16 + j] * X1[j * 64 + c];
                opW[t * 64 + c] = __expf(__logf(sigmoidf_(la)) * (1.0f / 16.0f));
                opK[t * 64 + c] = bf2f(ck[i]); opR[t * 64 + c] = bf2f(cq[i]) * 0.125f; }
            __syncthreads();
            scan_chunk<4, false>(s, opW, opK, opR, opW, opW, opV, Y, 128, row, sub);
            __syncthreads();
#pragma unroll
            for (int i = 0; i < 4; ++i) { const int t = wv * 4 + i; const size_t R = R0 + t;
                const float y0 = Y[t * 128 + lane], y1 = Y[t * 128 + 64 + lane], ss = red64(y0 * y0 + y1 * y1), rstd = rsqrtf(ss * (1.0f / 128.0f) + 1e-6f);
                bf16_t* rp = P + R * LDP + PC_GR + h * 128;
                const float r0 = bf2f(cg0[i]), r1 = bf2f(cg1[i]);
                if (!dry) { rp[lane] = f2bf(y0 * rstd * gn0 * siluf_(r0)); rp[64 + lane] = f2bf(y1 * rstd * gn1 * siluf_(r1)); } }
        }
#undef GLA_LOAD
    } else {
        const int b = item >> 3, hh = item & 7, g = hh >> 2;
        const int chx = hh * 64 + c, chb = 512 + g * 64 + c, chc = 640 + g * 64 + c;
        const float* cw = p.in[zo + I_SCW] + (size_t)L * 4 * 768; const float* cb = p.in[zo + I_SCB] + (size_t)L * 768;
        float cwx[4], cwb[4], cwc[4];
#pragma unroll
        for (int k = 0; k < 4; ++k) { cwx[k] = cw[k * 768 + chx]; cwb[k] = cw[k * 768 + chb]; cwc[k] = cw[k * 768 + chc]; }
        const float cbx = cb[chx], cbb = cb[chb], cbc = cb[chc];
        const float dtb = p.in[zo + I_SDTB][L * 8 + hh], Aneg = -__expf(p.in[zo + I_SALOG][L * 8 + hh]), Dsk = p.in[zo + I_SD][L * 8 + hh];
        f32x2 s[4];
#pragma unroll
        for (int e = 0; e < 4; ++e) s[e] = (f32x2){0.f, 0.f};
        const int row = wv * 8 + (lane >> 3), sub = lane & 7;
        const int t0 = wv * 4;
        bf16_t nx[7], nb[7], nc[7], nz[4]; float ndt[4];
#define SSD_LOAD(chn) do { const int sp0 = (chn) * TC + t0; \
        _Pragma("unroll") for (int q = 0; q < 7; ++q) { const int sp = sp0 - 3 + q; const size_t R = (size_t)b * SEQ + sp; \
            if (sp >= 0) { nx[q] = P[R * LDP + PC_XBC + chx]; nb[q] = P[R * LDP + PC_XBC + chb]; nc[q] = P[R * LDP + PC_XBC + chc]; } else { nx[q] = 0; nb[q] = 0; nc[q] = 0; } } \
        _Pragma("unroll") for (int i = 0; i < 4; ++i) { const size_t R = (size_t)b * SEQ + sp0 + i; nz[i] = P[R * LDP + PC_Z + chx]; ndt[i] = SM[R * 256 + hh]; } } while (0)
        SSD_LOAD(0);
        for (int ch = 0; ch < SEQ / TC; ++ch) {
            const size_t R0 = (size_t)b * SEQ + (size_t)ch * TC;
            float rx[7], rb[7], rc[7], cz[4], cdt[4];
#pragma unroll
            for (int q = 0; q < 7; ++q) { rx[q] = bf2f(nx[q]); rb[q] = bf2f(nb[q]); rc[q] = bf2f(nc[q]); }
#pragma unroll
            for (int i = 0; i < 4; ++i) { cz[i] = bf2f(nz[i]); cdt[i] = ndt[i]; }
            if (ch + 1 < SEQ / TC) SSD_LOAD(ch + 1);
#pragma unroll
            for (int i = 0; i < 4; ++i) { const int t = t0 + i;
                float x = cbx, bm = cbb, cm = cbc;
#pragma unroll
                for (int k = 0; k < 4; ++k) { x += cwx[k] * rx[i + k]; bm += cwb[k] * rb[i + k]; cm += cwc[k] * rc[i + k]; }
                x = siluf_(x); bm = siluf_(bm); cm = siluf_(cm);
                const float dt = softplusf_(cdt[i] + dtb);
                opW[t * 64 + c] = __expf(dt * Aneg); opK[t * 64 + c] = bm; opR[t * 64 + c] = cm; opV[t * 64 + c] = dt * x; X0[t * 64 + c] = x; }
            __syncthreads();
            scan_chunk<8, false>(s, opW, opK, opR, opW, opW, opV, Y, 64, row, sub);
            __syncthreads();
#pragma unroll
            for (int i = 0; i < 4; ++i) { const int t = t0 + i; const size_t R = R0 + t;
                const float y = Y[t * 64 + c] + Dsk * X0[t * 64 + c];
                if (!dry) P[R * LDP + PC_Z + chx] = f2bf(y * siluf_(cz[i])); }
            __syncthreads();
        }
#undef SSD_LOAD
    }
}

__device__ void lru_item(const Params& p, int L, int item, LAS float* lf, bool dry) {
    int zo = 0; asm volatile("" : "+s"(zo));
    int tid_ = threadIdx.x; asm volatile("" : "+v"(tid_));
    const int b = item >> 3, blk = item & 7, tid = tid_, wv = tid >> 6, lane = tid & 63, c = lane, cbi = blk * 64 + c;
    LAS float* wa = lf; LAS float* wx = wa + 4096; LAS float* XB = wx + 4096; LAS float* A_ = XB + 2048; LAS float* U_ = A_ + 2048; LAS float* HS = U_ + 2048;
    bf16_t* P = (bf16_t*)(p.ws + OFF_P);
    __syncthreads();
    for (int i = tid; i < 4096; i += 512) { wa[i] = p.in[zo + I_LWA][((size_t)L * 8 + blk) * 4096 + i]; wx[i] = p.in[zo + I_LWX][((size_t)L * 8 + blk) * 4096 + i]; }
    float cwv[4];
#pragma unroll
    for (int k = 0; k < 4; ++k) cwv[k] = p.in[zo + I_LCW][((size_t)L * 4 + k) * 512 + cbi];
    const float cbv = p.in[zo + I_LCB][L * 512 + cbi], ba = p.in[zo + I_LBA][L * 512 + cbi], bx = p.in[zo + I_LBX][L * 512 + cbi];
    const float spl = softplusf_(-p.in[zo + I_LLAM][L * 512 + cbi]);
    float hstate = 0.f;
    const int t0 = wv * 4;
    bf16_t nx[7], ngt[4];
#define LRU_LOAD(chn) do { const int sp0 = (chn) * TC + t0; \
        _Pragma("unroll") for (int q = 0; q < 7; ++q) { const int sp = sp0 - 3 + q; nx[q] = (sp >= 0) ? P[((size_t)b * SEQ + sp) * LDP + PC_LX + cbi] : (bf16_t)0; } \
        _Pragma("unroll") for (int i = 0; i < 4; ++i) ngt[i] = P[((size_t)b * SEQ + sp0 + i) * LDP + PC_LG + cbi]; } while (0)
    LRU_LOAD(0);
    for (int ch = 0; ch < SEQ / TC; ++ch) {
        const size_t R0 = (size_t)b * SEQ + (size_t)ch * TC;
        float rx[7], cg[4];
#pragma unroll
        for (int q = 0; q < 7; ++q) rx[q] = bf2f(nx[q]);
#pragma unroll
        for (int i = 0; i < 4; ++i) cg[i] = bf2f(ngt[i]);
        if (ch + 1 < SEQ / TC) LRU_LOAD(ch + 1);
        float xb[4];
#pragma unroll
        for (int i = 0; i < 4; ++i) { float x = cbv;
#pragma unroll
            for (int k = 0; k < 4; ++k) x += cwv[k] * rx[i + k];
            xb[i] = x; XB[(t0 + i) * 64 + c] = x; }
        __syncthreads();
        float ar[4] = {ba, ba, ba, ba}, ai[4] = {bx, bx, bx, bx};
#pragma unroll 4
        for (int j4 = 0; j4 < 16; ++j4) {
            float wra[4], wrx[4];
#pragma unroll
            for (int e = 0; e < 4; ++e) { wra[e] = wa[(j4 * 4 + e) * 64 + c]; wrx[e] = wx[(j4 * 4 + e) * 64 + c]; }
#pragma unroll
            for (int i = 0; i < 4; ++i) { const f32x4 x4 = *(const LAS f32x4*)(XB + (t0 + i) * 64 + j4 * 4);
                ar[i] += x4[0] * wra[0] + x4[1] * wra[1] + x4[2] * wra[2] + x4[3] * wra[3]; ai[i] += x4[0] * wrx[0] + x4[1] * wrx[1] + x4[2] * wrx[2] + x4[3] * wrx[3]; }
        }
#pragma unroll
        for (int i = 0; i < 4; ++i) { const float r = sigmoidf_(ar[i]), ig = sigmoidf_(ai[i]), la = -8.0f * r * spl, a = __expf(la);
            const float u = sqrtf(fmaxf(1.0f - a * a, 0.f)) * (ig * xb[i]);
            A_[(t0 + i) * 64 + c] = a; U_[(t0 + i) * 64 + c] = u; }
        __syncthreads();
        if (wv == 0) {
#pragma unroll 8
            for (int t = 0; t < TC; ++t) { hstate = A_[t * 64 + c] * hstate + U_[t * 64 + c]; HS[t * 64 + c] = hstate; }
        }
        __syncthreads();
#pragma unroll
        for (int i = 0; i < 4; ++i) { const size_t R = R0 + t0 + i; const float g = cg[i];
            const float u2 = 1.5957691216f * (g + 0.044715f * g * g * g);
            if (!dry) P[R * LDP + PC_LG + cbi] = f2bf(HS[(t0 + i) * 64 + c] * g * sigmoidf_(u2)); }
    }
#undef LRU_LOAD
}

__device__ void ssd_post(const Params& p, int L, int ordG, int ordC) {
    int zo = 0; asm volatile("" : "+s"(zo));
    int tid_ = threadIdx.x; asm volatile("" : "+v"(tid_));
    const int wid = tid_ >> 6, lane = tid_ & 63;
    bf16_t* P = (bf16_t*)(p.ws + OFF_P);
    const f32x4 g0 = *(const f32x4*)(p.in[zo + I_SNG] + L * 512 + lane * 8), g1 = *(const f32x4*)(p.in[zo + I_SNG] + L * 512 + lane * 8 + 4);
    const f32x4 gg0 = *(const f32x4*)(p.in[zo + I_GNG] + L * 128 + (lane & 15) * 8), gg1 = *(const f32x4*)(p.in[zo + I_GNG] + L * 128 + (lane & 15) * 8 + 4);
    for (int row = ordC * 8 + wid; row < T; row += ordG * 8) {
        u32x4* pp = (u32x4*)(P + (size_t)row * LDP + PC_Z + lane * 8); const u32x4 w = *pp;
        float v[8] = {bflo(w.x), bfhi(w.x), bflo(w.y), bfhi(w.y), bflo(w.z), bfhi(w.z), bflo(w.w), bfhi(w.w)};
        float ss = 0.f;
#pragma unroll
        for (int j = 0; j < 8; ++j) ss += v[j] * v[j];
        ss = red32(ss); const float rstd = rsqrtf(ss * (1.0f / 256.0f) + 1e-6f);
        u32x4 o; o.x = cvt_pk_bf16(v[0] * rstd * g0[0], v[1] * rstd * g0[1]); o.y = cvt_pk_bf16(v[2] * rstd * g0[2], v[3] * rstd * g0[3]);
        o.z = cvt_pk_bf16(v[4] * rstd * g1[0], v[5] * rstd * g1[1]); o.w = cvt_pk_bf16(v[6] * rstd * g1[2], v[7] * rstd * g1[3]);
        *pp = o;
        if (!GLA_SPLIT) continue;
        u32x4* gp = (u32x4*)(P + (size_t)row * LDP + PC_GR + lane * 8); const u32x4 yw = *(const u32x4*)(P + (size_t)row * LDP + PC_GV + lane * 8), rw = *gp;
        float y[8] = {bflo(yw.x), bfhi(yw.x), bflo(yw.y), bfhi(yw.y), bflo(yw.z), bfhi(yw.z), bflo(yw.w), bfhi(yw.w)};
        float rg[8] = {bflo(rw.x), bfhi(rw.x), bflo(rw.y), bfhi(rw.y), bflo(rw.z), bfhi(rw.z), bflo(rw.w), bfhi(rw.w)};
        float s2 = 0.f;
#pragma unroll
        for (int j = 0; j < 8; ++j) s2 += y[j] * y[j];
        s2 = red16(s2); const float rs2 = rsqrtf(s2 * (1.0f / 128.0f) + 1e-6f);
        float og[8];
#pragma unroll
        for (int j = 0; j < 8; ++j) og[j] = y[j] * rs2 * (j < 4 ? gg0[j] : gg1[j - 4]) * siluf_(rg[j]);
        u32x4 o2; o2.x = cvt_pk_bf16(og[0], og[1]); o2.y = cvt_pk_bf16(og[2], og[3]); o2.z = cvt_pk_bf16(og[4], og[5]); o2.w = cvt_pk_bf16(og[6], og[7]);
        *gp = o2;
    }
}


__device__ __forceinline__ void b1_fixup(const Params& p, int L, const bf16_t* stp, const float* sts) {
    int zo = 0; asm volatile("" : "+s"(zo));
    int tid_ = threadIdx.x; asm volatile("" : "+v"(tid_));
    bf16_t* P = (bf16_t*)(p.ws + OFF_P); float* SM = (float*)(p.ws + OFF_SM); bf16_t* VF = (bf16_t*)(p.ws + OFF_VF);
    const float* mu = p.in[zo + I_RMU] + L * 1696;
    for (int idx = blockIdx.x * 512 + tid_; idx < 512 * 1792; idx += gridDim.x * 512) {
        const int g = idx / 1792, c = idx % 1792; const size_t R = (size_t)g * 64; const bool first = (R % SEQ) == 0;
        if (c < 1536) { const float cur = bf2f(P[R * LDP + PC_RR + c]), prev = first ? 0.f : bf2f(stp[(size_t)(g - 1) * 1536 + c]);
            const bf16_t o = f2bf(cur + (prev - cur) * mu[c]); P[R * LDP + PC_RR + c] = o; if (L == 0 && c >= 1024) VF[R * 512 + c - 1024] = o; }
        else { const int sc = c - 1536; const float m = (sc >= 64 && sc < 224) ? mu[1536 + sc - 64] : 0.f;
            const float cur = SM[R * 256 + sc], prev = first ? 0.f : sts[(size_t)(g - 1) * 256 + sc]; SM[R * 256 + sc] = cur + (prev - cur) * m; }
    }
}

#define XB_TMO      128
#define XB_XCNT(j)  (256  + 64 * (j))
#define XB_XSUB(j)  (1280 + 64 * (j))
#define XB_XGEN(j)  (2304 + 64 * (j))
#define XB_TOP      3328
#define XB_TOPGEN   3392
#define XCD_BAR_WORDS 3456
#define XB_SPIN_CAP (1u << 22)
__device__ __forceinline__ unsigned xb_ld(unsigned* p)              { return __hip_atomic_load(p, __ATOMIC_RELAXED, __HIP_MEMORY_SCOPE_AGENT); }
__device__ __forceinline__ unsigned xb_add(unsigned* p, unsigned v) { return __hip_atomic_fetch_add(p, v, __ATOMIC_RELAXED, __HIP_MEMORY_SCOPE_AGENT); }
__device__ __forceinline__ unsigned xb_xcc_id() { return (unsigned)__builtin_amdgcn_s_getreg((3 << 11) | 20) & 0xFu; }
#define XB_SPIN(cond, bar) do { unsigned _sp = 0; while (cond) { __builtin_amdgcn_s_sleep(1); \
    if ((++_sp & 255u) == 0u) { if (xb_ld(&(bar)[XB_TMO])) break; if (_sp > XB_SPIN_CAP) { atomicAdd(&(bar)[XB_TMO], 1u); break; } } } } while (0)
struct XcdBarrier { unsigned* bar; unsigned x; volatile LAS unsigned* st; };
__device__ __forceinline__ XcdBarrier xcd_barrier_post(unsigned* bar, volatile LAS unsigned* st) {
    XcdBarrier b; b.bar = bar; b.x = xb_xcc_id(); b.st = st;
    if (threadIdx.x == 0) (void)xb_add(&bar[XB_XCNT(b.x)], 1u);
    return b;
}
__device__ __forceinline__ void xcd_barrier_complete(unsigned* bar, unsigned x, unsigned& nloc, unsigned& nx) {
    const unsigned G = gridDim.x * gridDim.y * gridDim.z;
    unsigned sum, cnt, mine, sp = 0u;
    for (;;) {
        sum = 0u; cnt = 0u; mine = 0u;
#pragma unroll
        for (unsigned j = 0; j < 16; ++j) { const unsigned c = xb_ld(&bar[XB_XCNT(j)]); sum += c; cnt += (c > 0u) ? 1u : 0u; mine = (j == x) ? c : mine; }
        if (sum == G) break;
        __builtin_amdgcn_s_sleep(1);
        if ((++sp & 255u) == 0u) { if (xb_ld(&bar[XB_TMO])) break; if (sp > XB_SPIN_CAP) { atomicAdd(&bar[XB_TMO], 1u); break; } }
    }
    nloc = mine > 0u ? mine : 1u; nx = cnt > 0u ? cnt : 1u;
}
__device__ __attribute__((noinline)) void xcd_barrier(const XcdBarrier b) {
    asm volatile("s_waitcnt vmcnt(0)" ::: "memory");
    __syncthreads();
    if (threadIdx.x == 0) {
        unsigned* bar = b.bar;
        __builtin_amdgcn_s_waitcnt(0);
        unsigned nloc = b.st[0], nx = b.st[1];
        if (nloc == 0u) { xcd_barrier_complete(bar, b.x, nloc, nx); b.st[0] = nloc; b.st[1] = nx; }
        const unsigned old = xb_add(&bar[XB_XSUB(b.x)], 1u);
        const unsigned gen = old / nloc;
        if (old + 1u == (gen + 1u) * nloc) {
            __builtin_amdgcn_fence(__ATOMIC_RELEASE, "agent");
            asm volatile("s_waitcnt vmcnt(0)" ::: "memory");
            const unsigned og = xb_add(&bar[XB_TOP], 1u);
            const unsigned tg = og / nx;
            if (og + 1u == (tg + 1u) * nx) xb_add(&bar[XB_TOPGEN], 1u);
            else XB_SPIN(xb_ld(&bar[XB_TOPGEN]) == tg, bar);
            __builtin_amdgcn_fence(__ATOMIC_ACQUIRE, "agent");
            xb_add(&bar[XB_XGEN(b.x)], 1u);
            asm volatile("s_waitcnt vmcnt(0)" ::: "memory");
        } else {
            XB_SPIN(xb_ld(&bar[XB_XGEN(b.x)]) == gen, bar);
            __builtin_amdgcn_fence(__ATOMIC_ACQUIRE, "agent");
            asm volatile("s_waitcnt vmcnt(0)" ::: "memory");
        }
    }
    __syncthreads();
}

__device__ __attribute__((noinline)) void sub_barrier(unsigned* word, unsigned n) {
    asm volatile("s_waitcnt vmcnt(0)" ::: "memory");
    __syncthreads();
    if (threadIdx.x == 0) {
        __builtin_amdgcn_fence(__ATOMIC_RELEASE, "agent");
        asm volatile("s_waitcnt vmcnt(0)" ::: "memory");
        (void)xb_add(word, 1u);
        unsigned sp = 0;
        while (xb_ld(word) < n) { __builtin_amdgcn_s_sleep(2); if (++sp > (1u << 24)) break; }
        __builtin_amdgcn_fence(__ATOMIC_ACQUIRE, "agent");
        asm volatile("s_waitcnt vmcnt(0)" ::: "memory");
    }
    __syncthreads();
}

__global__ __launch_bounds__(512) void mega(Params p) {
    extern __shared__ __attribute__((aligned(16))) unsigned char smem[];
    cg::grid_group grid = cg::this_grid();
    LAS unsigned char* lds = (LAS unsigned char*)smem; LAS float* lf = (LAS float*)smem;
    unsigned char* ws = p.ws;
    int zo = 0; asm volatile("" : "+s"(zo));
    bf16_t* H = (bf16_t*)(ws + OFF_H); bf16_t* P = (bf16_t*)(ws + OFF_P); float* SM = (float*)(ws + OFF_SM); bf16_t* VF = (bf16_t*)(ws + OFF_VF);
    const bf16_t* zrow = (const bf16_t*)(ws + OFF_Z);
    volatile LAS unsigned* xst = (volatile LAS unsigned*)(lds + LDS_BYTES - 16);
    if (threadIdx.x == 0) { xst[0] = 0u; xst[1] = 0u; }
    __syncthreads();
    const XcdBarrier xb = xcd_barrier_post((unsigned*)(ws + OFF_BAR), xst);
    float* X = p.out;
    bf16_t* ACT = P; float* FO = (float*)(ws + OFF_P + 176 * MiB);
    const int G = (int)gridDim.x, bid = (int)blockIdx.x;
    unsigned* subw = (unsigned*)(ws + OFF_BAR) + 3584;
    if (blockIdx.x == 0) for (int i = threadIdx.x; i < 1024; i += 512) ((unsigned*)(ws + OFF_Z))[i] = 0u;
    convert_weights(p, 0, lf, 0, 1408, G, bid);
    resnorm<0>(p.in[zo + I_X], nullptr, 0, nullptr, nullptr, p.in[zo + I_NG] + 0, H);
    grid.sync();
    for (int L = 0; L < 2; ++L) {
        asm volatile("" : "+s"(zo));
        const float* ng = p.in[zo + I_NG] + (size_t)L * 4 * DM;
        const float* xin = (L == 0) ? p.in[zo + I_X] : X;
        { Epi<EPI_B1> e{}; e.o16 = P; e.o32 = SM; e.vf = (L == 0) ? VF : nullptr; e.mu = p.in[zo + I_RMU] + L * 1696; e.stp = (bf16_t*)(ws + WB_R + 7 * MiB / 2); e.sts = (float*)(ws + WB_R + 5 * MiB);
          gemm_phase<Epi<EPI_B1>, false>(lds, H, DM, (const bf16_t*)(ws + WB_R), T, 1792, 1024, e, zrow, G, bid); }
        xcd_barrier(xb);
        b1_fixup(p, L, (const bf16_t*)(ws + WB_R + 7 * MiB / 2), (const float*)(ws + WB_R + 5 * MiB));
        xcd_barrier(xb);
        {
            const int NR = 64, NO = G - NR;
            if (bid < NR) {
                for (int item = bid; item < 64; item += NR) rwkv_item_old(p, L, item, lds, false);
            } else {
                const int oc = bid - NR;
                { Epi<EPI_B2> e{}; e.o16 = P; gemm_phase<Epi<EPI_B2>, false>(lds, H, DM, (const bf16_t*)(ws + WB_2), T, 3840, 1024, e, zrow, NO, oc); }
                sub_barrier(subw + (L * 2 + 0) * 64, (unsigned)NO);
                for (int item = oc; item < 192; item += NO) {
                    if (item < 64) gla_item(p, L, item, lf, false);
                    else if (item < 128) plain_item<1>(p, L, item - 64, lf, false);
                    else lru_item(p, L, item - 128, lf, false);
                }
                sub_barrier(subw + (L * 2 + 1) * 64, (unsigned)NO);
                ssd_post(p, L, NO, oc);
                convert_weights(p, L, lf, 1408, 5312, NO, oc);
                if (L == 0) convert_weights(p, 1, lf, 0, 1408, NO, oc);
            }
        }
        xcd_barrier(xb);
        bf16_t* U = (L == 0) ? (bf16_t*)p.out : (bf16_t*)(ws + OFF_SM);
        for (int q = 0; q < 4; ++q) {
            { Epi<EPI_U> e{}; e.o16 = U; gemm_phase<Epi<EPI_U>, false>(lds, P + (size_t)q * 8192 * LDP, LDP, (const bf16_t*)(ws + WB_B), 8192, 4096, 512, e, zrow, G, bid); }
            xcd_barrier(xb);
            { Epi<EPI_MERGE> e{}; e.o16 = P + (size_t)q * 8192 * LDP; e.uq = U; gemm_phase<Epi<EPI_MERGE>, false>(lds, H + (size_t)q * 8192 * DM, DM, (const bf16_t*)(ws + WB_G), 8192, 4096, 1024, e, zrow, G, bid); }
            xcd_barrier(xb);
        }
        { Epi<EPI_O> e{}; e.o16 = P; gemm_phase<Epi<EPI_O>, false>(lds, P + PC_MERGED, LDP, (const bf16_t*)(ws + WB_O), T, 1024, 1024, e, zrow, G, bid); }
        xcd_barrier(xb);
        resnorm<1>(xin, P + PC_O, LDP, ng + DM, X, ng + 2 * DM, H);
        xcd_barrier(xb);
        { Epi<EPI_FFN> e{}; e.o16 = ACT; gemm_phase<Epi<EPI_FFN>, false>(lds, H, DM, (const bf16_t*)(ws + WB_F), T, 5632, 1024, e, zrow, G, bid); }
        xcd_barrier(xb);
        { Epi<EPI_DOWN> e{}; e.o16 = (bf16_t*)FO; gemm_phase<Epi<EPI_DOWN>, false>(lds, ACT, FH, (const bf16_t*)(ws + WB_D), T, 1024, FH, e, zrow, G, bid); }
        xcd_barrier(xb);
        if (L == 0) {
            resnorm<1>(X, FO, DM, ng + 3 * DM, X, p.in[zo + I_NG] + 4 * DM, H);
            xcd_barrier(xb);
        } else {
            resnorm<1>(X, FO, DM, ng + 3 * DM, X, nullptr, nullptr);
        }
    }
}

extern "C" void kernel_launch(void* const* d_in, const int* in_sizes, int n_in, void* d_out, int out_size, void* d_ws, size_t ws_size, hipStream_t stream) {
    static int grid_blocks = 0;
    if (grid_blocks == 0) {
        if (n_in != N_INPUTS || out_size != T * DM || ws_size < WS_END) { fprintf(stderr, "kernel_launch: unexpected problem (n_in %d, out %d, ws %zu)\n", n_in, out_size, ws_size); grid_blocks = -1; return; }
        int dev = 0, cus = 0, per_cu = 0;
        (void)hipGetDevice(&dev); (void)hipDeviceGetAttribute(&cus, hipDeviceAttributeMultiprocessorCount, dev);
        if (hipFuncSetAttribute((const void*)mega, hipFuncAttributeMaxDynamicSharedMemorySize, LDS_BYTES) != hipSuccess) { fprintf(stderr, "kernel_launch: hipFuncSetAttribute failed\n"); grid_blocks = -1; return; }
        if (hipOccupancyMaxActiveBlocksPerMultiprocessor(&per_cu, (const void*)mega, 512, LDS_BYTES) != hipSuccess || per_cu < 1) { fprintf(stderr, "kernel_launch: occupancy query says %d\n", per_cu); per_cu = 1; }
        (void)hipGetLastError();
        grid_blocks = cus * 1;
        if (grid_blocks < 128) { fprintf(stderr, "kernel_launch: needs at least 128 CUs\n"); grid_blocks = -1; return; }
    }
    if (grid_blocks < 0) return;
    if (hipMemsetAsync((char*)d_ws + OFF_BAR, 0, 4096 * 4, stream) != hipSuccess) { fprintf(stderr, "kernel_launch: memset failed\n"); return; }
    Params p{};
    for (int i = 0; i < N_INPUTS; ++i) p.in[i] = (const float*)d_in[i];
    p.out = (float*)d_out; p.ws = (unsigned char*)d_ws;
    void* args[] = {&p};
    hipError_t e = hipLaunchCooperativeKernel((const void*)mega, dim3(grid_blocks), dim3(512), args, LDS_BYTES, stream);
    if (e != hipSuccess) fprintf(stderr, "cooperative launch failed: %s (grid %d)\n", hipGetErrorString(e), grid_blocks);
}
```

```cpp
#include <hip/hip_runtime.h>
#include <hip/hip_cooperative_groups.h>
#include <cstdio>
namespace cg = cooperative_groups;

#define LAS __attribute__((address_space(3)))
typedef unsigned short bf16_t;
typedef short bf16x8 __attribute__((ext_vector_type(8)));
typedef float f32x4 __attribute__((ext_vector_type(4)));
typedef unsigned u32x4 __attribute__((ext_vector_type(4)));
typedef unsigned u32x2 __attribute__((ext_vector_type(2)));

constexpr int NB = 8, SEQ = 4096, T = NB * SEQ, DM = 1024, NIN = 9656, FH = 2816, LDP = 5376;
constexpr int BM = 256, BK = 64, HALF = 128, HTB = HALF * BK * 2, STAGE_BYTES = 8 * HTB, NXCD = 8, WGM = 8;
constexpr int LDS_BYTES = 144 * 1024;
constexpr bool DRY_SKIP_SCAN = false;
constexpr bool GLA_SPLIT = true;
constexpr int DRY_MASK = 15;
constexpr int REP_GEMM = 1, REP_SCAN = 0, REP_SYNC = 1, REP_CONV = 1, REP_NORM = 1;
constexpr size_t MiB = 1u << 20;
constexpr size_t WB_R = 0, WB_2 = 7 * MiB, WB_G = WB_2 + 15 * MiB / 2, WB_B = WB_G + 8 * MiB, WB_O = WB_B + 4 * MiB, WB_F = WB_O + 2 * MiB, WB_D = WB_F + 11 * MiB;
constexpr size_t OFF_Z = 45 * MiB, OFF_H = 46 * MiB, OFF_P = 110 * MiB, OFF_SM = 446 * MiB, OFF_VF = 478 * MiB, OFF_BAR = 510 * MiB, OFF_BON = 510 * MiB + 65536, WS_END = OFF_BON + MiB;
constexpr int PC_Z = 0, PC_XBC = 512, PC_GQ = 1280, PC_GK = 1536, PC_GV = 1792, PC_GR = 2304, PC_LX = 2816, PC_LG = 3328, PC_RR = 3840, PC_RK = 4352, PC_RV = 4864;
constexpr int PC_MERGED = 1280, PC_O = 4352;

enum { I_X = 0, I_NG, I_WIN, I_WVRES, I_SCW, I_SCB, I_SDTB, I_SALOG, I_SD, I_SNG, I_GAW, I_GAB, I_GNG, I_LCW, I_LCB, I_LWA, I_LBA, I_LWX, I_LBX, I_LLAM,
       I_RMU, I_RW0, I_RWW2, I_RA0, I_RAW2, I_RV0, I_RVW2, I_RGW2, I_RKK, I_RKA, I_RRK, I_RLNG, I_RLNB, I_WBR, I_WOUT, I_FG, I_FU, I_FD, N_INPUTS };

struct Params { const float* in[N_INPUTS]; float* out; unsigned char* ws; };

__device__ __forceinline__ unsigned cvt_pk_bf16(float lo, float hi) { unsigned r; asm volatile("v_cvt_pk_bf16_f32 %0, %1, %2" : "=v"(r) : "v"(lo), "v"(hi)); return r; }
__device__ __forceinline__ float bf2f(bf16_t v) { return __uint_as_float((unsigned)v << 16); }
__device__ __forceinline__ float bflo(unsigned v) { return __uint_as_float(v << 16); }
__device__ __forceinline__ float bfhi(unsigned v) { return __uint_as_float(v & 0xffff0000u); }
__device__ __forceinline__ bf16_t f2bf(float v) { return (bf16_t)(cvt_pk_bf16(v, 0.f) & 0xffffu); }
__device__ __forceinline__ float sigmoidf_(float x) { return __builtin_amdgcn_rcpf(1.0f + __expf(-x)); }
__device__ __forceinline__ float siluf_(float x) { return x * sigmoidf_(x); }
__device__ __forceinline__ float softplusf_(float x) { return fmaxf(x, 0.f) + log1pf(__expf(-fabsf(x))); }
template <int CTRL> __device__ __forceinline__ float dpp_add(float x) { int v = __builtin_amdgcn_update_dpp(0, __float_as_int(x), CTRL, 0xF, 0xF, true); return x + __int_as_float(v); }
__device__ __forceinline__ float red4(float x) { x = dpp_add<0xB1>(x); x = dpp_add<0x4E>(x); return x; }
__device__ __forceinline__ float red8(float x) { x = red4(x); x = dpp_add<0x141>(x); return x; }
__device__ __forceinline__ float red16(float x) { x = red8(x); x = dpp_add<0x140>(x); return x; }
__device__ __forceinline__ float red32(float x) { x = red16(x); x += __shfl_xor(x, 16); return x; }
__device__ __forceinline__ float red64(float x) { x = red32(x); x += __shfl_xor(x, 32); return x; }
template <int N> __device__ __forceinline__ void red64n(float (&v)[N]) {
#pragma unroll
    for (int i = 0; i < N; ++i) v[i] = red16(v[i]);
    float t[N];
#pragma unroll
    for (int i = 0; i < N; ++i) t[i] = __shfl_xor(v[i], 16);
#pragma unroll
    for (int i = 0; i < N; ++i) v[i] += t[i];
#pragma unroll
    for (int i = 0; i < N; ++i) t[i] = __shfl_xor(v[i], 32);
#pragma unroll
    for (int i = 0; i < N; ++i) v[i] += t[i];
}

__device__ __forceinline__ int lds_byte(int r, int c) { const int st = (r >> 4) * 2 + (c >> 5), rr = r & 15, cc = c & 31, ob = rr * 64 + cc * 2; return st * 1024 + (ob ^ (((ob >> 9) & 1) << 5)); }
__device__ __forceinline__ void stage_rc(int b, int& R, int& C) { const int st = b / 1024, sb = b % 1024, swz = sb ^ (((sb >> 9) & 1) << 5); R = (st >> 1) * 16 + swz / 64; C = (st & 1) * 32 + (swz % 64) / 2; }
__device__ __forceinline__ int perm32(int rho) { const int n = rho >> 4, i = rho & 15; return 8 * (i >> 2) + 4 * n + (i & 3); }
struct Unit { int pm, pn; };
struct Order {
    int nM, nN, nwg, G, c;
    __device__ void init(int M, int N, int G_, int c_) { nM = M / BM; nN = N / BM; nwg = nM * nN; G = G_; c = c_; }
    __device__ bool next(int i, Unit& u) const {
        const long L = (long)i * G + c; if (L >= nwg) return false;
        int wgid = (int)L; { const int q = nwg / NXCD, r = nwg % NXCD, xcd = wgid % NXCD, off = wgid / NXCD; wgid = (xcd < r ? xcd * (q + 1) : r * (q + 1) + (xcd - r) * q) + off; }
        const int nig = WGM * nN, gid = wgid / nig, fm = gid * WGM, gsz = (nM - fm) < WGM ? (nM - fm) : WGM;
        u.pm = fm + ((wgid % nig) % gsz); u.pn = (wgid % nig) / gsz; return true;
    }
};

enum { EPI_B2 = 0, EPI_B1, EPI_U, EPI_MERGE, EPI_O, EPI_FFN, EPI_DOWN };
template <int MODE> struct Epi {
    static constexpr bool PERM = (MODE != EPI_MERGE);
    bf16_t* o16; float* o32; const bf16_t* uq; bf16_t* vf; const float* mu; bf16_t* stp; float* sts;
    __device__ __forceinline__ int a_col(int pn) const { if (MODE == EPI_U) { const int k = pn >> 2; return k == 0 ? PC_Z : (k == 1 ? PC_GR : (k == 2 ? PC_LG : PC_RR)); } return 0; }
    __device__ __forceinline__ void operator()(const f32x4 (&acc)[2][2][4][2], const Unit& u, int wr, int wc, int fr, int fq) const {
        const int row0 = u.pm * BM + wr * 64 + fr;
        if constexpr (MODE == EPI_B1) {
            const bool small = (u.pn == 6);
#pragma unroll
            for (int bj = 0; bj < 2; ++bj) {
                const int cb = u.pn * BM + bj * HALF + wc * 32 + 8 * fq;
                float mu8[8];
#pragma unroll
                for (int e = 0; e < 8; ++e) { const int sc = cb + e - 1536; mu8[e] = !small ? mu[cb + e] : ((sc >= 64 && sc < 224) ? mu[1536 + sc - 64] : 0.f); }
#pragma unroll
                for (int ai = 0; ai < 2; ++ai)
#pragma unroll
                    for (int m = 0; m < 4; ++m) { const size_t r = (size_t)(row0 + ai * HALF + m * 16); float o[8], raw[8];
#pragma unroll
                        for (int e = 0; e < 8; ++e) { const float cur = acc[ai][bj][m][e >> 2][e & 3]; raw[e] = cur;
                            const float p1 = __int_as_float(__builtin_amdgcn_update_dpp(0, __float_as_int(cur), 0x111, 0xF, 0xF, true));
                            float p0 = 0.f; if (m > 0) p0 = __int_as_float(__builtin_amdgcn_update_dpp(0, __float_as_int(acc[ai][bj][m > 0 ? m - 1 : 0][e >> 2][e & 3]), 0x121, 0xF, 0xF, true));
                            const float prev = (fr == 0) ? p0 : p1, lerp = cur + (prev - cur) * mu8[e];
                            o[e] = (fr == 0 && m == 0) ? cur : lerp; }
                        if (small) { float* rp = o32 + r * 256 + (cb - 1536); *(f32x4*)rp = (f32x4){o[0], o[1], o[2], o[3]}; *(f32x4*)(rp + 4) = (f32x4){o[4], o[5], o[6], o[7]}; }
                        else { u32x4 w; w.x = cvt_pk_bf16(o[0], o[1]); w.y = cvt_pk_bf16(o[2], o[3]); w.z = cvt_pk_bf16(o[4], o[5]); w.w = cvt_pk_bf16(o[6], o[7]);
                            *(u32x4*)(o16 + r * LDP + PC_RR + cb) = w; if (vf != nullptr && u.pn >= 4) *(u32x4*)(vf + r * 512 + (cb - 1024)) = w; }
                        if (m == 3 && fr == 15) { const size_t g = r >> 6;
                            if (small) { float* sp = sts + g * 256 + (cb - 1536); *(f32x4*)sp = (f32x4){raw[0], raw[1], raw[2], raw[3]}; *(f32x4*)(sp + 4) = (f32x4){raw[4], raw[5], raw[6], raw[7]}; }
                            else { u32x4 w; w.x = cvt_pk_bf16(raw[0], raw[1]); w.y = cvt_pk_bf16(raw[2], raw[3]); w.z = cvt_pk_bf16(raw[4], raw[5]); w.w = cvt_pk_bf16(raw[6], raw[7]); *(u32x4*)(stp + g * 1536 + cb) = w; } } }
            }
        } else if constexpr (MODE == EPI_B2 || MODE == EPI_O || MODE == EPI_U || MODE == EPI_DOWN) {
            const int ct = wc * 32 + 8 * fq;
            if (MODE == EPI_B1 && u.pn == 6) {
#pragma unroll
                for (int ai = 0; ai < 2; ++ai)
#pragma unroll
                    for (int m = 0; m < 4; ++m) { float* rowp = o32 + (size_t)(row0 + ai * HALF + m * 16) * 256 + ct;
#pragma unroll
                        for (int bj = 0; bj < 2; ++bj) { *(f32x4*)(rowp + bj * HALF) = acc[ai][bj][m][0]; *(f32x4*)(rowp + bj * HALF + 4) = acc[ai][bj][m][1]; } }
                return;
            }
            const int ld = (MODE == EPI_U) ? 4096 : (MODE == EPI_DOWN ? DM : LDP);
            const int colbase = (MODE == EPI_B2) ? 0 : (MODE == EPI_B1 ? PC_RR : (MODE == EPI_O ? PC_O : 0));
            const int col0 = colbase + u.pn * BM + ct;
            const bool dovf = (MODE == EPI_B1) && vf != nullptr && u.pn >= 4;
#pragma unroll
            for (int ai = 0; ai < 2; ++ai)
#pragma unroll
                for (int m = 0; m < 4; ++m) { const size_t r = (size_t)(row0 + ai * HALF + m * 16); bf16_t* rowp = o16 + r * ld + col0;
#pragma unroll
                    for (int bj = 0; bj < 2; ++bj) { const f32x4 v0 = acc[ai][bj][m][0], v1 = acc[ai][bj][m][1];
                        u32x4 w; w.x = cvt_pk_bf16(v0[0], v0[1]); w.y = cvt_pk_bf16(v0[2], v0[3]); w.z = cvt_pk_bf16(v1[0], v1[1]); w.w = cvt_pk_bf16(v1[2], v1[3]);
                        *(u32x4*)(rowp + bj * HALF) = w;
                        if (MODE == EPI_B1) { if (dovf) *(u32x4*)(vf + r * 512 + (u.pn - 4) * BM + ct + bj * HALF) = w; } } }
        } else if constexpr (MODE == EPI_FFN) {
            const int hc0 = u.pn * HALF + wc * 32 + 8 * fq;
#pragma unroll
            for (int ai = 0; ai < 2; ++ai)
#pragma unroll
                for (int m = 0; m < 4; ++m) { bf16_t* rowp = o16 + (size_t)(row0 + ai * HALF + m * 16) * FH + hc0; float a[8];
#pragma unroll
                    for (int n = 0; n < 2; ++n)
#pragma unroll
                        for (int j = 0; j < 4; ++j) a[n * 4 + j] = siluf_(acc[ai][0][m][n][j]) * acc[ai][1][m][n][j];
                    u32x4 w; w.x = cvt_pk_bf16(a[0], a[1]); w.y = cvt_pk_bf16(a[2], a[3]); w.z = cvt_pk_bf16(a[4], a[5]); w.w = cvt_pk_bf16(a[6], a[7]);
                    *(u32x4*)rowp = w; }
        } else {
            const int d0 = u.pn * 64 + wc * 16 + 4 * fq;
#pragma unroll
            for (int ai = 0; ai < 2; ++ai)
#pragma unroll
                for (int m = 0; m < 4; ++m) { const size_t r = (size_t)(row0 + ai * HALF + m * 16); const bf16_t* up = uq + r * 4096 + d0; float s[4] = {0.f, 0.f, 0.f, 0.f};
#pragma unroll
                    for (int bj = 0; bj < 2; ++bj)
#pragma unroll
                        for (int n = 0; n < 2; ++n) { const u32x2 uu = *(const u32x2*)(up + (2 * bj + n) * 1024); const f32x4 g = acc[ai][bj][m][n];
                            s[0] += sigmoidf_(g[0]) * bflo(uu.x); s[1] += sigmoidf_(g[1]) * bfhi(uu.x); s[2] += sigmoidf_(g[2]) * bflo(uu.y); s[3] += sigmoidf_(g[3]) * bfhi(uu.y); }
                    u32x2 w; w.x = cvt_pk_bf16(s[0], s[1]); w.y = cvt_pk_bf16(s[2], s[3]);
                    *(u32x2*)(o16 + r * LDP + PC_MERGED + d0) = w; }
        }
    }
};

template <class EpiT, bool SHIFT>
__device__ __forceinline__ void gemm_phase(LAS unsigned char* lds, const bf16_t* A, int lda, const bf16_t* Bt, int M, int N, int K, const EpiT& E, const bf16_t* zrow, int ordG, int ordC) {
    int tid_ = threadIdx.x; asm volatile("" : "+v"(tid_));
    const int tid = tid_, wid = __builtin_amdgcn_readfirstlane(tid >> 6), lane = tid & 63, wr = wid >> 2, wc = wid & 3, fr = lane & 15, fq = lane >> 4;
    const int nt = K / BK;
    Order S; S.init(M, N, ordG, ordC);
    unsigned voffA[2], voffB[2]; bool z0[2];
#pragma unroll
    for (int i = 0; i < 2; ++i) { int R, C; stage_rc(tid * 16 + i * 8192, R, C); const int Rb = EpiT::PERM ? ((R & ~31) + perm32(R & 31)) : R;
        voffA[i] = (unsigned)(R * lda + C) * 2u; voffB[i] = (unsigned)(Rb * K + C) * 2u; z0[i] = (R == 0); }
    const size_t kstep = (size_t)(BK * 2);
    const size_t hstepA = (size_t)HALF * lda * 2, tstepA = 2 * hstepA, hstepB = (size_t)HALF * K * 2, tstepB = 2 * hstepB;
    const size_t shiftsub = (size_t)lda * 2 + (size_t)K;
    const unsigned ldsw = (unsigned)wid * 1024u;
    const int aoff = lds_byte(wr * 64 + fr, fq * 8), boff = lds_byte(wc * 32 + fr, fq * 8);
#define PG8_SA(b, h) (((b) * 2 + (h)) * HTB)
#define PG8_SB(b, h) ((4 + (b) * 2 + (h)) * HTB)
#define PG8_STAGEB(bufoff, gbase) do { _Pragma("unroll") for (int _i = 0; _i < 2; ++_i) \
        __builtin_amdgcn_global_load_lds((const unsigned*)((const char*)(gbase) + voffB[_i]), (LAS unsigned*)(lds + (bufoff) + ldsw + _i * 8192), 16, 0, 0); } while (0)
#define PG8_STAGEA(bufoff, gbase, zf) do { _Pragma("unroll") for (int _i = 0; _i < 2; ++_i) { const char* _p = (const char*)(gbase) + voffA[_i]; \
        if (SHIFT) { if ((zf) && z0[_i]) _p = (const char*)zrow + lane * 16; } \
        __builtin_amdgcn_global_load_lds((const unsigned*)_p, (LAS unsigned*)(lds + (bufoff) + ldsw + _i * 8192), 16, 0, 0); } } while (0)
#define PG8_LDA(dst, b, h) do { _Pragma("unroll") for (int m = 0; m < 4; ++m) _Pragma("unroll") for (int k = 0; k < 2; ++k) dst[m][k] = *(const LAS bf16x8*)(lds + PG8_SA(b, h) + aoff + m * 2048 + k * 1024); } while (0)
#define PG8_LDB(dst, b, h) do { _Pragma("unroll") for (int n = 0; n < 2; ++n) _Pragma("unroll") for (int k = 0; k < 2; ++k) dst[n][k] = *(const LAS bf16x8*)(lds + PG8_SB(b, h) + boff + n * 2048 + k * 1024); } while (0)
#define PG8_MMA(ai, bj, At, Bt_) do { __builtin_amdgcn_s_setprio(1); _Pragma("unroll") for (int m = 0; m < 4; ++m) _Pragma("unroll") for (int n = 0; n < 2; ++n) _Pragma("unroll") for (int k = 0; k < 2; ++k) \
        acc[ai][bj][m][n] = __builtin_amdgcn_mfma_f32_16x16x32_bf16(Bt_[n][k], At[m][k], acc[ai][bj][m][n], 0, 0, 0); __builtin_amdgcn_s_setprio(0); } while (0)
#define PG8_WAIT_V(n) asm volatile("s_waitcnt vmcnt(" #n ")" ::: "memory")
#define PG8_WAIT_L(n) asm volatile("s_waitcnt lgkmcnt(" #n ")" ::: "memory")
#define PG8_BAR __builtin_amdgcn_s_barrier()
#define PG8_SCHED __builtin_amdgcn_sched_barrier(0)
#define PG8_AOFF(tau) ((size_t)(tau) * kstep - ((SHIFT && (tau) >= nt / 2) ? shiftsub : (size_t)0))
    Unit cur, nxt; int ui = 0;
    if (!S.next(0, cur)) return;
    f32x4 acc[2][2][4][2];
#pragma unroll
    for (int a = 0; a < 2; ++a)
#pragma unroll
        for (int b = 0; b < 2; ++b)
#pragma unroll
            for (int m = 0; m < 4; ++m)
#pragma unroll
                for (int n = 0; n < 2; ++n) acc[a][b][m][n] = (f32x4){0.f, 0.f, 0.f, 0.f};
    bf16x8 At[4][2], B0[2][2], B1[2][2];
    const char* cA = (const char*)(A + E.a_col(cur.pn)) + (size_t)cur.pm * tstepA; const char* cB = (const char*)Bt + (size_t)cur.pn * tstepB;
    PG8_STAGEB(PG8_SB(0, 0), cB); PG8_STAGEA(PG8_SA(0, 0), cA, false); PG8_STAGEB(PG8_SB(0, 1), cB + hstepB); PG8_STAGEA(PG8_SA(0, 1), cA + hstepA, false);
    if (wr == 1) PG8_BAR;
    PG8_WAIT_V(4); PG8_BAR;
    PG8_STAGEB(PG8_SB(1, 0), cB + kstep); PG8_STAGEA(PG8_SA(1, 0), cA + kstep, false); PG8_STAGEB(PG8_SB(1, 1), cB + hstepB + kstep);
    PG8_WAIT_V(6); PG8_BAR;
    for (;;) {
        const bool has_next = S.next(ui + 1, nxt);
        const char* nA = has_next ? (const char*)(A + E.a_col(nxt.pn)) + (size_t)nxt.pm * tstepA : cA; const char* nB = has_next ? (const char*)Bt + (size_t)nxt.pn * tstepB : cB;
        const bool seq0 = SHIFT && ((cur.pm & 15) == 0);
        for (int t = 0; t < nt; t += 2) {
            const bool last = (t == nt - 2);
            const char* a1 = cA + PG8_AOFF(t + 1);
            const char* a2 = last ? nA : cA + PG8_AOFF(t + 2); const char* b2 = last ? nB : cB + (size_t)(t + 2) * kstep;
            const char* a3 = a2 + kstep; const char* b3 = b2 + kstep;
            const bool zf = seq0 && !last && (t + 2 >= nt / 2);
            PG8_LDB(B0, 0, 0); PG8_SCHED; PG8_LDA(At, 0, 0); PG8_STAGEA(PG8_SA(1, 1), a1 + hstepA, false);
            PG8_WAIT_L(8); PG8_BAR; PG8_WAIT_L(0); PG8_MMA(0, 0, At, B0); PG8_BAR; PG8_SCHED;
            PG8_LDB(B1, 0, 1); PG8_STAGEB(PG8_SB(0, 0), b2);
            PG8_BAR; PG8_WAIT_L(0); PG8_MMA(0, 1, At, B1); PG8_BAR;
            PG8_LDA(At, 0, 1); PG8_STAGEA(PG8_SA(0, 0), a2, zf);
            PG8_BAR; PG8_WAIT_L(0); PG8_MMA(1, 0, At, B0); PG8_BAR; PG8_SCHED;
            PG8_STAGEB(PG8_SB(0, 1), b2 + hstepB);
            PG8_WAIT_V(6); PG8_BAR; PG8_MMA(1, 1, At, B1); PG8_BAR;
            PG8_LDB(B0, 1, 0); PG8_SCHED; PG8_LDA(At, 1, 0); PG8_STAGEA(PG8_SA(0, 1), a2 + hstepA, false);
            PG8_WAIT_L(8); PG8_BAR; PG8_WAIT_L(0); PG8_MMA(0, 0, At, B0); PG8_BAR; PG8_SCHED;
            PG8_LDB(B1, 1, 1); PG8_STAGEB(PG8_SB(1, 0), b3);
            PG8_BAR; PG8_WAIT_L(0); PG8_MMA(0, 1, At, B1); PG8_BAR;
            PG8_LDA(At, 1, 1); PG8_STAGEA(PG8_SA(1, 0), a3, zf);
            PG8_BAR; PG8_WAIT_L(0); PG8_MMA(1, 0, At, B0); PG8_BAR; PG8_SCHED;
            PG8_STAGEB(PG8_SB(1, 1), b3 + hstepB);
            PG8_WAIT_V(6); PG8_BAR; PG8_MMA(1, 1, At, B1); PG8_BAR;
        }
        E(acc, cur, wr, wc, fr, fq);
        if (!has_next) break;
#pragma unroll
        for (int a = 0; a < 2; ++a)
#pragma unroll
            for (int b = 0; b < 2; ++b)
#pragma unroll
                for (int m = 0; m < 4; ++m)
#pragma unroll
                    for (int n = 0; n < 2; ++n) acc[a][b][m][n] = (f32x4){0.f, 0.f, 0.f, 0.f};
        cur = nxt; cA = nA; cB = nB; ++ui;
    }
    PG8_WAIT_V(0);
    if (wr == 0) PG8_BAR;
    PG8_BAR;
#undef PG8_SA
#undef PG8_SB
#undef PG8_STAGEA
#undef PG8_STAGEB
#undef PG8_LDA
#undef PG8_LDB
#undef PG8_MMA
#undef PG8_WAIT_V
#undef PG8_WAIT_L
#undef PG8_BAR
#undef PG8_SCHED
#undef PG8_AOFF
}

__device__ __forceinline__ float wval(const Params& p, int zo, int L, int spec, int n, int k) {
    const float* win = p.in[zo + I_WIN] + (size_t)L * DM * NIN;
    if (spec == 0) {
        if (n < 1536) return win[(size_t)k * NIN + 3864 + n];
        const int s = n - 1536;
        if (s < 8) return win[(size_t)k * NIN + 1280 + s];
        if (s < 24) return win[(size_t)k * NIN + 2824 + (s - 8)];
        if (s < 56) return (L == 0) ? 0.f : p.in[zo + I_WVRES][((size_t)(L - 1) * DM + k) * 32 + (s - 24)];
        if (s < 64) return 0.f;
        if (s < 224) return win[(size_t)k * NIN + 5400 + (s - 64)];
        return 0.f;
    } else if (spec == 1) {
        const int col = n < 1280 ? n : (n < 2816 ? n + 8 : n + 24); return win[(size_t)k * NIN + col];
    } else if (spec == 2) {
        const int pn = n >> 8, ct = n & 255, bj = ct >> 7, wc = (ct >> 5) & 3, nn = (ct >> 4) & 1, r16 = ct & 15;
        return win[(size_t)k * NIN + 5560 + (2 * bj + nn) * 1024 + pn * 64 + wc * 16 + r16];
    } else if (spec == 3) {
        const int kb = n >> 10, d = n & 1023; return p.in[zo + I_WBR][(((size_t)L * 4 + kb) * 512 + k) * 1024 + d];
    } else if (spec == 4) {
        return p.in[zo + I_WOUT][((size_t)L * 1024 + k) * 1024 + n];
    } else if (spec == 5) {
        const int pn = n >> 8, ct = n & 255;
        return ct < 128 ? p.in[zo + I_FG][((size_t)L * 1024 + k) * FH + pn * 128 + ct] : p.in[zo + I_FU][((size_t)L * 1024 + k) * FH + pn * 128 + ct - 128];
    } else {
        return p.in[zo + I_FD][((size_t)L * FH + k) * 1024 + n];
    }
}
__device__ void convert_weights(const Params& p, int L, LAS float* lf, int tile0, int tile1, int ordG, int ordC) {
    int zo = 0; asm volatile("" : "+s"(zo));
    int tid_ = threadIdx.x; asm volatile("" : "+v"(tid_));
    const int tid = tid_;
    for (int tile = tile0 + ordC; tile < tile1; tile += ordG) {
        int spec, tl = tile, ktiles; size_t dofs; int K;
        if (tl < 448) { spec = 0; ktiles = 16; dofs = WB_R; K = 1024; }
        else if ((tl -= 448) < 960) { spec = 1; ktiles = 16; dofs = WB_2; K = 1024; }
        else if ((tl -= 960) < 1024) { spec = 2; ktiles = 16; dofs = WB_G; K = 1024; }
        else if ((tl -= 1024) < 512) { spec = 3; ktiles = 8; dofs = WB_B; K = 512; }
        else if ((tl -= 512) < 256) { spec = 4; ktiles = 16; dofs = WB_O; K = 1024; }
        else if ((tl -= 256) < 1408) { spec = 5; ktiles = 16; dofs = WB_F; K = 1024; }
        else { tl -= 1408; spec = 6; ktiles = 44; dofs = WB_D; K = FH; }
        const int n0 = (tl / ktiles) * 64, k0 = (tl % ktiles) * 64;
        bf16_t* dst = (bf16_t*)(p.ws + dofs);
#pragma unroll
        for (int i = 0; i < 8; ++i) { const int idx = tid + i * 512, kk = idx >> 6, nn = idx & 63; lf[kk * 65 + nn] = wval(p, zo, L, spec, n0 + nn, k0 + kk); }
        __syncthreads();
#pragma unroll
        for (int i = 0; i < 4; ++i) { const int idx = tid + i * 512, nn = idx >> 5, k2 = (idx & 31) * 2;
            *(unsigned*)(dst + (size_t)(n0 + nn) * K + k0 + k2) = cvt_pk_bf16(lf[k2 * 65 + nn], lf[(k2 + 1) * 65 + nn]); }
        __syncthreads();
    }
}

template <int DT>
__device__ void resnorm(const float* xin, const void* delta, int ldd, const float* gd, float* xout, const float* gn, bf16_t* H) {
    int tid_ = threadIdx.x; asm volatile("" : "+v"(tid_));
    const int wid = tid_ >> 6, lane = tid_ & 63;
    const int stride = gridDim.x * 8;
    int row = blockIdx.x * 8 + wid;
    f32x4 gdv[4], gnv[4];
#pragma unroll
    for (int j = 0; j < 4; ++j) { gdv[j] = (DT != 0) ? *(const f32x4*)(gd + (j * 64 + lane) * 4) : (f32x4){0.f, 0.f, 0.f, 0.f}; gnv[j] = gn ? *(const f32x4*)(gn + (j * 64 + lane) * 4) : (f32x4){0.f, 0.f, 0.f, 0.f}; }
    f32x4 nx[4], nd[4]; u32x2 nb[4];
#define RN_LOAD(r_) do { _Pragma("unroll") for (int j = 0; j < 4; ++j) { nx[j] = *(const f32x4*)(xin + (size_t)(r_) * DM + (j * 64 + lane) * 4); \
        if (DT == 1) nb[j] = *(const u32x2*)((const bf16_t*)delta + (size_t)(r_) * ldd + (j * 64 + lane) * 4); \
        if (DT == 2) nd[j] = *(const f32x4*)((const float*)delta + (size_t)(r_) * ldd + (j * 64 + lane) * 4); } } while (0)
    if (row < T) RN_LOAD(row);
    while (row < T) {
        f32x4 xv[4], dv[4];
#pragma unroll
        for (int j = 0; j < 4; ++j) { xv[j] = nx[j]; if (DT == 1) dv[j] = (f32x4){bflo(nb[j].x), bfhi(nb[j].x), bflo(nb[j].y), bfhi(nb[j].y)}; if (DT == 2) dv[j] = nd[j]; }
        const int nrow = row + stride;
        if (nrow < T) RN_LOAD(nrow);
        if (DT != 0) {
            float ss = 0.f;
#pragma unroll
            for (int j = 0; j < 4; ++j) ss += dv[j][0] * dv[j][0] + dv[j][1] * dv[j][1] + dv[j][2] * dv[j][2] + dv[j][3] * dv[j][3];
            ss = red64(ss); const float rstd = rsqrtf(ss * (1.0f / DM) + 1e-6f);
#pragma unroll
            for (int j = 0; j < 4; ++j) xv[j] += dv[j] * rstd * gdv[j];
        }
        if (xout) {
#pragma unroll
            for (int j = 0; j < 4; ++j) *(f32x4*)(xout + (size_t)row * DM + (j * 64 + lane) * 4) = xv[j];
        }
        if (gn) {
            float ss = 0.f;
#pragma unroll
            for (int j = 0; j < 4; ++j) ss += xv[j][0] * xv[j][0] + xv[j][1] * xv[j][1] + xv[j][2] * xv[j][2] + xv[j][3] * xv[j][3];
            ss = red64(ss); const float rstd = rsqrtf(ss * (1.0f / DM) + 1e-6f);
#pragma unroll
            for (int j = 0; j < 4; ++j) { const f32x4 h = xv[j] * rstd * gnv[j];
                u32x2 w; w.x = cvt_pk_bf16(h[0], h[1]); w.y = cvt_pk_bf16(h[2], h[3]); *(u32x2*)(H + (size_t)row * DM + (j * 64 + lane) * 4) = w; }
        }
        row = nrow;
    }
#undef RN_LOAD
}

constexpr int TC = 32;
typedef float f32x2 __attribute__((ext_vector_type(2)));
template <int NE, bool RW> struct StepOps { f32x4 w[NE / 4], k[NE / 4], r[NE / 4], a[RW ? NE / 4 : 1], b[RW ? NE / 4 : 1]; float v; };
template <int NE, bool RW>
__device__ __forceinline__ void step_load(StepOps<NE, RW>& o, const LAS float* base, const LAS float* opV, int vo) {
#pragma unroll
    for (int e = 0; e < NE / 4; ++e) { o.w[e] = *(const LAS f32x4*)(base + 4 * e); o.k[e] = *(const LAS f32x4*)(base + 2048 + 4 * e); o.r[e] = *(const LAS f32x4*)(base + 4096 + 4 * e);
        if (RW) { o.a[e] = *(const LAS f32x4*)(base + 6144 + 4 * e); o.b[e] = *(const LAS f32x4*)(base + 8192 + 4 * e); } }
    o.v = opV[vo];
}
#define LO2(q) ((f32x2){(q)[0], (q)[1]})
#define HI2(q) ((f32x2){(q)[2], (q)[3]})
template <int LPR, bool RW>
__device__ __forceinline__ float step_compute(f32x2 (&s)[32 / LPR], const StepOps<64 / LPR, RW>& o) {
    constexpr int NE = 64 / LPR;
    f32x2 tk[NE / 2];
    const f32x2 v2 = (f32x2){o.v, o.v};
#pragma unroll
    for (int e = 0; e < NE / 4; ++e) { tk[2 * e] = LO2(o.k[e]) * v2; tk[2 * e + 1] = HI2(o.k[e]) * v2; }
    if (RW) {
        f32x2 sa2 = (f32x2){0.f, 0.f}, sb2 = (f32x2){0.f, 0.f};
#pragma unroll
        for (int e = 0; e < NE / 4; ++e) { sa2 += s[2 * e] * LO2(o.a[e]); sb2 += s[2 * e + 1] * HI2(o.a[e]); }
        sa2 += sb2; float sa = sa2[0] + sa2[1]; sa = (LPR == 8) ? red8(sa) : red4(sa);
        const f32x2 sv = (f32x2){sa, sa};
#pragma unroll
        for (int e = 0; e < NE / 4; ++e) { tk[2 * e] += LO2(o.b[e]) * sv; tk[2 * e + 1] += HI2(o.b[e]) * sv; }
    }
    f32x2 y2 = (f32x2){0.f, 0.f}, z2 = (f32x2){0.f, 0.f};
#pragma unroll
    for (int e = 0; e < NE / 4; ++e) { s[2 * e] = s[2 * e] * LO2(o.w[e]) + tk[2 * e]; s[2 * e + 1] = s[2 * e + 1] * HI2(o.w[e]) + tk[2 * e + 1];
        y2 += s[2 * e] * LO2(o.r[e]); z2 += s[2 * e + 1] * HI2(o.r[e]); }
    y2 += z2; float y = y2[0] + y2[1]; y = (LPR == 8) ? red8(y) : red4(y);
    return y;
}
template <int LPR, bool RW>
__device__ __forceinline__ void scan_chunk(f32x2 (&s)[32 / LPR], const LAS float* opW, const LAS float* opK, const LAS float* opR, const LAS float* opA, const LAS float* opB,
                                           const LAS float* opV, LAS float* Y, int vstride, int row, int sub) {
    constexpr int NE = 64 / LPR;
    StepOps<NE, RW> o0, o1;
    unsigned bt = (unsigned)(size_t)(opW + sub * NE), bv = (unsigned)(size_t)(opV + row), by = (unsigned)(size_t)(Y + row);
    step_load<NE, RW>(o0, (const LAS float*)(size_t)bt, (const LAS float*)(size_t)bv, 0);
#pragma unroll 1
    for (int t = 0; t < TC; t += 4) {
        asm volatile("" : "+v"(bt), "+v"(bv), "+v"(by));
        const LAS float* b0 = (const LAS float*)(size_t)bt; const LAS float* v0 = (const LAS float*)(size_t)bv; LAS float* yp = (LAS float*)(size_t)by;
        step_load<NE, RW>(o1, b0 + 64, v0, vstride);
        const float y0 = step_compute<LPR, RW>(s, o0);
        step_load<NE, RW>(o0, b0 + 128, v0, 2 * vstride);
        const float y1 = step_compute<LPR, RW>(s, o1);
        step_load<NE, RW>(o1, b0 + 192, v0, 3 * vstride);
        const float y2 = step_compute<LPR, RW>(s, o0);
        step_load<NE, RW>(o0, b0 + 256, v0, 4 * vstride);
        const float y3 = step_compute<LPR, RW>(s, o1);
        yp[0] = y0; yp[vstride] = y1; yp[2 * vstride] = y2; yp[3 * vstride] = y3;
        bt += 1024; bv += 16 * vstride; by += 16 * vstride;
    }
}

__device__ void rwkv_item_old(const Params& p, int L, int item, LAS unsigned char* lds, bool dry) {
    int zo = 0; asm volatile("" : "+s"(zo));
    int tid_ = threadIdx.x; asm volatile("" : "+v"(tid_));
    const int b = item >> 3, h = item & 7, tid = tid_, wv = tid >> 6, lane = tid & 63, c = lane, hc = h * 64 + c;
    LAS bf16_t* WT = (LAS bf16_t*)lds;
    LAS bf16_t* LOSB = WT + 64 * 200;
    LAS float* AW = (LAS float*)(lds + 38400); LAS float* AA = AW + 2048; LAS float* AV = AA + 2048; LAS float* G = AV + 2048;
    LAS float* opW = G + 2048; LAS float* opK = opW + 2048; LAS float* opR = opK + 2048; LAS float* opA = opR + 2048; LAS float* opB = opA + 2048;
    LAS float* opV = opB + 2048; LAS float* Y = opV + 2048; LAS float* BON = Y + 2048; LAS float* G1 = BON + 32;
    bf16_t* P = (bf16_t*)(p.ws + OFF_P); const float* SM = (const float*)(p.ws + OFF_SM); const bf16_t* VF = (const bf16_t*)(p.ws + OFF_VF);
    __syncthreads();
    for (int i = tid; i < 192 * 64; i += 512) { const int j = i >> 6, cc = i & 63; float v;
        if (j < 32) v = p.in[zo + I_RWW2][((size_t)L * 32 + j) * 512 + h * 64 + cc];
        else if (j < 64) v = p.in[zo + I_RAW2][((size_t)L * 32 + (j - 32)) * 512 + h * 64 + cc];
        else if (j < 96) v = (L > 0) ? p.in[zo + I_RVW2][((size_t)(L - 1) * 32 + (j - 64)) * 512 + h * 64 + cc] : 0.f;
        else v = p.in[zo + I_RGW2][((size_t)L * 96 + (j - 96)) * 512 + h * 64 + cc];
        WT[cc * 200 + j] = f2bf(v); }
    const float w0 = p.in[zo + I_RW0][L * 512 + hc], a0 = p.in[zo + I_RA0][L * 512 + hc], v0 = (L > 0) ? p.in[zo + I_RV0][(L - 1) * 512 + hc] : 0.f;
    const float k_k = p.in[zo + I_RKK][L * 512 + hc], k_a = p.in[zo + I_RKA][L * 512 + hc], r_k = p.in[zo + I_RRK][L * 512 + hc], ln_g = p.in[zo + I_RLNG][L * 512 + hc], ln_b = p.in[zo + I_RLNB][L * 512 + hc];
    f32x2 s[4];
#pragma unroll
    for (int e = 0; e < 4; ++e) s[e] = (f32x2){0.f, 0.f};
    const int row = wv * 8 + (lane >> 3), sub = lane & 7;
    int smo[12];
#pragma unroll
    for (int i = 0; i < 12; ++i) { const int idx = tid + i * 512, t = idx / 192, j = idx % 192; smo[i] = t * 256 + (j < 64 ? 64 + j : (j < 96 ? j - 40 : j + 32)); }
    float nsm[12]; bf16_t nr[4], nk[4], nv[4], nf[4];
#define RWKV_LOAD_SM(chn) do { const size_t Rn = (size_t)b * SEQ + (size_t)(chn) * TC; \
        _Pragma("unroll") for (int i = 0; i < 12; ++i) nsm[i] = SM[Rn * 256 + smo[i]]; } while (0)
#define RWKV_LOAD(chn) do { const size_t Rn = (size_t)b * SEQ + (size_t)(chn) * TC; \
        _Pragma("unroll") for (int i = 0; i < 4; ++i) { const size_t R = Rn + wv * 4 + i; nr[i] = P[R * LDP + PC_RR + hc]; nk[i] = P[R * LDP + PC_RK + hc]; nv[i] = P[R * LDP + PC_RV + hc]; nf[i] = (L > 0) ? VF[R * 512 + hc] : (bf16_t)0; } } while (0)
#define RWKV_P0() do { _Pragma("unroll") for (int i = 0; i < 12; ++i) { const int idx = tid + i * 512, t = idx / 192, j = idx % 192; \
            const float v = nsm[i], e = __expf(j < 32 ? 2.0f * v : -v), rr = __builtin_amdgcn_rcpf(1.0f + e);     \
            LOSB[t * 200 + j] = f2bf(j < 32 ? 1.0f - 2.0f * rr : (j >= 96 ? rr : v)); } } while (0)
    RWKV_LOAD_SM(0); RWKV_P0(); RWKV_LOAD_SM(1); RWKV_LOAD(0);
    __syncthreads();
    for (int ch = 0; ch < SEQ / TC; ++ch) {
        const size_t R0 = (size_t)b * SEQ + (size_t)ch * TC;
        LAS float* Gc = (ch & 1) ? G1 : G;
        { const int mt = wv & 1, nt = wv >> 1; const int ao = (mt * 16 + (lane & 15)) * 200 + 8 * (lane >> 4), bo = (nt * 16 + (lane & 15)) * 200 + 8 * (lane >> 4);
            bf16x8 af[6], bfr[6];
#pragma unroll
            for (int ks = 0; ks < 6; ++ks) { af[ks] = *(const LAS bf16x8*)(LOSB + ao + ks * 32); bfr[ks] = *(const LAS bf16x8*)(WT + bo + ks * 32); }
            const f32x4 z4 = (f32x4){0.f, 0.f, 0.f, 0.f};
            const f32x4 cw = __builtin_amdgcn_mfma_f32_16x16x32_bf16(af[0], bfr[0], z4, 0, 0, 0);
            const f32x4 ca = __builtin_amdgcn_mfma_f32_16x16x32_bf16(af[1], bfr[1], z4, 0, 0, 0);
            const f32x4 cvv = __builtin_amdgcn_mfma_f32_16x16x32_bf16(af[2], bfr[2], z4, 0, 0, 0);
            f32x4 cg = __builtin_amdgcn_mfma_f32_16x16x32_bf16(af[3], bfr[3], z4, 0, 0, 0);
            cg = __builtin_amdgcn_mfma_f32_16x16x32_bf16(af[4], bfr[4], cg, 0, 0, 0);
            cg = __builtin_amdgcn_mfma_f32_16x16x32_bf16(af[5], bfr[5], cg, 0, 0, 0);
#pragma unroll
            for (int rg = 0; rg < 4; ++rg) { const int o = (mt * 16 + (lane >> 4) * 4 + rg) * 64 + nt * 16 + (lane & 15); AW[o] = cw[rg]; AA[o] = ca[rg]; AV[o] = cvv[rg]; Gc[o] = cg[rg]; } }
        __syncthreads();
        { float kkr[4], km[4], av_[4], vv[4], rr_[4], red[8];
#pragma unroll
            for (int i = 0; i < 4; ++i) { const int t = wv * 4 + i;
                av_[i] = sigmoidf_(a0 + AA[t * 64 + c]);
                const float k_ = bf2f(nk[i]); rr_[i] = bf2f(nr[i]); vv[i] = bf2f(nv[i]);
                if (L > 0) { const float vf = bf2f(nf[i]); vv[i] = vv[i] + (vf - vv[i]) * sigmoidf_(v0 + AV[t * 64 + c]); }
                kkr[i] = k_ * k_k; km[i] = k_ * (1.0f + (av_[i] - 1.0f) * k_a);
                red[i] = kkr[i] * kkr[i]; red[4 + i] = rr_[i] * km[i] * r_k; }
            red64n<8>(red);
#pragma unroll
            for (int i = 0; i < 4; ++i) { const int t = wv * 4 + i;
                const float wdec = __expf(-0.60653066f * sigmoidf_(w0 + AW[t * 64 + c]));
                const float kk = kkr[i] * rsqrtf(fmaxf(red[i], 1e-24f));
                opW[t * 64 + c] = wdec; opK[t * 64 + c] = km[i]; opR[t * 64 + c] = rr_[i]; opA[t * 64 + c] = -kk; opB[t * 64 + c] = kk * av_[i]; opV[t * 64 + c] = vv[i];
                if (lane == 0) BON[t] = red[4 + i]; } }
        if (ch + 1 < SEQ / TC) { RWKV_P0(); RWKV_LOAD(ch + 1); if (ch + 2 < SEQ / TC) RWKV_LOAD_SM(ch + 2); }
        __syncthreads();
        if (!(dry && DRY_SKIP_SCAN)) scan_chunk<8, true>(s, opW, opK, opR, opA, opB, opV, Y, 64, row, sub);
        __syncthreads();
        { float y[4], m[4], q[4];
#pragma unroll
            for (int i = 0; i < 4; ++i) { y[i] = Y[(wv * 4 + i) * 64 + c]; m[i] = y[i]; }
            red64n<4>(m);
#pragma unroll
            for (int i = 0; i < 4; ++i) { y[i] -= m[i] * (1.0f / 64.0f); q[i] = y[i] * y[i]; }
            red64n<4>(q);
#pragma unroll
            for (int i = 0; i < 4; ++i) { const int t = wv * 4 + i; const size_t R = R0 + t;
                float yn = y[i] * rsqrtf(q[i] * (1.0f / 64.0f) + 64e-5f) * ln_g + ln_b; yn += BON[t] * opV[t * 64 + c];
                if (!dry) P[R * LDP + PC_RR + hc] = f2bf(yn * Gc[t * 64 + c]); } }
    }
#undef RWKV_LOAD_SM
#undef RWKV_P0
#undef RWKV_LOAD
}


__device__ void gla_item(const Params& p, int L, int item, LAS float* lf, bool dry) {
    int zo = 0; asm volatile("" : "+s"(zo));
    int tid_ = threadIdx.x; asm volatile("" : "+v"(tid_));
    const int tid = tid_, wv = tid >> 6, lane = tid & 63, c = lane;
    LAS float* opW = lf; LAS float* opK = opW + 2048; LAS float* opR = opK + 2048; LAS float* opV = opR + 2048; LAS float* Y = opV + 2048; LAS float* X0 = Y + 2048; LAS float* X1 = X0 + 512;
    bf16_t* P = (bf16_t*)(p.ws + OFF_P); const float* SM = (const float*)(p.ws + OFF_SM);
    const int half = item & 1, bh = item >> 1, b = bh >> 2, h = bh & 3, vcol = PC_GV + h * 128 + half * 64;
    __syncthreads();
    for (int i = tid; i < 16 * 64; i += 512) X1[i] = p.in[zo + I_GAW][((size_t)L * 16 + (i >> 6)) * 256 + h * 64 + (i & 63)];
    const float ab = p.in[zo + I_GAB][L * 256 + h * 64 + c];
    f32x2 s[4];
#pragma unroll
    for (int e = 0; e < 4; ++e) s[e] = (f32x2){0.f, 0.f};
    const int row = wv * 8 + (lane >> 3), sub = lane & 7;
    float nlo; bf16_t nvv[4], nk[4], nq[4];
#define GLA_LOAD(chn) do { const size_t Rn = (size_t)b * SEQ + (size_t)(chn) * TC; nlo = SM[(Rn + (tid >> 4)) * 256 + 8 + (tid & 15)]; \
        _Pragma("unroll") for (int i = 0; i < 4; ++i) { const int idx = tid + i * 512; nvv[i] = P[(Rn + (idx >> 6)) * LDP + vcol + (idx & 63)]; } \
        _Pragma("unroll") for (int i = 0; i < 4; ++i) { const size_t R = Rn + wv * 4 + i; nk[i] = P[R * LDP + PC_GK + h * 64 + c]; nq[i] = P[R * LDP + PC_GQ + h * 64 + c]; } } while (0)
    GLA_LOAD(0);
    for (int ch = 0; ch < SEQ / TC; ++ch) {
        const size_t R0 = (size_t)b * SEQ + (size_t)ch * TC;
        X0[tid] = nlo;
#pragma unroll
        for (int i = 0; i < 4; ++i) opV[tid + i * 512] = bf2f(nvv[i]);
        bf16_t ck[4], cq[4];
#pragma unroll
        for (int i = 0; i < 4; ++i) { ck[i] = nk[i]; cq[i] = nq[i]; }
        if (ch + 1 < SEQ / TC) GLA_LOAD(ch + 1);
        __syncthreads();
#pragma unroll
        for (int i = 0; i < 4; ++i) { const int t = wv * 4 + i; float la = ab;
#pragma unroll
            for (int j = 0; j < 16; ++j) la += X0[t * 16 + j] * X1[j * 64 + c];
            opW[t * 64 + c] = __expf(__logf(sigmoidf_(la)) * (1.0f / 16.0f));
            opK[t * 64 + c] = bf2f(ck[i]); opR[t * 64 + c] = bf2f(cq[i]) * 0.125f; }
        __syncthreads();
        scan_chunk<8, false>(s, opW, opK, opR, opW, opW, opV, Y, 64, row, sub);
        __syncthreads();
        if (!dry) {
#pragma unroll
            for (int i = 0; i < 4; ++i) { const int t = wv * 4 + i; P[(R0 + t) * LDP + vcol + c] = f2bf(Y[t * 64 + c]); }
        }
    }
#undef GLA_LOAD
}

template <int MODE>
__device__ void plain_item(const Params& p, int L, int item, LAS float* lf, bool dry) {
    int zo = 0; asm volatile("" : "+s"(zo));
    int tid_ = threadIdx.x; asm volatile("" : "+v"(tid_));
    const int tid = tid_, wv = tid >> 6, lane = tid & 63, c = lane;
    constexpr int VS = (MODE == 0) ? 128 : 64;
    LAS float* opW = lf; LAS float* opK = opW + 2048; LAS float* opR = opK + 2048; LAS float* opV = opR + 2048; LAS float* Y = opV + TC * VS; LAS float* X0 = Y + TC * VS; LAS float* X1 = X0 + 2048;
    bf16_t* P = (bf16_t*)(p.ws + OFF_P); const float* SM = (const float*)(p.ws + OFF_SM);
    __syncthreads();
    if (MODE == 0) {
        const int b = item >> 2, h = item & 3;
        for (int i = tid; i < 16 * 64; i += 512) X1[i] = p.in[zo + I_GAW][((size_t)L * 16 + (i >> 6)) * 256 + h * 64 + (i & 63)];
        const float ab = p.in[zo + I_GAB][L * 256 + h * 64 + c], gn0 = p.in[zo + I_GNG][L * 128 + lane], gn1 = p.in[zo + I_GNG][L * 128 + 64 + lane];
        f32x2 s[8];
#pragma unroll
        for (int e = 0; e < 8; ++e) s[e] = (f32x2){0.f, 0.f};
        const int row = wv * 16 + (lane >> 2), sub = lane & 3;
        float nlo; bf16_t nvv[8], nk[4], nq[4], ng0[4], ng1[4];
#define GLA_LOAD(chn) do { const size_t Rn = (size_t)b * SEQ + (size_t)(chn) * TC; nlo = SM[(Rn + (tid >> 4)) * 256 + 8 + (tid & 15)]; \
        _Pragma("unroll") for (int i = 0; i < 8; ++i) { const int idx = tid + i * 512; nvv[i] = P[(Rn + (idx >> 7)) * LDP + PC_GV + h * 128 + (idx & 127)]; } \
        _Pragma("unroll") for (int i = 0; i < 4; ++i) { const size_t R = Rn + wv * 4 + i; nk[i] = P[R * LDP + PC_GK + h * 64 + c]; nq[i] = P[R * LDP + PC_GQ + h * 64 + c]; \
            ng0[i] = P[R * LDP + PC_GR + h * 128 + lane]; ng1[i] = P[R * LDP + PC_GR + h * 128 + 64 + lane]; } } while (0)
        GLA_LOAD(0);
        for (int ch = 0; ch < SEQ / TC; ++ch) {
            const size_t R0 = (size_t)b * SEQ + (size_t)ch * TC;
            X0[tid] = nlo;
#pragma unroll
            for (int i = 0; i < 8; ++i) opV[tid + i * 512] = bf2f(nvv[i]);
            bf16_t ck[4], cq[4], cg0[4], cg1[4];
#pragma unroll
            for (int i = 0; i < 4; ++i) { ck[i] = nk[i]; cq[i] = nq[i]; cg0[i] = ng0[i]; cg1[i] = ng1[i]; }
            if (ch + 1 < SEQ / TC) GLA_LOAD(ch + 1);
            __syncthreads();
#pragma unroll
            for (int i = 0; i < 4; ++i) { const int t = wv * 4 + i; float la = ab;
#pragma unroll
                for (int j = 0; j < 16; ++j) la += X0[t * 16 + j] * X1[j * 64 + c];
                opW[t * 64 + c] = __expf(__logf(sigmoidf_(la)) * (1.0f / 16.0f));
                opK[t * 64 + c] = bf2f(ck[i]); opR[t * 64 + c] = bf2f(cq[i]) * 0.125f; }
            __syncthreads();
            scan_chunk<4, false>(s, opW, opK, opR, opW, opW, opV, Y, 128, row, sub);
            __syncthreads();
#pragma unroll
            for (int i = 0; i < 4; ++i) { const int t = wv * 4 + i; const size_t R = R0 + t;
                const float y0 = Y[t * 128 + lane], y1 = Y[t * 128 + 64 + lane], ss = red64(y0 * y0 + y1 * y1), rstd = rsqrtf(ss * (1.0f / 128.0f) + 1e-6f);
                bf16_t* rp = P + R * LDP + PC_GR + h * 128;
                const float r0 = bf2f(cg0[i]), r1 = bf2f(cg1[i]);
                if (!dry) { rp[lane] = f2bf(y0 * rstd * gn0 * siluf_(r0)); rp[64 + lane] = f2bf(y1 * rstd * gn1 * siluf_(r1)); } }
        }
#undef GLA_LOAD
    } else {
        const int b = item >> 3, hh = item & 7, g = hh >> 2;
        const int chx = hh * 64 + c, chb = 512 + g * 64 + c, chc = 640 + g * 64 + c;
        const float* cw = p.in[zo + I_SCW] + (size_t)L * 4 * 768; const float* cb = p.in[zo + I_SCB] + (size_t)L * 768;
        float cwx[4], cwb[4], cwc[4];
#pragma unroll
        for (int k = 0; k < 4; ++k) { cwx[k] = cw[k * 768 + chx]; cwb[k] = cw[k * 768 + chb]; cwc[k] = cw[k * 768 + chc]; }
        const float cbx = cb[chx], cbb = cb[chb], cbc = cb[chc];
        const float dtb = p.in[zo + I_SDTB][L * 8 + hh], Aneg = -__expf(p.in[zo + I_SALOG][L * 8 + hh]), Dsk = p.in[zo + I_SD][L * 8 + hh];
        f32x2 s[4];
#pragma unroll
        for (int e = 0; e < 4; ++e) s[e] = (f32x2){0.f, 0.f};
        const int row = wv * 8 + (lane >> 3), sub = lane & 7;
        const int t0 = wv * 4;
        bf16_t nx[7], nb[7], nc[7], nz[4]; float ndt[4];
#define SSD_LOAD(chn) do { const int sp0 = (chn) * TC + t0; \
        _Pragma("unroll") for (int q = 0; q < 7; ++q) { const int sp = sp0 - 3 + q; const size_t R = (size_t)b * SEQ + sp; \
            if (sp >= 0) { nx[q] = P[R * LDP + PC_XBC + chx]; nb[q] = P[R * LDP + PC_XBC + chb]; nc[q] = P[R * LDP + PC_XBC + chc]; } else { nx[q] = 0; nb[q] = 0; nc[q] = 0; } } \
        _Pragma("unroll") for (int i = 0; i < 4; ++i) { const size_t R = (size_t)b * SEQ + sp0 + i; nz[i] = P[R * LDP + PC_Z + chx]; ndt[i] = SM[R * 256 + hh]; } } while (0)
        SSD_LOAD(0);
        for (int ch = 0; ch < SEQ / TC; ++ch) {
            const size_t R0 = (size_t)b * SEQ + (size_t)ch * TC;
            float rx[7], rb[7], rc[7], cz[4], cdt[4];
#pragma unroll
            for (int q = 0; q < 7; ++q) { rx[q] = bf2f(nx[q]); rb[q] = bf2f(nb[q]); rc[q] = bf2f(nc[q]); }
#pragma unroll
            for (int i = 0; i < 4; ++i) { cz[i] = bf2f(nz[i]); cdt[i] = ndt[i]; }
            if (ch + 1 < SEQ / TC) SSD_LOAD(ch + 1);
#pragma unroll
            for (int i = 0; i < 4; ++i) { const int t = t0 + i;
                float x = cbx, bm = cbb, cm = cbc;
#pragma unroll
                for (int k = 0; k < 4; ++k) { x += cwx[k] * rx[i + k]; bm += cwb[k] * rb[i + k]; cm += cwc[k] * rc[i + k]; }
                x = siluf_(x); bm = siluf_(bm); cm = siluf_(cm);
                const float dt = softplusf_(cdt[i] + dtb);
                opW[t * 64 + c] = __expf(dt * Aneg); opK[t * 64 + c] = bm; opR[t * 64 + c] = cm; opV[t * 64 + c] = dt * x; X0[t * 64 + c] = x; }
            __syncthreads();
            scan_chunk<8, false>(s, opW, opK, opR, opW, opW, opV, Y, 64, row, sub);
            __syncthreads();
#pragma unroll
            for (int i = 0; i < 4; ++i) { const int t = t0 + i; const size_t R = R0 + t;
                const float y = Y[t * 64 + c] + Dsk * X0[t * 64 + c];
                if (!dry) P[R * LDP + PC_Z + chx] = f2bf(y * siluf_(cz[i])); }
            __syncthreads();
        }
#undef SSD_LOAD
    }
}

__device__ void lru_item(const Params& p, int L, int item, LAS float* lf, bool dry) {
    int zo = 0; asm volatile("" : "+s"(zo));
    int tid_ = threadIdx.x; asm volatile("" : "+v"(tid_));
    const int b = item >> 3, blk = item & 7, tid = tid_, wv = tid >> 6, lane = tid & 63, c = lane, cbi = blk * 64 + c;
    LAS float* wa = lf; LAS float* wx = wa + 4096; LAS float* XB = wx + 4096; LAS float* A_ = XB + 2048; LAS float* U_ = A_ + 2048; LAS float* HS = U_ + 2048;
    bf16_t* P = (bf16_t*)(p.ws + OFF_P);
    __syncthreads();
    for (int i = tid; i < 4096; i += 512) { wa[i] = p.in[zo + I_LWA][((size_t)L * 8 + blk) * 4096 + i]; wx[i] = p.in[zo + I_LWX][((size_t)L * 8 + blk) * 4096 + i]; }
    float cwv[4];
#pragma unroll
    for (int k = 0; k < 4; ++k) cwv[k] = p.in[zo + I_LCW][((size_t)L * 4 + k) * 512 + cbi];
    const float cbv = p.in[zo + I_LCB][L * 512 + cbi], ba = p.in[zo + I_LBA][L * 512 + cbi], bx = p.in[zo + I_LBX][L * 512 + cbi];
    const float spl = softplusf_(-p.in[zo + I_LLAM][L * 512 + cbi]);
    float hstate = 0.f;
    const int t0 = wv * 4;
    bf16_t nx[7], ngt[4];
#define LRU_LOAD(chn) do { const int sp0 = (chn) * TC + t0; \
        _Pragma("unroll") for (int q = 0; q < 7; ++q) { const int sp = sp0 - 3 + q; nx[q] = (sp >= 0) ? P[((size_t)b * SEQ + sp) * LDP + PC_LX + cbi] : (bf16_t)0; } \
        _Pragma("unroll") for (int i = 0; i < 4; ++i) ngt[i] = P[((size_t)b * SEQ + sp0 + i) * LDP + PC_LG + cbi]; } while (0)
    LRU_LOAD(0);
    for (int ch = 0; ch < SEQ / TC; ++ch) {
        const size_t R0 = (size_t)b * SEQ + (size_t)ch * TC;
        float rx[7], cg[4];
#pragma unroll
        for (int q = 0; q < 7; ++q) rx[q] = bf2f(nx[q]);
#pragma unroll
        for (int i = 0; i < 4; ++i) cg[i] = bf2f(ngt[i]);
        if (ch + 1 < SEQ / TC) LRU_LOAD(ch + 1);
        float xb[4];
#pragma unroll
        for (int i = 0; i < 4; ++i) { float x = cbv;
#pragma unroll
            for (int k = 0; k < 4; ++k) x += cwv[k] * rx[i + k];
            xb[i] = x; XB[(t0 + i) * 64 + c] = x; }
        __syncthreads();
        float ar[4] = {ba, ba, ba, ba}, ai[4] = {bx, bx, bx, bx};
#pragma unroll 4
        for (int j4 = 0; j4 < 16; ++j4) {
            float wra[4], wrx[4];
#pragma unroll
            for (int e = 0; e < 4; ++e) { wra[e] = wa[(j4 * 4 + e) * 64 + c]; wrx[e] = wx[(j4 * 4 + e) * 64 + c]; }
#pragma unroll
            for (int i = 0; i < 4; ++i) { const f32x4 x4 = *(const LAS f32x4*)(XB + (t0 + i) * 64 + j4 * 4);
                ar[i] += x4[0] * wra[0] + x4[1] * wra[1] + x4[2] * wra[2] + x4[3] * wra[3]; ai[i] += x4[0] * wrx[0] + x4[1] * wrx[1] + x4[2] * wrx[2] + x4[3] * wrx[3]; }
        }
#pragma unroll
        for (int i = 0; i < 4; ++i) { const float r = sigmoidf_(ar[i]), ig = sigmoidf_(ai[i]), la = -8.0f * r * spl, a = __expf(la);
            const float u = sqrtf(fmaxf(1.0f - a * a, 0.f)) * (ig * xb[i]);
            A_[(t0 + i) * 64 + c] = a; U_[(t0 + i) * 64 + c] = u; }
        __syncthreads();
        if (wv == 0) {
#pragma unroll 8
            for (int t = 0; t < TC; ++t) { hstate = A_[t * 64 + c] * hstate + U_[t * 64 + c]; HS[t * 64 + c] = hstate; }
        }
        __syncthreads();
#pragma unroll
        for (int i = 0; i < 4; ++i) { const size_t R = R0 + t0 + i; const float g = cg[i];
            const float u2 = 1.5957691216f * (g + 0.044715f * g * g * g);
            if (!dry) P[R * LDP + PC_LG + cbi] = f2bf(HS[(t0 + i) * 64 + c] * g * sigmoidf_(u2)); }
    }
#undef LRU_LOAD
}

__device__ void ssd_post(const Params& p, int L, int ordG, int ordC) {
    int zo = 0; asm volatile("" : "+s"(zo));
    int tid_ = threadIdx.x; asm volatile("" : "+v"(tid_));
    const int wid = tid_ >> 6, lane = tid_ & 63;
    bf16_t* P = (bf16_t*)(p.ws + OFF_P);
    const f32x4 g0 = *(const f32x4*)(p.in[zo + I_SNG] + L * 512 + lane * 8), g1 = *(const f32x4*)(p.in[zo + I_SNG] + L * 512 + lane * 8 + 4);
    const f32x4 gg0 = *(const f32x4*)(p.in[zo + I_GNG] + L * 128 + (lane & 15) * 8), gg1 = *(const f32x4*)(p.in[zo + I_GNG] + L * 128 + (lane & 15) * 8 + 4);
    for (int row = ordC * 8 + wid; row < T; row += ordG * 8) {
        u32x4* pp = (u32x4*)(P + (size_t)row * LDP + PC_Z + lane * 8); const u32x4 w = *pp;
        float v[8] = {bflo(w.x), bfhi(w.x), bflo(w.y), bfhi(w.y), bflo(w.z), bfhi(w.z), bflo(w.w), bfhi(w.w)};
        float ss = 0.f;
#pragma unroll
        for (int j = 0; j < 8; ++j) ss += v[j] * v[j];
        ss = red32(ss); const float rstd = rsqrtf(ss * (1.0f / 256.0f) + 1e-6f);
        u32x4 o; o.x = cvt_pk_bf16(v[0] * rstd * g0[0], v[1] * rstd * g0[1]); o.y = cvt_pk_bf16(v[2] * rstd * g0[2], v[3] * rstd * g0[3]);
        o.z = cvt_pk_bf16(v[4] * rstd * g1[0], v[5] * rstd * g1[1]); o.w = cvt_pk_bf16(v[6] * rstd * g1[2], v[7] * rstd * g1[3]);
        *pp = o;
        if (!GLA_SPLIT) continue;
        u32x4* gp = (u32x4*)(P + (size_t)row * LDP + PC_GR + lane * 8); const u32x4 yw = *(const u32x4*)(P + (size_t)row * LDP + PC_GV + lane * 8), rw = *gp;
        float y[8] = {bflo(yw.x), bfhi(yw.x), bflo(yw.y), bfhi(yw.y), bflo(yw.z), bfhi(yw.z), bflo(yw.w), bfhi(yw.w)};
        float rg[8] = {bflo(rw.x), bfhi(rw.x), bflo(rw.y), bfhi(rw.y), bflo(rw.z), bfhi(rw.z), bflo(rw.w), bfhi(rw.w)};
        float s2 = 0.f;
#pragma unroll
        for (int j = 0; j < 8; ++j) s2 += y[j] * y[j];
        s2 = red16(s2); const float rs2 = rsqrtf(s2 * (1.0f / 128.0f) + 1e-6f);
        float og[8];
#pragma unroll
        for (int j = 0; j < 8; ++j) og[j] = y[j] * rs2 * (j < 4 ? gg0[j] : gg1[j - 4]) * siluf_(rg[j]);
        u32x4 o2; o2.x = cvt_pk_bf16(og[0], og[1]); o2.y = cvt_pk_bf16(og[2], og[3]); o2.z = cvt_pk_bf16(og[4], og[5]); o2.w = cvt_pk_bf16(og[6], og[7]);
        *gp = o2;
    }
}


__device__ __forceinline__ void b1_fixup(const Params& p, int L, const bf16_t* stp, const float* sts) {
    int zo = 0; asm volatile("" : "+s"(zo));
    int tid_ = threadIdx.x; asm volatile("" : "+v"(tid_));
    bf16_t* P = (bf16_t*)(p.ws + OFF_P); float* SM = (float*)(p.ws + OFF_SM); bf16_t* VF = (bf16_t*)(p.ws + OFF_VF);
    const float* mu = p.in[zo + I_RMU] + L * 1696;
    for (int idx = blockIdx.x * 512 + tid_; idx < 512 * 1792; idx += gridDim.x * 512) {
        const int g = idx / 1792, c = idx % 1792; const size_t R = (size_t)g * 64; const bool first = (R % SEQ) == 0;
        if (c < 1536) { const float cur = bf2f(P[R * LDP + PC_RR + c]), prev = first ? 0.f : bf2f(stp[(size_t)(g - 1) * 1536 + c]);
            const bf16_t o = f2bf(cur + (prev - cur) * mu[c]); P[R * LDP + PC_RR + c] = o; if (L == 0 && c >= 1024) VF[R * 512 + c - 1024] = o; }
        else { const int sc = c - 1536; const float m = (sc >= 64 && sc < 224) ? mu[1536 + sc - 64] : 0.f;
            const float cur = SM[R * 256 + sc], prev = first ? 0.f : sts[(size_t)(g - 1) * 256 + sc]; SM[R * 256 + sc] = cur + (prev - cur) * m; }
    }
}

#define XB_TMO      128
#define XB_XCNT(j)  (256  + 64 * (j))
#define XB_XSUB(j)  (1280 + 64 * (j))
#define XB_XGEN(j)  (2304 + 64 * (j))
#define XB_TOP      3328
#define XB_TOPGEN   3392
#define XCD_BAR_WORDS 3456
#define XB_SPIN_CAP (1u << 22)
__device__ __forceinline__ unsigned xb_ld(unsigned* p)              { return __hip_atomic_load(p, __ATOMIC_RELAXED, __HIP_MEMORY_SCOPE_AGENT); }
__device__ __forceinline__ unsigned xb_add(unsigned* p, unsigned v) { return __hip_atomic_fetch_add(p, v, __ATOMIC_RELAXED, __HIP_MEMORY_SCOPE_AGENT); }
__device__ __forceinline__ unsigned xb_xcc_id() { return (unsigned)__builtin_amdgcn_s_getreg((3 << 11) | 20) & 0xFu; }
#define XB_SPIN(cond, bar) do { unsigned _sp = 0; while (cond) { __builtin_amdgcn_s_sleep(1); \
    if ((++_sp & 255u) == 0u) { if (xb_ld(&(bar)[XB_TMO])) break; if (_sp > XB_SPIN_CAP) { atomicAdd(&(bar)[XB_TMO], 1u); break; } } } } while (0)
struct XcdBarrier { unsigned* bar; unsigned x; volatile LAS unsigned* st; };
__device__ __forceinline__ XcdBarrier xcd_barrier_post(unsigned* bar, volatile LAS unsigned* st) {
    XcdBarrier b; b.bar = bar; b.x = xb_xcc_id(); b.st = st;
    if (threadIdx.x == 0) (void)xb_add(&bar[XB_XCNT(b.x)], 1u);
    return b;
}
__device__ __forceinline__ void xcd_barrier_complete(unsigned* bar, unsigned x, unsigned& nloc, unsigned& nx) {
    const unsigned G = gridDim.x * gridDim.y * gridDim.z;
    unsigned sum, cnt, mine, sp = 0u;
    for (;;) {
        sum = 0u; cnt = 0u; mine = 0u;
#pragma unroll
        for (unsigned j = 0; j < 16; ++j) { const unsigned c = xb_ld(&bar[XB_XCNT(j)]); sum += c; cnt += (c > 0u) ? 1u : 0u; mine = (j == x) ? c : mine; }
        if (sum == G) break;
        __builtin_amdgcn_s_sleep(1);
        if ((++sp & 255u) == 0u) { if (xb_ld(&bar[XB_TMO])) break; if (sp > XB_SPIN_CAP) { atomicAdd(&bar[XB_TMO], 1u); break; } }
    }
    nloc = mine > 0u ? mine : 1u; nx = cnt > 0u ? cnt : 1u;
}
__device__ __attribute__((noinline)) void xcd_barrier(const XcdBarrier b) {
    asm volatile("s_waitcnt vmcnt(0)" ::: "memory");
    __syncthreads();
    if (threadIdx.x == 0) {
        unsigned* bar = b.bar;
        __builtin_amdgcn_s_waitcnt(0);
        unsigned nloc = b.st[0], nx = b.st[1];
        if (nloc == 0u) { xcd_barrier_complete(bar, b.x, nloc, nx); b.st[0] = nloc; b.st[1] = nx; }
        const unsigned old = xb_add(&bar[XB_XSUB(b.x)], 1u);
        const unsigned gen = old / nloc;
        if (old + 1u == (gen + 1u) * nloc) {
            __builtin_amdgcn_fence(__ATOMIC_RELEASE, "agent");
            asm volatile("s_waitcnt vmcnt(0)" ::: "memory");
            const unsigned og = xb_add(&bar[XB_TOP], 1u);
            const unsigned tg = og / nx;
            if (og + 1u == (tg + 1u) * nx) xb_add(&bar[XB_TOPGEN], 1u);
            else XB_SPIN(xb_ld(&bar[XB_TOPGEN]) == tg, bar);
            __builtin_amdgcn_fence(__ATOMIC_ACQUIRE, "agent");
            xb_add(&bar[XB_XGEN(b.x)], 1u);
            asm volatile("s_waitcnt vmcnt(0)" ::: "memory");
        } else {
            XB_SPIN(xb_ld(&bar[XB_XGEN(b.x)]) == gen, bar);
            __builtin_amdgcn_fence(__ATOMIC_ACQUIRE, "agent");
            asm volatile("s_waitcnt vmcnt(0)" ::: "memory");
        }
    }
    __syncthreads();
}

__device__ __attribute__((noinline)) void sub_barrier(unsigned* word, unsigned n) {
    asm volatile("s_waitcnt vmcnt(0)" ::: "memory");
    __syncthreads();
    if (threadIdx.x == 0) {
        __builtin_amdgcn_fence(__ATOMIC_RELEASE, "agent");
        asm volatile("s_waitcnt vmcnt(0)" ::: "memory");
        (void)xb_add(word, 1u);
        unsigned sp = 0;
        while (xb_ld(word) < n) { __builtin_amdgcn_s_sleep(2); if (++sp > (1u << 24)) break; }
        __builtin_amdgcn_fence(__ATOMIC_ACQUIRE, "agent");
        asm volatile("s_waitcnt vmcnt(0)" ::: "memory");
    }
    __syncthreads();
}

__global__ __launch_bounds__(512) void mega(Params p) {
    extern __shared__ __attribute__((aligned(16))) unsigned char smem[];
    cg::grid_group grid = cg::this_grid();
    LAS unsigned char* lds = (LAS unsigned char*)smem; LAS float* lf = (LAS float*)smem;
    unsigned char* ws = p.ws;
    int zo = 0; asm volatile("" : "+s"(zo));
    bf16_t* H = (bf16_t*)(ws + OFF_H); bf16_t* P = (bf16_t*)(ws + OFF_P); float* SM = (float*)(ws + OFF_SM); bf16_t* VF = (bf16_t*)(ws + OFF_VF);
    const bf16_t* zrow = (const bf16_t*)(ws + OFF_Z);
    volatile LAS unsigned* xst = (volatile LAS unsigned*)(lds + LDS_BYTES - 16);
    if (threadIdx.x == 0) { xst[0] = 0u; xst[1] = 0u; }
    __syncthreads();
    const XcdBarrier xb = xcd_barrier_post((unsigned*)(ws + OFF_BAR), xst);
    float* X = p.out;
    bf16_t* ACT = P; float* FO = (float*)(ws + OFF_P + 176 * MiB);
    const int G = (int)gridDim.x, bid = (int)blockIdx.x;
    unsigned* subw = (unsigned*)(ws + OFF_BAR) + 3584;
    if (blockIdx.x == 0) for (int i = threadIdx.x; i < 1024; i += 512) ((unsigned*)(ws + OFF_Z))[i] = 0u;
    convert_weights(p, 0, lf, 0, 1408, G, bid);
    resnorm<0>(p.in[zo + I_X], nullptr, 0, nullptr, nullptr, p.in[zo + I_NG] + 0, H);
    grid.sync();
    for (int L = 0; L < 2; ++L) {
        asm volatile("" : "+s"(zo));
        const float* ng = p.in[zo + I_NG] + (size_t)L * 4 * DM;
        const float* xin = (L == 0) ? p.in[zo + I_X] : X;
        { Epi<EPI_B1> e{}; e.o16 = P; e.o32 = SM; e.vf = (L == 0) ? VF : nullptr; e.mu = p.in[zo + I_RMU] + L * 1696; e.stp = (bf16_t*)(ws + WB_R + 7 * MiB / 2); e.sts = (float*)(ws + WB_R + 5 * MiB);
          gemm_phase<Epi<EPI_B1>, false>(lds, H, DM, (const bf16_t*)(ws + WB_R), T, 1792, 1024, e, zrow, G, bid); }
        xcd_barrier(xb);
        b1_fixup(p, L, (const bf16_t*)(ws + WB_R + 7 * MiB / 2), (const float*)(ws + WB_R + 5 * MiB));
        xcd_barrier(xb);
        {
            const int NR = 64, NO = G - NR;
            if (bid < NR) {
                for (int item = bid; item < 64; item += NR) rwkv_item_old(p, L, item, lds, false);
            } else {
                const int oc = bid - NR;
                { Epi<EPI_B2> e{}; e.o16 = P; gemm_phase<Epi<EPI_B2>, false>(lds, H, DM, (const bf16_t*)(ws + WB_2), T, 3840, 1024, e, zrow, NO, oc); }
                sub_barrier(subw + (L * 2 + 0) * 64, (unsigned)NO);
                for (int item = oc; item < 192; item += NO) {
                    if (item < 64) gla_item(p, L, item, lf, false);
                    else if (item < 128) plain_item<1>(p, L, item - 64, lf, false);
                    else lru_item(p, L, item - 128, lf, false);
                }
                sub_barrier(subw + (L * 2 + 1) * 64, (unsigned)NO);
                ssd_post(p, L, NO, oc);
                convert_weights(p, L, lf, 1408, 5312, NO, oc);
                if (L == 0) convert_weights(p, 1, lf, 0, 1408, NO, oc);
            }
        }
        xcd_barrier(xb);
        bf16_t* U = (L == 0) ? (bf16_t*)p.out : (bf16_t*)(ws + OFF_SM);
        for (int q = 0; q < 4; ++q) {
            { Epi<EPI_U> e{}; e.o16 = U; gemm_phase<Epi<EPI_U>, false>(lds, P + (size_t)q * 8192 * LDP, LDP, (const bf16_t*)(ws + WB_B), 8192, 4096, 512, e, zrow, G, bid); }
            xcd_barrier(xb);
            { Epi<EPI_MERGE> e{}; e.o16 = P + (size_t)q * 8192 * LDP; e.uq = U; gemm_phase<Epi<EPI_MERGE>, false>(lds, H + (size_t)q * 8192 * DM, DM, (const bf16_t*)(ws + WB_G), 8192, 4096, 1024, e, zrow, G, bid); }
            xcd_barrier(xb);
        }
        { Epi<EPI_O> e{}; e.o16 = P; gemm_phase<Epi<EPI_O>, false>(lds, P + PC_MERGED, LDP, (const bf16_t*)(ws + WB_O), T, 1024, 1024, e, zrow, G, bid); }
        xcd_barrier(xb);
        resnorm<1>(xin, P + PC_O, LDP, ng + DM, X, ng + 2 * DM, H);
        xcd_barrier(xb);
        { Epi<EPI_FFN> e{}; e.o16 = ACT; gemm_phase<Epi<EPI_FFN>, false>(lds, H, DM, (const bf16_t*)(ws + WB_F), T, 5632, 1024, e, zrow, G, bid); }
        xcd_barrier(xb);
        { Epi<EPI_DOWN> e{}; e.o16 = (bf16_t*)FO; gemm_phase<Epi<EPI_DOWN>, false>(lds, ACT, FH, (const bf16_t*)(ws + WB_D), T, 1024, FH, e, zrow, G, bid); }
        xcd_barrier(xb);
        if (L == 0) {
            resnorm<1>(X, FO, DM, ng + 3 * DM, X, p.in[zo + I_NG] + 4 * DM, H);
            xcd_barrier(xb);
        } else {
            resnorm<1>(X, FO, DM, ng + 3 * DM, X, nullptr, nullptr);
        }
    }
}

extern "C" void kernel_launch(void* const* d_in, const int* in_sizes, int n_in, void* d_out, int out_size, void* d_ws, size_t ws_size, hipStream_t stream) {
    static int grid_blocks = 0;
    if (grid_blocks == 0) {
        if (n_in != N_INPUTS || out_size != T * DM || ws_size < WS_END) { fprintf(stderr, "kernel_launch: unexpected problem (n_in %d, out %d, ws %zu)\n", n_in, out_size, ws_size); grid_blocks = -1; return; }
        int dev = 0, cus = 0, per_cu = 0;
        (void)hipGetDevice(&dev); (void)hipDeviceGetAttribute(&cus, hipDeviceAttributeMultiprocessorCount, dev);
        if (hipFuncSetAttribute((const void*)mega, hipFuncAttributeMaxDynamicSharedMemorySize, LDS_BYTES) != hipSuccess) { fprintf(stderr, "kernel_launch: hipFuncSetAttribute failed\n"); grid_blocks = -1; return; }
        if (hipOccupancyMaxActiveBlocksPerMultiprocessor(&per_cu, (const void*)mega, 512, LDS_BYTES) != hipSuccess || per_cu < 1) { fprintf(stderr, "kernel_launch: occupancy query says %d\n", per_cu); per_cu = 1; }
        (void)hipGetLastError();
        grid_blocks = cus * 1;
        if (grid_blocks < 128) { fprintf(stderr, "kernel_launch: needs at least 128 CUs\n"); grid_blocks = -1; return; }
    }
    if (grid_blocks < 0) return;
    if (hipMemsetAsync((char*)d_ws + OFF_BAR, 0, 4096 * 4, stream) != hipSuccess) { fprintf(stderr, "kernel_launch: memset failed\n"); return; }
    Params p{};
    for (int i = 0; i < N_INPUTS; ++i) p.in[i] = (const float*)d_in[i];
    p.out = (float*)d_out; p.ws = (unsigned char*)d_ws;
    void* args[] = {&p};
    hipError_t e = hipLaunchCooperativeKernel((const void*)mega, dim3(grid_blocks), dim3(512), args, LDS_BYTES, stream);
    if (e != hipSuccess) fprintf(stderr, "cooperative launch failed: %s (grid %d)\n", hipGetErrorString(e), grid_blocks);
}
```

```cpp
#include <hip/hip_runtime.h>
#include <hip/hip_cooperative_groups.h>
#include <cstdio>
namespace cg = cooperative_groups;

#define LAS __attribute__((address_space(3)))
typedef unsigned short bf16_t;
typedef short bf16x8 __attribute__((ext_vector_type(8)));
typedef float f32x4 __attribute__((ext_vector_type(4)));
typedef unsigned u32x4 __attribute__((ext_vector_type(4)));
typedef unsigned u32x2 __attribute__((ext_vector_type(2)));

constexpr int NB = 8, SEQ = 4096, T = NB * SEQ, DM = 1024, NIN = 9656, FH = 2816, LDP = 5376;
constexpr int BM = 256, BK = 64, HALF = 128, HTB = HALF * BK * 2, STAGE_BYTES = 8 * HTB, NXCD = 8, WGM = 8;
constexpr int LDS_BYTES = 144 * 1024;
constexpr bool DRY_SKIP_SCAN = false;
constexpr bool GLA_SPLIT = true;
constexpr int DRY_MASK = 15;
constexpr int REP_GEMM = 1, REP_SCAN = 0, REP_SYNC = 1, REP_CONV = 1, REP_NORM = 1;
constexpr size_t MiB = 1u << 20;
constexpr size_t WB_R = 0, WB_2 = 7 * MiB, WB_G = WB_2 + 15 * MiB / 2, WB_B = WB_G + 8 * MiB, WB_O = WB_B + 4 * MiB, WB_F = WB_O + 2 * MiB, WB_D = WB_F + 11 * MiB;
constexpr size_t OFF_Z = 45 * MiB, OFF_H = 46 * MiB, OFF_P = 110 * MiB, OFF_SM = 446 * MiB, OFF_VF = 478 * MiB, OFF_BAR = 510 * MiB, OFF_BON = 510 * MiB + 65536, WS_END = OFF_BON + MiB;
constexpr int PC_Z = 0, PC_XBC = 512, PC_GQ = 1280, PC_GK = 1536, PC_GV = 1792, PC_GR = 2304, PC_LX = 2816, PC_LG = 3328, PC_RR = 3840, PC_RK = 4352, PC_RV = 4864;
constexpr int PC_MERGED = 1280, PC_O = 4352;

enum { I_X = 0, I_NG, I_WIN, I_WVRES, I_SCW, I_SCB, I_SDTB, I_SALOG, I_SD, I_SNG, I_GAW, I_GAB, I_GNG, I_LCW, I_LCB, I_LWA, I_LBA, I_LWX, I_LBX, I_LLAM,
       I_RMU, I_RW0, I_RWW2, I_RA0, I_RAW2, I_RV0, I_RVW2, I_RGW2, I_RKK, I_RKA, I_RRK, I_RLNG, I_RLNB, I_WBR, I_WOUT, I_FG, I_FU, I_FD, N_INPUTS };

struct Params { const float* in[N_INPUTS]; float* out; unsigned char* ws; };

__device__ __forceinline__ unsigned cvt_pk_bf16(float lo, float hi) { unsigned r; asm volatile("v_cvt_pk_bf16_f32 %0, %1, %2" : "=v"(r) : "v"(lo), "v"(hi)); return r; }
__device__ __forceinline__ float bf2f(bf16_t v) { return __uint_as_float((unsigned)v << 16); }
__device__ __forceinline__ float bflo(unsigned v) { return __uint_as_float(v << 16); }
__device__ __forceinline__ float bfhi(unsigned v) { return __uint_as_float(v & 0xffff0000u); }
__device__ __forceinline__ bf16_t f2bf(float v) { return (bf16_t)(cvt_pk_bf16(v, 0.f) & 0xffffu); }
__device__ __forceinline__ float sigmoidf_(float x) { return __builtin_amdgcn_rcpf(1.0f + __expf(-x)); }
__device__ __forceinline__ float siluf_(float x) { return x * sigmoidf_(x); }
__device__ __forceinline__ float softplusf_(float x) { return fmaxf(x, 0.f) + log1pf(__expf(-fabsf(x))); }
template <int CTRL> __device__ __forceinline__ float dpp_add(float x) { int v = __builtin_amdgcn_update_dpp(0, __float_as_int(x), CTRL, 0xF, 0xF, true); return x + __int_as_float(v); }
__device__ __forceinline__ float red4(float x) { x = dpp_add<0xB1>(x); x = dpp_add<0x4E>(x); return x; }
__device__ __forceinline__ float red8(float x) { x = red4(x); x = dpp_add<0x141>(x); return x; }
__device__ __forceinline__ float red16(float x) { x = red8(x); x = dpp_add<0x140>(x); return x; }
__device__ __forceinline__ float red32(float x) { x = red16(x); x += __shfl_xor(x, 16); return x; }
__device__ __forceinline__ float red64(float x) { x = red32(x); x += __shfl_xor(x, 32); return x; }
template <int N> __device__ __forceinline__ void red64n(float (&v)[N]) {
#pragma unroll
    for (int i = 0; i < N; ++i) v[i] = red16(v[i]);
    float t[N];
#pragma unroll
    for (int i = 0; i < N; ++i) t[i] = __shfl_xor(v[i], 16);
#pragma unroll
    for (int i = 0; i < N; ++i) v[i] += t[i];
#pragma unroll
    for (int i = 0; i < N; ++i) t[i] = __shfl_xor(v[i], 32);
#pragma unroll
    for (int i = 0; i < N; ++i) v[i] += t[i];
}

__device__ __forceinline__ int lds_byte(int r, int c) { const int st = (r >> 4) * 2 + (c >> 5), rr = r & 15, cc = c & 31, ob = rr * 64 + cc * 2; return st * 1024 + (ob ^ (((ob >> 9) & 1) << 5)); }
__device__ __forceinline__ void stage_rc(int b, int& R, int& C) { const int st = b / 1024, sb = b % 1024, swz = sb ^ (((sb >> 9) & 1) << 5); R = (st >> 1) * 16 + swz / 64; C = (st & 1) * 32 + (swz % 64) / 2; }
__device__ __forceinline__ int perm32(int rho) { const int n = rho >> 4, i = rho & 15; return 8 * (i >> 2) + 4 * n + (i & 3); }
struct Unit { int pm, pn; };
struct Order {
    int nM, nN, nwg, G, c;
    __device__ void init(int M, int N, int G_, int c_) { nM = M / BM; nN = N / BM; nwg = nM * nN; G = G_; c = c_; }
    __device__ bool next(int i, Unit& u) const {
        const long L = (long)i * G + c; if (L >= nwg) return false;
        int wgid = (int)L; { const int q = nwg / NXCD, r = nwg % NXCD, xcd = wgid % NXCD, off = wgid / NXCD; wgid = (xcd < r ? xcd * (q + 1) : r * (q + 1) + (xcd - r) * q) + off; }
        const int nig = WGM * nN, gid = wgid / nig, fm = gid * WGM, gsz = (nM - fm) < WGM ? (nM - fm) : WGM;
        u.pm = fm + ((wgid % nig) % gsz); u.pn = (wgid % nig) / gsz; return true;
    }
};

enum { EPI_B2 = 0, EPI_B1, EPI_U, EPI_MERGE, EPI_O, EPI_FFN, EPI_DOWN };
template <int MODE> struct Epi {
    static constexpr bool PERM = (MODE != EPI_MERGE);
    bf16_t* o16; float* o32; const bf16_t* uq; bf16_t* vf; const float* mu; bf16_t* stp; float* sts;
    __device__ __forceinline__ int a_col(int pn) const { if (MODE == EPI_U) { const int k = pn >> 2; return k == 0 ? PC_Z : (k == 1 ? PC_GR : (k == 2 ? PC_LG : PC_RR)); } return 0; }
    __device__ __forceinline__ void operator()(const f32x4 (&acc)[2][2][4][2], const Unit& u, int wr, int wc, int fr, int fq) const {
        const int row0 = u.pm * BM + wr * 64 + fr;
        if constexpr (MODE == EPI_B1) {
            const bool small = (u.pn == 6);
#pragma unroll
            for (int bj = 0; bj < 2; ++bj) {
                const int cb = u.pn * BM + bj * HALF + wc * 32 + 8 * fq;
                float mu8[8];
#pragma unroll
                for (int e = 0; e < 8; ++e) { const int sc = cb + e - 1536; mu8[e] = !small ? mu[cb + e] : ((sc >= 64 && sc < 224) ? mu[1536 + sc - 64] : 0.f); }
#pragma unroll
                for (int ai = 0; ai < 2; ++ai)
#pragma unroll
                    for (int m = 0; m < 4; ++m) { const size_t r = (size_t)(row0 + ai * HALF + m * 16); float o[8], raw[8];
#pragma unroll
                        for (int e = 0; e < 8; ++e) { const float cur = acc[ai][bj][m][e >> 2][e & 3]; raw[e] = cur;
                            const float p1 = __int_as_float(__builtin_amdgcn_update_dpp(0, __float_as_int(cur), 0x111, 0xF, 0xF, true));
                            float p0 = 0.f; if (m > 0) p0 = __int_as_float(__builtin_amdgcn_update_dpp(0, __float_as_int(acc[ai][bj][m > 0 ? m - 1 : 0][e >> 2][e & 3]), 0x121, 0xF, 0xF, true));
                            const float prev = (fr == 0) ? p0 : p1, lerp = cur + (prev - cur) * mu8[e];
                            o[e] = (fr == 0 && m == 0) ? cur : lerp; }
                        if (small) { float* rp = o32 + r * 256 + (cb - 1536); *(f32x4*)rp = (f32x4){o[0], o[1], o[2], o[3]}; *(f32x4*)(rp + 4) = (f32x4){o[4], o[5], o[6], o[7]}; }
                        else { u32x4 w; w.x = cvt_pk_bf16(o[0], o[1]); w.y = cvt_pk_bf16(o[2], o[3]); w.z = cvt_pk_bf16(o[4], o[5]); w.w = cvt_pk_bf16(o[6], o[7]);
                            *(u32x4*)(o16 + r * LDP + PC_RR + cb) = w; if (vf != nullptr && u.pn >= 4) *(u32x4*)(vf + r * 512 + (cb - 1024)) = w; }
                        if (m == 3 && fr == 15) { const size_t g = r >> 6;
                            if (small) { float* sp = sts + g * 256 + (cb - 1536); *(f32x4*)sp = (f32x4){raw[0], raw[1], raw[2], raw[3]}; *(f32x4*)(sp + 4) = (f32x4){raw[4], raw[5], raw[6], raw[7]}; }
                            else { u32x4 w; w.x = cvt_pk_bf16(raw[0], raw[1]); w.y = cvt_pk_bf16(raw[2], raw[3]); w.z = cvt_pk_bf16(raw[4], raw[5]); w.w = cvt_pk_bf16(raw[6], raw[7]); *(u32x4*)(stp + g * 1536 + cb) = w; } } }
            }
        } else if constexpr (MODE == EPI_B2 || MODE == EPI_O || MODE == EPI_U || MODE == EPI_DOWN) {
            const int ct = wc * 32 + 8 * fq;
            if (MODE == EPI_B1 && u.pn == 6) {
#pragma unroll
                for (int ai = 0; ai < 2; ++ai)
#pragma unroll
                    for (int m = 0; m < 4; ++m) { float* rowp = o32 + (size_t)(row0 + ai * HALF + m * 16) * 256 + ct;
#pragma unroll
                        for (int bj = 0; bj < 2; ++bj) { *(f32x4*)(rowp + bj * HALF) = acc[ai][bj][m][0]; *(f32x4*)(rowp + bj * HALF + 4) = acc[ai][bj][m][1]; } }
                return;
            }
            const int ld = (MODE == EPI_U) ? 4096 : (MODE == EPI_DOWN ? DM : LDP);
            const int colbase = (MODE == EPI_B2) ? 0 : (MODE == EPI_B1 ? PC_RR : (MODE == EPI_O ? PC_O : 0));
            const int col0 = colbase + u.pn * BM + ct;
            const bool dovf = (MODE == EPI_B1) && vf != nullptr && u.pn >= 4;
#pragma unroll
            for (int ai = 0; ai < 2; ++ai)
#pragma unroll
                for (int m = 0; m < 4; ++m) { const size_t r = (size_t)(row0 + ai * HALF + m * 16); bf16_t* rowp = o16 + r * ld + col0;
#pragma unroll
                    for (int bj = 0; bj < 2; ++bj) { const f32x4 v0 = acc[ai][bj][m][0], v1 = acc[ai][bj][m][1];
                        u32x4 w; w.x = cvt_pk_bf16(v0[0], v0[1]); w.y = cvt_pk_bf16(v0[2], v0[3]); w.z = cvt_pk_bf16(v1[0], v1[1]); w.w = cvt_pk_bf16(v1[2], v1[3]);
                        *(u32x4*)(rowp + bj * HALF) = w;
                        if (MODE == EPI_B1) { if (dovf) *(u32x4*)(vf + r * 512 + (u.pn - 4) * BM + ct + bj * HALF) = w; } } }
        } else if constexpr (MODE == EPI_FFN) {
            const int hc0 = u.pn * HALF + wc * 32 + 8 * fq;
#pragma unroll
            for (int ai = 0; ai < 2; ++ai)
#pragma unroll
                for (int m = 0; m < 4; ++m) { bf16_t* rowp = o16 + (size_t)(row0 + ai * HALF + m * 16) * FH + hc0; float a[8];
#pragma unroll
                    for (int n = 0; n < 2; ++n)
#pragma unroll
                        for (int j = 0; j < 4; ++j) a[n * 4 + j] = siluf_(acc[ai][0][m][n][j]) * acc[ai][1][m][n][j];
                    u32x4 w; w.x = cvt_pk_bf16(a[0], a[1]); w.y = cvt_pk_bf16(a[2], a[3]); w.z = cvt_pk_bf16(a[4], a[5]); w.w = cvt_pk_bf16(a[6], a[7]);
                    *(u32x4*)rowp = w; }
        } else {
            const int d0 = u.pn * 64 + wc * 16 + 4 * fq;
#pragma unroll
            for (int ai = 0; ai < 2; ++ai)
#pragma unroll
                for (int m = 0; m < 4; ++m) { const size_t r = (size_t)(row0 + ai * HALF + m * 16); const bf16_t* up = uq + r * 4096 + d0; float s[4] = {0.f, 0.f, 0.f, 0.f};
#pragma unroll
                    for (int bj = 0; bj < 2; ++bj)
#pragma unroll
                        for (int n = 0; n < 2; ++n) { const u32x2 uu = *(const u32x2*)(up + (2 * bj + n) * 1024); const f32x4 g = acc[ai][bj][m][n];
                            s[0] += sigmoidf_(g[0]) * bflo(uu.x); s[1] += sigmoidf_(g[1]) * bfhi(uu.x); s[2] += sigmoidf_(g[2]) * bflo(uu.y); s[3] += sigmoidf_(g[3]) * bfhi(uu.y); }
                    u32x2 w; w.x = cvt_pk_bf16(s[0], s[1]); w.y = cvt_pk_bf16(s[2], s[3]);
                    *(u32x2*)(o16 + r * LDP + PC_MERGED + d0) = w; }
        }
    }
};

template <class EpiT, bool SHIFT>
__device__ __forceinline__ void gemm_phase(LAS unsigned char* lds, const bf16_t* A, int lda, const bf16_t* Bt, int M, int N, int K, const EpiT& E, const bf16_t* zrow, int ordG, int ordC) {
    int tid_ = threadIdx.x; asm volatile("" : "+v"(tid_));
    const int tid = tid_, wid = __builtin_amdgcn_readfirstlane(tid >> 6), lane = tid & 63, wr = wid >> 2, wc = wid & 3, fr = lane & 15, fq = lane >> 4;
    const int nt = K / BK;
    Order S; S.init(M, N, ordG, ordC);
    unsigned voffA[2], voffB[2]; bool z0[2];
#pragma unroll
    for (int i = 0; i < 2; ++i) { int R, C; stage_rc(tid * 16 + i * 8192, R, C); const int Rb = EpiT::PERM ? ((R & ~31) + perm32(R & 31)) : R;
        voffA[i] = (unsigned)(R * lda + C) * 2u; voffB[i] = (unsigned)(Rb * K + C) * 2u; z0[i] = (R == 0); }
    const size_t kstep = (size_t)(BK * 2);
    const size_t hstepA = (size_t)HALF * lda * 2, tstepA = 2 * hstepA, hstepB = (size_t)HALF * K * 2, tstepB = 2 * hstepB;
    const size_t shiftsub = (size_t)lda * 2 + (size_t)K;
    const unsigned ldsw = (unsigned)wid * 1024u;
    const int aoff = lds_byte(wr * 64 + fr, fq * 8), boff = lds_byte(wc * 32 + fr, fq * 8);
#define PG8_SA(b, h) (((b) * 2 + (h)) * HTB)
#define PG8_SB(b, h) ((4 + (b) * 2 + (h)) * HTB)
#define PG8_STAGEB(bufoff, gbase) do { _Pragma("unroll") for (int _i = 0; _i < 2; ++_i) \
        __builtin_amdgcn_global_load_lds((const unsigned*)((const char*)(gbase) + voffB[_i]), (LAS unsigned*)(lds + (bufoff) + ldsw + _i * 8192), 16, 0, 0); } while (0)
#define PG8_STAGEA(bufoff, gbase, zf) do { _Pragma("unroll") for (int _i = 0; _i < 2; ++_i) { const char* _p = (const char*)(gbase) + voffA[_i]; \
        if (SHIFT) { if ((zf) && z0[_i]) _p = (const char*)zrow + lane * 16; } \
        __builtin_amdgcn_global_load_lds((const unsigned*)_p, (LAS unsigned*)(lds + (bufoff) + ldsw + _i * 8192), 16, 0, 0); } } while (0)
#define PG8_LDA(dst, b, h) do { _Pragma("unroll") for (int m = 0; m < 4; ++m) _Pragma("unroll") for (int k = 0; k < 2; ++k) dst[m][k] = *(const LAS bf16x8*)(lds + PG8_SA(b, h) + aoff + m * 2048 + k * 1024); } while (0)
#define PG8_LDB(dst, b, h) do { _Pragma("unroll") for (int n = 0; n < 2; ++n) _Pragma("unroll") for (int k = 0; k < 2; ++k) dst[n][k] = *(const LAS bf16x8*)(lds + PG8_SB(b, h) + boff + n * 2048 + k * 1024); } while (0)
#define PG8_MMA(ai, bj, At, Bt_) do { __builtin_amdgcn_s_setprio(1); _Pragma("unroll") for (int m = 0; m < 4; ++m) _Pragma("unroll") for (int n = 0; n < 2; ++n) _Pragma("unroll") for (int k = 0; k < 2; ++k) \
        acc[ai][bj][m][n] = __builtin_amdgcn_mfma_f32_16x16x32_bf16(Bt_[n][k], At[m][k], acc[ai][bj][m][n], 0, 0, 0); __builtin_amdgcn_s_setprio(0); } while (0)
#define PG8_WAIT_V(n) asm volatile("s_waitcnt vmcnt(" #n ")" ::: "memory")
#define PG8_WAIT_L(n) asm volatile("s_waitcnt lgkmcnt(" #n ")" ::: "memory")
#define PG8_BAR __builtin_amdgcn_s_barrier()
#define PG8_SCHED __builtin_amdgcn_sched_barrier(0)
#define PG8_AOFF(tau) ((size_t)(tau) * kstep - ((SHIFT && (tau) >= nt / 2) ? shiftsub : (size_t)0))
    Unit cur, nxt; int ui = 0;
    if (!S.next(0, cur)) return;
    f32x4 acc[2][2][4][2];
#pragma unroll
    for (int a = 0; a < 2; ++a)
#pragma unroll
        for (int b = 0; b < 2; ++b)
#pragma unroll
            for (int m = 0; m < 4; ++m)
#pragma unroll
                for (int n = 0; n < 2; ++n) acc[a][b][m][n] = (f32x4){0.f, 0.f, 0.f, 0.f};
    bf16x8 At[4][2], B0[2][2], B1[2][2];
    const char* cA = (const char*)(A + E.a_col(cur.pn)) + (size_t)cur.pm * tstepA; const char* cB = (const char*)Bt + (size_t)cur.pn * tstepB;
    PG8_STAGEB(PG8_SB(0, 0), cB); PG8_STAGEA(PG8_SA(0, 0), cA, false); PG8_STAGEB(PG8_SB(0, 1), cB + hstepB); PG8_STAGEA(PG8_SA(0, 1), cA + hstepA, false);
    if (wr == 1) PG8_BAR;
    PG8_WAIT_V(4); PG8_BAR;
    PG8_STAGEB(PG8_SB(1, 0), cB + kstep); PG8_STAGEA(PG8_SA(1, 0), cA + kstep, false); PG8_STAGEB(PG8_SB(1, 1), cB + hstepB + kstep);
    PG8_WAIT_V(6); PG8_BAR;
    for (;;) {
        const bool has_next = S.next(ui + 1, nxt);
        const char* nA = has_next ? (const char*)(A + E.a_col(nxt.pn)) + (size_t)nxt.pm * tstepA : cA; const char* nB = has_next ? (const char*)Bt + (size_t)nxt.pn * tstepB : cB;
        const bool seq0 = SHIFT && ((cur.pm & 15) == 0);
        for (int t = 0; t < nt; t += 2) {
            const bool last = (t == nt - 2);
            const char* a1 = cA + PG8_AOFF(t + 1);
            const char* a2 = last ? nA : cA + PG8_AOFF(t + 2); const char* b2 = last ? nB : cB + (size_t)(t + 2) * kstep;
            const char* a3 = a2 + kstep; const char* b3 = b2 + kstep;
            const bool zf = seq0 && !last && (t + 2 >= nt / 2);
            PG8_LDB(B0, 0, 0); PG8_SCHED; PG8_LDA(At, 0, 0); PG8_STAGEA(PG8_SA(1, 1), a1 + hstepA, false);
            PG8_WAIT_L(8); PG8_BAR; PG8_WAIT_L(0); PG8_MMA(0, 0, At, B0); PG8_BAR; PG8_SCHED;
            PG8_LDB(B1, 0, 1); PG8_STAGEB(PG8_SB(0, 0), b2);
            PG8_BAR; PG8_WAIT_L(0); PG8_MMA(0, 1, At, B1); PG8_BAR;
            PG8_LDA(At, 0, 1); PG8_STAGEA(PG8_SA(0, 0), a2, zf);
            PG8_BAR; PG8_WAIT_L(0); PG8_MMA(1, 0, At, B0); PG8_BAR; PG8_SCHED;
            PG8_STAGEB(PG8_SB(0, 1), b2 + hstepB);
            PG8_WAIT_V(6); PG8_BAR; PG8_MMA(1, 1, At, B1); PG8_BAR;
            PG8_LDB(B0, 1, 0); PG8_SCHED; PG8_LDA(At, 1, 0); PG8_STAGEA(PG8_SA(0, 1), a2 + hstepA, false);
            PG8_WAIT_L(8); PG8_BAR; PG8_WAIT_L(0); PG8_MMA(0, 0, At, B0); PG8_BAR; PG8_SCHED;
            PG8_LDB(B1, 1, 1); PG8_STAGEB(PG8_SB(1, 0), b3);
            PG8_BAR; PG8_WAIT_L(0); PG8_MMA(0, 1, At, B1); PG8_BAR;
            PG8_LDA(At, 1, 1); PG8_STAGEA(PG8_SA(1, 0), a3, zf);
            PG8_BAR; PG8_WAIT_L(0); PG8_MMA(1, 0, At, B0); PG8_BAR; PG8_SCHED;
            PG8_STAGEB(PG8_SB(1, 1), b3 + hstepB);
            PG8_WAIT_V(6); PG8_BAR; PG8_MMA(1, 1, At, B1); PG8_BAR;
        }
        E(acc, cur, wr, wc, fr, fq);
        if (!has_next) break;
#pragma unroll
        for (int a = 0; a < 2; ++a)
#pragma unroll
            for (int b = 0; b < 2; ++b)
#pragma unroll
                for (int m = 0; m < 4; ++m)
#pragma unroll
                    for (int n = 0; n < 2; ++n) acc[a][b][m][n] = (f32x4){0.f, 0.f, 0.f, 0.f};
        cur = nxt; cA = nA; cB = nB; ++ui;
    }
    PG8_WAIT_V(0);
    if (wr == 0) PG8_BAR;
    PG8_BAR;
#undef PG8_SA
#undef PG8_SB
#undef PG8_STAGEA
#undef PG8_STAGEB
#undef PG8_LDA
#undef PG8_LDB
#undef PG8_MMA
#undef PG8_WAIT_V
#undef PG8_WAIT_L
#undef PG8_BAR
#undef PG8_SCHED
#undef PG8_AOFF
}

__device__ __forceinline__ float wval(const Params& p, int zo, int L, int spec, int n, int k) {
    const float* win = p.in[zo + I_WIN] + (size_t)L * DM * NIN;
    if (spec == 0) {
        if (n < 1536) return win[(size_t)k * NIN + 3864 + n];
        const int s = n - 1536;
        if (s < 8) return win[(size_t)k * NIN + 1280 + s];
        if (s < 24) return win[(size_t)k * NIN + 2824 + (s - 8)];
        if (s < 56) return (L == 0) ? 0.f : p.in[zo + I_WVRES][((size_t)(L - 1) * DM + k) * 32 + (s - 24)];
        if (s < 64) return 0.f;
        if (s < 224) return win[(size_t)k * NIN + 5400 + (s - 64)];
        return 0.f;
    } else if (spec == 1) {
        const int col = n < 1280 ? n : (n < 2816 ? n + 8 : n + 24); return win[(size_t)k * NIN + col];
    } else if (spec == 2) {
        const int pn = n >> 8, ct = n & 255, bj = ct >> 7, wc = (ct >> 5) & 3, nn = (ct >> 4) & 1, r16 = ct & 15;
        return win[(size_t)k * NIN + 5560 + (2 * bj + nn) * 1024 + pn * 64 + wc * 16 + r16];
    } else if (spec == 3) {
        const int kb = n >> 10, d = n & 1023; return p.in[zo + I_WBR][(((size_t)L * 4 + kb) * 512 + k) * 1024 + d];
    } else if (spec == 4) {
        return p.in[zo + I_WOUT][((size_t)L * 1024 + k) * 1024 + n];
    } else if (spec == 5) {
        const int pn = n >> 8, ct = n & 255;
        return ct < 128 ? p.in[zo + I_FG][((size_t)L * 1024 + k) * FH + pn * 128 + ct] : p.in[zo + I_FU][((size_t)L * 1024 + k) * FH + pn * 128 + ct - 128];
    } else {
        return p.in[zo + I_FD][((size_t)L * FH + k) * 1024 + n];
    }
}
__device__ void convert_weights(const Params& p, int L, LAS float* lf, int tile0, int tile1, int ordG, int ordC) {
    int zo = 0; asm volatile("" : "+s"(zo));
    int tid_ = threadIdx.x; asm volatile("" : "+v"(tid_));
    const int tid = tid_;
    for (int tile = tile0 + ordC; tile < tile1; tile += ordG) {
        int spec, tl = tile, ktiles; size_t dofs; int K;
        if (tl < 448) { spec = 0; ktiles = 16; dofs = WB_R; K = 1024; }
        else if ((tl -= 448) < 960) { spec = 1; ktiles = 16; dofs = WB_2; K = 1024; }
        else if ((tl -= 960) < 1024) { spec = 2; ktiles = 16; dofs = WB_G; K = 1024; }
        else if ((tl -= 1024) < 512) { spec = 3; ktiles = 8; dofs = WB_B; K = 512; }
        else if ((tl -= 512) < 256) { spec = 4; ktiles = 16; dofs = WB_O; K = 1024; }
        else if ((tl -= 256) < 1408) { spec = 5; ktiles = 16; dofs = WB_F; K = 1024; }
        else { tl -= 1408; spec = 6; ktiles = 44; dofs = WB_D; K = FH; }
        const int n0 = (tl / ktiles) * 64, k0 = (tl % ktiles) * 64;
        bf16_t* dst = (bf16_t*)(p.ws + dofs);
#pragma unroll
        for (int i = 0; i < 8; ++i) { const int idx = tid + i * 512, kk = idx >> 6, nn = idx & 63; lf[kk * 65 + nn] = wval(p, zo, L, spec, n0 + nn, k0 + kk); }
        __syncthreads();
#pragma unroll
        for (int i = 0; i < 4; ++i) { const int idx = tid + i * 512, nn = idx >> 5, k2 = (idx & 31) * 2;
            *(unsigned*)(dst + (size_t)(n0 + nn) * K + k0 + k2) = cvt_pk_bf16(lf[k2 * 65 + nn], lf[(k2 + 1) * 65 + nn]); }
        __syncthreads();
    }
}

template <int DT>
__device__ void resnorm(const float* xin, const void* delta, int ldd, const float* gd, float* xout, const float* gn, bf16_t* H) {
    int tid_ = threadIdx.x; asm volatile("" : "+v"(tid_));
    const int wid = tid_ >> 6, lane = tid_ & 63;
    const int stride = gridDim.x * 8;
    int row = blockIdx.x * 8 + wid;
    f32x4 gdv[4], gnv[4];
#pragma unroll
    for (int j = 0; j < 4; ++j) { gdv[j] = (DT != 0) ? *(const f32x4*)(gd + (j * 64 + lane) * 4) : (f32x4){0.f, 0.f, 0.f, 0.f}; gnv[j] = gn ? *(const f32x4*)(gn + (j * 64 + lane) * 4) : (f32x4){0.f, 0.f, 0.f, 0.f}; }
    f32x4 nx[4], nd[4]; u32x2 nb[4];
#define RN_LOAD(r_) do { _Pragma("unroll") for (int j = 0; j < 4; ++j) { nx[j] = *(const f32x4*)(xin + (size_t)(r_) * DM + (j * 64 + lane) * 4); \
        if (DT == 1) nb[j] = *(const u32x2*)((const bf16_t*)delta + (size_t)(r_) * ldd + (j * 64 + lane) * 4); \
        if (DT == 2) nd[j] = *(const f32x4*)((const float*)delta + (size_t)(r_) * ldd + (j * 64 + lane) * 4); } } while (0)
    if (row < T) RN_LOAD(row);
    while (row < T) {
        f32x4 xv[4], dv[4];
#pragma unroll
        for (int j = 0; j < 4; ++j) { xv[j] = nx[j]; if (DT == 1) dv[j] = (f32x4){bflo(nb[j].x), bfhi(nb[j].x), bflo(nb[j].y), bfhi(nb[j].y)}; if (DT == 2) dv[j] = nd[j]; }
        const int nrow = row + stride;
        if (nrow < T) RN_LOAD(nrow);
        if (DT != 0) {
            float ss = 0.f;
#pragma unroll
            for (int j = 0; j < 4; ++j) ss += dv[j][0] * dv[j][0] + dv[j][1] * dv[j][1] + dv[j][2] * dv[j][2] + dv[j][3] * dv[j][3];
            ss = red64(ss); const float rstd = rsqrtf(ss * (1.0f / DM) + 1e-6f);
#pragma unroll
            for (int j = 0; j < 4; ++j) xv[j] += dv[j] * rstd * gdv[j];
        }
        if (xout) {
#pragma unroll
            for (int j = 0; j < 4; ++j) *(f32x4*)(xout + (size_t)row * DM + (j * 64 + lane) * 4) = xv[j];
        }
        if (gn) {
            float ss = 0.f;
#pragma unroll
            for (int j = 0; j < 4; ++j) ss += xv[j][0] * xv[j][0] + xv[j][1] * xv[j][1] + xv[j][2] * xv[j][2] + xv[j][3] * xv[j][3];
            ss = red64(ss); const float rstd = rsqrtf(ss * (1.0f / DM) + 1e-6f);
#pragma unroll
            for (int j = 0; j < 4; ++j) { const f32x4 h = xv[j] * rstd * gnv[j];
                u32x2 w; w.x = cvt_pk_bf16(h[0], h[1]); w.y = cvt_pk_bf16(h[2], h[3]); *(u32x2*)(H + (size_t)row * DM + (j * 64 + lane) * 4) = w; }
        }
        row = nrow;
    }
#undef RN_LOAD
}

constexpr int TC = 32;
typedef float f32x2 __attribute__((ext_vector_type(2)));
template <int NE, bool RW> struct StepOps { f32x4 w[NE / 4], k[NE / 4], r[NE / 4], a[RW ? NE / 4 : 1], b[RW ? NE / 4 : 1]; float v; };
template <int NE, bool RW>
__device__ __forceinline__ void step_load(StepOps<NE, RW>& o, const LAS float* base, const LAS float* opV, int vo) {
#pragma unroll
    for (int e = 0; e < NE / 4; ++e) { o.w[e] = *(const LAS f32x4*)(base + 4 * e); o.k[e] = *(const LAS f32x4*)(base + 2048 + 4 * e); o.r[e] = *(const LAS f32x4*)(base + 4096 + 4 * e);
        if (RW) { o.a[e] = *(const LAS f32x4*)(base + 6144 + 4 * e); o.b[e] = *(const LAS f32x4*)(base + 8192 + 4 * e); } }
    o.v = opV[vo];
}
#define LO2(q) ((f32x2){(q)[0], (q)[1]})
#define HI2(q) ((f32x2){(q)[2], (q)[3]})
template <int LPR, bool RW>
__device__ __forceinline__ float step_compute(f32x2 (&s)[32 / LPR], const StepOps<64 / LPR, RW>& o) {
    constexpr int NE = 64 / LPR;
    f32x2 tk[NE / 2];
    const f32x2 v2 = (f32x2){o.v, o.v};
#pragma unroll
    for (int e = 0; e < NE / 4; ++e) { tk[2 * e] = LO2(o.k[e]) * v2; tk[2 * e + 1] = HI2(o.k[e]) * v2; }
    if (RW) {
        f32x2 sa2 = (f32x2){0.f, 0.f}, sb2 = (f32x2){0.f, 0.f};
#pragma unroll
        for (int e = 0; e < NE / 4; ++e) { sa2 += s[2 * e] * LO2(o.a[e]); sb2 += s[2 * e + 1] * HI2(o.a[e]); }
        sa2 += sb2; float sa = sa2[0] + sa2[1]; sa = (LPR == 8) ? red8(sa) : red4(sa);
        const f32x2 sv = (f32x2){sa, sa};
#pragma unroll
        for (int e = 0; e < NE / 4; ++e) { tk[2 * e] += LO2(o.b[e]) * sv; tk[2 * e + 1] += HI2(o.b[e]) * sv; }
    }
    f32x2 y2 = (f32x2){0.f, 0.f}, z2 = (f32x2){0.f, 0.f};
#pragma unroll
    for (int e = 0; e < NE / 4; ++e) { s[2 * e] = s[2 * e] * LO2(o.w[e]) + tk[2 * e]; s[2 * e + 1] = s[2 * e + 1] * HI2(o.w[e]) + tk[2 * e + 1];
        y2 += s[2 * e] * LO2(o.r[e]); z2 += s[2 * e + 1] * HI2(o.r[e]); }
    y2 += z2; float y = y2[0] + y2[1]; y = (LPR == 8) ? red8(y) : red4(y);
    return y;
}
template <int LPR, bool RW>
__device__ __forceinline__ void scan_chunk(f32x2 (&s)[32 / LPR], const LAS float* opW, const LAS float* opK, const LAS float* opR, const LAS float* opA, const LAS float* opB,
                                           const LAS float* opV, LAS float* Y, int vstride, int row, int sub) {
    constexpr int NE = 64 / LPR;
    StepOps<NE, RW> o0, o1;
    unsigned bt = (unsigned)(size_t)(opW + sub * NE), bv = (unsigned)(size_t)(opV + row), by = (unsigned)(size_t)(Y + row);
    step_load<NE, RW>(o0, (const LAS float*)(size_t)bt, (const LAS float*)(size_t)bv, 0);
#pragma unroll 1
    for (int t = 0; t < TC; t += 8) {
        asm volatile("" : "+v"(bt), "+v"(bv), "+v"(by));
        const LAS float* b0 = (const LAS float*)(size_t)bt; const LAS float* v0 = (const LAS float*)(size_t)bv; LAS float* yp = (LAS float*)(size_t)by;
#pragma unroll
        for (int q = 0; q < 4; ++q) {
            step_load<NE, RW>(o1, b0 + (2 * q + 1) * 64, v0, (2 * q + 1) * vstride);
            const float ya = step_compute<LPR, RW>(s, o0);
            step_load<NE, RW>(o0, b0 + (2 * q + 2) * 64, v0, (2 * q + 2) * vstride);
            const float yb = step_compute<LPR, RW>(s, o1);
            yp[(2 * q) * vstride] = ya; yp[(2 * q + 1) * vstride] = yb;
        }
        bt += 2048; bv += 32 * vstride; by += 32 * vstride;
    }
}

__device__ void rwkv_item_old(const Params& p, int L, int item, LAS unsigned char* lds, bool dry) {
    int zo = 0; asm volatile("" : "+s"(zo));
    int tid_ = threadIdx.x; asm volatile("" : "+v"(tid_));
    const int b = item >> 3, h = item & 7, tid = tid_, wv = tid >> 6, lane = tid & 63, c = lane, hc = h * 64 + c;
    LAS bf16_t* WT = (LAS bf16_t*)lds;
    LAS bf16_t* LOSB = WT + 64 * 200;
    LAS float* AW = (LAS float*)(lds + 38400); LAS float* AA = AW + 2048; LAS float* AV = AA + 2048; LAS float* G = AV + 2048;
    LAS float* opW = G + 2048; LAS float* opK = opW + 2048; LAS float* opR = opK + 2048; LAS float* opA = opR + 2048; LAS float* opB = opA + 2048;
    LAS float* opV = opB + 2048; LAS float* Y = opV + 2048; LAS float* BON = Y + 2048; LAS float* G1 = BON + 32;
    bf16_t* P = (bf16_t*)(p.ws + OFF_P); const float* SM = (const float*)(p.ws + OFF_SM); const bf16_t* VF = (const bf16_t*)(p.ws + OFF_VF);
    __syncthreads();
    for (int i = tid; i < 192 * 64; i += 512) { const int j = i >> 6, cc = i & 63; float v;
        if (j < 32) v = p.in[zo + I_RWW2][((size_t)L * 32 + j) * 512 + h * 64 + cc];
        else if (j < 64) v = p.in[zo + I_RAW2][((size_t)L * 32 + (j - 32)) * 512 + h * 64 + cc];
        else if (j < 96) v = (L > 0) ? p.in[zo + I_RVW2][((size_t)(L - 1) * 32 + (j - 64)) * 512 + h * 64 + cc] : 0.f;
        else v = p.in[zo + I_RGW2][((size_t)L * 96 + (j - 96)) * 512 + h * 64 + cc];
        WT[cc * 200 + j] = f2bf(v); }
    const float w0 = p.in[zo + I_RW0][L * 512 + hc], a0 = p.in[zo + I_RA0][L * 512 + hc], v0 = (L > 0) ? p.in[zo + I_RV0][(L - 1) * 512 + hc] : 0.f;
    const float k_k = p.in[zo + I_RKK][L * 512 + hc], k_a = p.in[zo + I_RKA][L * 512 + hc], r_k = p.in[zo + I_RRK][L * 512 + hc], ln_g = p.in[zo + I_RLNG][L * 512 + hc], ln_b = p.in[zo + I_RLNB][L * 512 + hc];
    f32x2 s[4];
#pragma unroll
    for (int e = 0; e < 4; ++e) s[e] = (f32x2){0.f, 0.f};
    const int row = wv * 8 + (lane >> 3), sub = lane & 7;
    int smo[12];
#pragma unroll
    for (int i = 0; i < 12; ++i) { const int idx = tid + i * 512, t = idx / 192, j = idx % 192; smo[i] = t * 256 + (j < 64 ? 64 + j : (j < 96 ? j - 40 : j + 32)); }
    float nsm[12]; bf16_t nr[4], nk[4], nv[4], nf[4];
#define RWKV_LOAD_SM(chn) do { const size_t Rn = (size_t)b * SEQ + (size_t)(chn) * TC; \
        _Pragma("unroll") for (int i = 0; i < 12; ++i) nsm[i] = SM[Rn * 256 + smo[i]]; } while (0)
#define RWKV_LOAD(chn) do { const size_t Rn = (size_t)b * SEQ + (size_t)(chn) * TC; \
        _Pragma("unroll") for (int i = 0; i < 4; ++i) { const size_t R = Rn + wv * 4 + i; nr[i] = P[R * LDP + PC_RR + hc]; nk[i] = P[R * LDP + PC_RK + hc]; nv[i] = P[R * LDP + PC_RV + hc]; nf[i] = (L > 0) ? VF[R * 512 + hc] : (bf16_t)0; } } while (0)
#define RWKV_P0() do { _Pragma("unroll") for (int i = 0; i < 12; ++i) { const int idx = tid + i * 512, t = idx / 192, j = idx % 192; \
            const float v = nsm[i], e = __expf(j < 32 ? 2.0f * v : -v), rr = __builtin_amdgcn_rcpf(1.0f + e);     \
            LOSB[t * 200 + j] = f2bf(j < 32 ? 1.0f - 2.0f * rr : (j >= 96 ? rr : v)); } } while (0)
    RWKV_LOAD_SM(0); RWKV_P0(); RWKV_LOAD_SM(1); RWKV_LOAD(0);
    __syncthreads();
    for (int ch = 0; ch < SEQ / TC; ++ch) {
        const size_t R0 = (size_t)b * SEQ + (size_t)ch * TC;
        LAS float* Gc = (ch & 1) ? G1 : G;
        { const int mt = wv & 1, nt = wv >> 1; const int ao = (mt * 16 + (lane & 15)) * 200 + 8 * (lane >> 4), bo = (nt * 16 + (lane & 15)) * 200 + 8 * (lane >> 4);
            bf16x8 af[6], bfr[6];
#pragma unroll
            for (int ks = 0; ks < 6; ++ks) { af[ks] = *(const LAS bf16x8*)(LOSB + ao + ks * 32); bfr[ks] = *(const LAS bf16x8*)(WT + bo + ks * 32); }
            const f32x4 z4 = (f32x4){0.f, 0.f, 0.f, 0.f};
            const f32x4 cw = __builtin_amdgcn_mfma_f32_16x16x32_bf16(af[0], bfr[0], z4, 0, 0, 0);
            const f32x4 ca = __builtin_amdgcn_mfma_f32_16x16x32_bf16(af[1], bfr[1], z4, 0, 0, 0);
            const f32x4 cvv = __builtin_amdgcn_mfma_f32_16x16x32_bf16(af[2], bfr[2], z4, 0, 0, 0);
            f32x4 cg = __builtin_amdgcn_mfma_f32_16x16x32_bf16(af[3], bfr[3], z4, 0, 0, 0);
            cg = __builtin_amdgcn_mfma_f32_16x16x32_bf16(af[4], bfr[4], cg, 0, 0, 0);
            cg = __builtin_amdgcn_mfma_f32_16x16x32_bf16(af[5], bfr[5], cg, 0, 0, 0);
#pragma unroll
            for (int rg = 0; rg < 4; ++rg) { const int o = (mt * 16 + (lane >> 4) * 4 + rg) * 64 + nt * 16 + (lane & 15); AW[o] = cw[rg]; AA[o] = ca[rg]; AV[o] = cvv[rg]; Gc[o] = cg[rg]; } }
        __syncthreads();
        { float kkr[4], km[4], av_[4], vv[4], rr_[4], red[8];
#pragma unroll
            for (int i = 0; i < 4; ++i) { const int t = wv * 4 + i;
                av_[i] = sigmoidf_(a0 + AA[t * 64 + c]);
                const float k_ = bf2f(nk[i]); rr_[i] = bf2f(nr[i]); vv[i] = bf2f(nv[i]);
                if (L > 0) { const float vf = bf2f(nf[i]); vv[i] = vv[i] + (vf - vv[i]) * sigmoidf_(v0 + AV[t * 64 + c]); }
                kkr[i] = k_ * k_k; km[i] = k_ * (1.0f + (av_[i] - 1.0f) * k_a);
                red[i] = kkr[i] * kkr[i]; red[4 + i] = rr_[i] * km[i] * r_k; }
            red64n<8>(red);
#pragma unroll
            for (int i = 0; i < 4; ++i) { const int t = wv * 4 + i;
                const float wdec = __expf(-0.60653066f * sigmoidf_(w0 + AW[t * 64 + c]));
                const float kk = kkr[i] * rsqrtf(fmaxf(red[i], 1e-24f));
                opW[t * 64 + c] = wdec; opK[t * 64 + c] = km[i]; opR[t * 64 + c] = rr_[i]; opA[t * 64 + c] = -kk; opB[t * 64 + c] = kk * av_[i]; opV[t * 64 + c] = vv[i];
                if (lane == 0) BON[t] = red[4 + i]; } }
        if (ch + 1 < SEQ / TC) { RWKV_P0(); RWKV_LOAD(ch + 1); if (ch + 2 < SEQ / TC) RWKV_LOAD_SM(ch + 2); }
        __syncthreads();
        if (!(dry && DRY_SKIP_SCAN)) scan_chunk<8, true>(s, opW, opK, opR, opA, opB, opV, Y, 64, row, sub);
        __syncthreads();
        { float y[4], m[4], q[4];
#pragma unroll
            for (int i = 0; i < 4; ++i) { y[i] = Y[(wv * 4 + i) * 64 + c]; m[i] = y[i]; }
            red64n<4>(m);
#pragma unroll
            for (int i = 0; i < 4; ++i) { y[i] -= m[i] * (1.0f / 64.0f); q[i] = y[i] * y[i]; }
            red64n<4>(q);
#pragma unroll
            for (int i = 0; i < 4; ++i) { const int t = wv * 4 + i; const size_t R = R0 + t;
                float yn = y[i] * rsqrtf(q[i] * (1.0f / 64.0f) + 64e-5f) * ln_g + ln_b; yn += BON[t] * opV[t * 64 + c];
                if (!dry) P[R * LDP + PC_RR + hc] = f2bf(yn * Gc[t * 64 + c]); } }
    }
#undef RWKV_LOAD_SM
#undef RWKV_P0
#undef RWKV_LOAD
}


__device__ void gla_item(const Params& p, int L, int item, LAS float* lf, bool dry) {
    int zo = 0; asm volatile("" : "+s"(zo));
    int tid_ = threadIdx.x; asm volatile("" : "+v"(tid_));
    const int tid = tid_, wv = tid >> 6, lane = tid & 63, c = lane;
    LAS float* opW = lf; LAS float* opK = opW + 2048; LAS float* opR = opK + 2048; LAS float* opV = opR + 2048; LAS float* Y = opV + 2048; LAS float* X0 = Y + 2048; LAS float* X1 = X0 + 512;
    bf16_t* P = (bf16_t*)(p.ws + OFF_P); const float* SM = (const float*)(p.ws + OFF_SM);
    const int half = item & 1, bh = item >> 1, b = bh >> 2, h = bh & 3, vcol = PC_GV + h * 128 + half * 64;
    __syncthreads();
    for (int i = tid; i < 16 * 64; i += 512) X1[i] = p.in[zo + I_GAW][((size_t)L * 16 + (i >> 6)) * 256 + h * 64 + (i & 63)];
    const float ab = p.in[zo + I_GAB][L * 256 + h * 64 + c];
    f32x2 s[4];
#pragma unroll
    for (int e = 0; e < 4; ++e) s[e] = (f32x2){0.f, 0.f};
    const int row = wv * 8 + (lane >> 3), sub = lane & 7;
    float nlo; bf16_t nvv[4], nk[4], nq[4];
#define GLA_LOAD(chn) do { const size_t Rn = (size_t)b * SEQ + (size_t)(chn) * TC; nlo = SM[(Rn + (tid >> 4)) * 256 + 8 + (tid & 15)]; \
        _Pragma("unroll") for (int i = 0; i < 4; ++i) { const int idx = tid + i * 512; nvv[i] = P[(Rn + (idx >> 6)) * LDP + vcol + (idx & 63)]; } \
        _Pragma("unroll") for (int i = 0; i < 4; ++i) { const size_t R = Rn + wv * 4 + i; nk[i] = P[R * LDP + PC_GK + h * 64 + c]; nq[i] = P[R * LDP + PC_GQ + h * 64 + c]; } } while (0)
    GLA_LOAD(0);
    for (int ch = 0; ch < SEQ / TC; ++ch) {
        const size_t R0 = (size_t)b * SEQ + (size_t)ch * TC;
        X0[tid] = nlo;
#pragma unroll
        for (int i = 0; i < 4; ++i) opV[tid + i * 512] = bf2f(nvv[i]);
        bf16_t ck[4], cq[4];
#pragma unroll
        for (int i = 0; i < 4; ++i) { ck[i] = nk[i]; cq[i] = nq[i]; }
        if (ch + 1 < SEQ / TC) GLA_LOAD(ch + 1);
        __syncthreads();
#pragma unroll
        for (int i = 0; i < 4; ++i) { const int t = wv * 4 + i; float la = ab;
#pragma unroll
            for (int j = 0; j < 16; ++j) la += X0[t * 16 + j] * X1[j * 64 + c];
            opW[t * 64 + c] = __expf(__logf(sigmoidf_(la)) * (1.0f / 16.0f));
            opK[t * 64 + c] = bf2f(ck[i]); opR[t * 64 + c] = bf2f(cq[i]) * 0.125f; }
        __syncthreads();
        scan_chunk<8, false>(s, opW, opK, opR, opW, opW, opV, Y, 64, row, sub);
        __syncthreads();
        if (!dry) {
#pragma unroll
            for (int i = 0; i < 4; ++i) { const int t = wv * 4 + i; P[(R0 + t) * LDP + vcol + c] = f2bf(Y[t * 64 + c]); }
        }
    }
#undef GLA_LOAD
}

template <int MODE>
__device__ void plain_item(const Params& p, int L, int item, LAS float* lf, bool dry) {
    int zo = 0; asm volatile("" : "+s"(zo));
    int tid_ = threadIdx.x; asm volatile("" : "+v"(tid_));
    const int tid = tid_, wv = tid >> 6, lane = tid & 63, c = lane;
    constexpr int VS = (MODE == 0) ? 128 : 64;
    LAS float* opW = lf; LAS float* opK = opW + 2048; LAS float* opR = opK + 2048; LAS float* opV = opR + 2048; LAS float* Y = opV + TC * VS; LAS float* X0 = Y + TC * VS; LAS float* X1 = X0 + 2048;
    bf16_t* P = (bf16_t*)(p.ws + OFF_P); const float* SM = (const float*)(p.ws + OFF_SM);
    __syncthreads();
    if (MODE == 0) {
        const int b = item >> 2, h = item & 3;
        for (int i = tid; i < 16 * 64; i += 512) X1[i] = p.in[zo + I_GAW][((size_t)L * 16 + (i >> 6)) * 256 + h * 64 + (i & 63)];
        const float ab = p.in[zo + I_GAB][L * 256 + h * 64 + c], gn0 = p.in[zo + I_GNG][L * 128 + lane], gn1 = p.in[zo + I_GNG][L * 128 + 64 + lane];
        f32x2 s[8];
#pragma unroll
        for (int e = 0; e < 8; ++e) s[e] = (f32x2){0.f, 0.f};
        const int row = wv * 16 + (lane >> 2), sub = lane & 3;
        float nlo; bf16_t nvv[8], nk[4], nq[4], ng0[4], ng1[4];
#define GLA_LOAD(chn) do { const size_t Rn = (size_t)b * SEQ + (size_t)(chn) * TC; nlo = SM[(Rn + (tid >> 4)) * 256 + 8 + (tid & 15)]; \
        _Pragma("unroll") for (int i = 0; i < 8; ++i) { const int idx = tid + i * 512; nvv[i] = P[(Rn + (idx >> 7)) * LDP + PC_GV + h * 128 + (idx & 127)]; } \
        _Pragma("unroll") for (int i = 0; i < 4; ++i) { const size_t R = Rn + wv * 4 + i; nk[i] = P[R * LDP + PC_GK + h * 64 + c]; nq[i] = P[R * LDP + PC_GQ + h * 64 + c]; \
            ng0[i] = P[R * LDP + PC_GR + h * 128 + lane]; ng1[i] = P[R * LDP + PC_GR + h * 128 + 64 + lane]; } } while (0)
        GLA_LOAD(0);
        for (int ch = 0; ch < SEQ / TC; ++ch) {
            const size_t R0 = (size_t)b * SEQ + (size_t)ch * TC;
            X0[tid] = nlo;
#pragma unroll
            for (int i = 0; i < 8; ++i) opV[tid + i * 512] = bf2f(nvv[i]);
            bf16_t ck[4], cq[4], cg0[4], cg1[4];
#pragma unroll
            for (int i = 0; i < 4; ++i) { ck[i] = nk[i]; cq[i] = nq[i]; cg0[i] = ng0[i]; cg1[i] = ng1[i]; }
            if (ch + 1 < SEQ / TC) GLA_LOAD(ch + 1);
            __syncthreads();
#pragma unroll
            for (int i = 0; i < 4; ++i) { const int t = wv * 4 + i; float la = ab;
#pragma unroll
                for (int j = 0; j < 16; ++j) la += X0[t * 16 + j] * X1[j * 64 + c];
                opW[t * 64 + c] = __expf(__logf(sigmoidf_(la)) * (1.0f / 16.0f));
                opK[t * 64 + c] = bf2f(ck[i]); opR[t * 64 + c] = bf2f(cq[i]) * 0.125f; }
            __syncthreads();
            scan_chunk<4, false>(s, opW, opK, opR, opW, opW, opV, Y, 128, row, sub);
            __syncthreads();
#pragma unroll
            for (int i = 0; i < 4; ++i) { const int t = wv * 4 + i; const size_t R = R0 + t;
                const float y0 = Y[t * 128 + lane], y1 = Y[t * 128 + 64 + lane], ss = red64(y0 * y0 + y1 * y1), rstd = rsqrtf(ss * (1.0f / 128.0f) + 1e-6f);
                bf16_t* rp = P + R * LDP + PC_GR + h * 128;
                const float r0 = bf2f(cg0[i]), r1 = bf2f(cg1[i]);
                if (!dry) { rp[lane] = f2bf(y0 * rstd * gn0 * siluf_(r0)); rp[64 + lane] = f2bf(y1 * rstd * gn1 * siluf_(r1)); } }
        }
#undef GLA_LOAD
    } else {
        const int b = item >> 3, hh = item & 7, g = hh >> 2;
        const int chx = hh * 64 + c, chb = 512 + g * 64 + c, chc = 640 + g * 64 + c;
        const float* cw = p.in[zo + I_SCW] + (size_t)L * 4 * 768; const float* cb = p.in[zo + I_SCB] + (size_t)L * 768;
        float cwx[4], cwb[4], cwc[4];
#pragma unroll
        for (int k = 0; k < 4; ++k) { cwx[k] = cw[k * 768 + chx]; cwb[k] = cw[k * 768 + chb]; cwc[k] = cw[k * 768 + chc]; }
        const float cbx = cb[chx], cbb = cb[chb], cbc = cb[chc];
        const float dtb = p.in[zo + I_SDTB][L * 8 + hh], Aneg = -__expf(p.in[zo + I_SALOG][L * 8 + hh]), Dsk = p.in[zo + I_SD][L * 8 + hh];
        f32x2 s[4];
#pragma unroll
        for (int e = 0; e < 4; ++e) s[e] = (f32x2){0.f, 0.f};
        const int row = wv * 8 + (lane >> 3), sub = lane & 7;
        const int t0 = wv * 4;
        bf16_t nx[7], nb[7], nc[7], nz[4]; float ndt[4];
#define SSD_LOAD(chn) do { const int sp0 = (chn) * TC + t0; \
        _Pragma("unroll") for (int q = 0; q < 7; ++q) { const int sp = sp0 - 3 + q; const size_t R = (size_t)b * SEQ + sp; \
            if (sp >= 0) { nx[q] = P[R * LDP + PC_XBC + chx]; nb[q] = P[R * LDP + PC_XBC + chb]; nc[q] = P[R * LDP + PC_XBC + chc]; } else { nx[q] = 0; nb[q] = 0; nc[q] = 0; } } \
        _Pragma("unroll") for (int i = 0; i < 4; ++i) { const size_t R = (size_t)b * SEQ + sp0 + i; nz[i] = P[R * LDP + PC_Z + chx]; ndt[i] = SM[R * 256 + hh]; } } while (0)
        SSD_LOAD(0);
        for (int ch = 0; ch < SEQ / TC; ++ch) {
            const size_t R0 = (size_t)b * SEQ + (size_t)ch * TC;
            float rx[7], rb[7], rc[7], cz[4], cdt[4];
#pragma unroll
            for (int q = 0; q < 7; ++q) { rx[q] = bf2f(nx[q]); rb[q] = bf2f(nb[q]); rc[q] = bf2f(nc[q]); }
#pragma unroll
            for (int i = 0; i < 4; ++i) { cz[i] = bf2f(nz[i]); cdt[i] = ndt[i]; }
            if (ch + 1 < SEQ / TC) SSD_LOAD(ch + 1);
#pragma unroll
            for (int i = 0; i < 4; ++i) { const int t = t0 + i;
                float x = cbx, bm = cbb, cm = cbc;
#pragma unroll
                for (int k = 0; k < 4; ++k) { x += cwx[k] * rx[i + k]; bm += cwb[k] * rb[i + k]; cm += cwc[k] * rc[i + k]; }
                x = siluf_(x); bm = siluf_(bm); cm = siluf_(cm);
                const float dt = softplusf_(cdt[i] + dtb);
                opW[t * 64 + c] = __expf(dt * Aneg); opK[t * 64 + c] = bm; opR[t * 64 + c] = cm; opV[t * 64 + c] = dt * x; X0[t * 64 + c] = x; }
            __syncthreads();
            scan_chunk<8, false>(s, opW, opK, opR, opW, opW, opV, Y, 64, row, sub);
            __syncthreads();
#pragma unroll
            for (int i = 0; i < 4; ++i) { const int t = t0 + i; const size_t R = R0 + t;
                const float y = Y[t * 64 + c] + Dsk * X0[t * 64 + c];
                if (!dry) P[R * LDP + PC_Z + chx] = f2bf(y * siluf_(cz[i])); }
            __syncthreads();
        }
#undef SSD_LOAD
    }
}

__device__ void lru_item(const Params& p, int L, int item, LAS float* lf, bool dry) {
    int zo = 0; asm volatile("" : "+s"(zo));
    int tid_ = threadIdx.x; asm volatile("" : "+v"(tid_));
    const int b = item >> 3, blk = item & 7, tid = tid_, wv = tid >> 6, lane = tid & 63, c = lane, cbi = blk * 64 + c;
    LAS float* wa = lf; LAS float* wx = wa + 4096; LAS float* XB = wx + 4096; LAS float* A_ = XB + 2048; LAS float* U_ = A_ + 2048; LAS float* HS = U_ + 2048;
    bf16_t* P = (bf16_t*)(p.ws + OFF_P);
    __syncthreads();
    for (int i = tid; i < 4096; i += 512) { wa[i] = p.in[zo + I_LWA][((size_t)L * 8 + blk) * 4096 + i]; wx[i] = p.in[zo + I_LWX][((size_t)L * 8 + blk) * 4096 + i]; }
    float cwv[4];
#pragma unroll
    for (int k = 0; k < 4; ++k) cwv[k] = p.in[zo + I_LCW][((size_t)L * 4 + k) * 512 + cbi];
    const float cbv = p.in[zo + I_LCB][L * 512 + cbi], ba = p.in[zo + I_LBA][L * 512 + cbi], bx = p.in[zo + I_LBX][L * 512 + cbi];
    const float spl = softplusf_(-p.in[zo + I_LLAM][L * 512 + cbi]);
    float hstate = 0.f;
    const int t0 = wv * 4;
    bf16_t nx[7], ngt[4];
#define LRU_LOAD(chn) do { const int sp0 = (chn) * TC + t0; \
        _Pragma("unroll") for (int q = 0; q < 7; ++q) { const int sp = sp0 - 3 + q; nx[q] = (sp >= 0) ? P[((size_t)b * SEQ + sp) * LDP + PC_LX + cbi] : (bf16_t)0; } \
        _Pragma("unroll") for (int i = 0; i < 4; ++i) ngt[i] = P[((size_t)b * SEQ + sp0 + i) * LDP + PC_LG + cbi]; } while (0)
    LRU_LOAD(0);
    for (int ch = 0; ch < SEQ / TC; ++ch) {
        const size_t R0 = (size_t)b * SEQ + (size_t)ch * TC;
        float rx[7], cg[4];
#pragma unroll
        for (int q = 0; q < 7; ++q) rx[q] = bf2f(nx[q]);
#pragma unroll
        for (int i = 0; i < 4; ++i) cg[i] = bf2f(ngt[i]);
        if (ch + 1 < SEQ / TC) LRU_LOAD(ch + 1);
        float xb[4];
#pragma unroll
        for (int i = 0; i < 4; ++i) { float x = cbv;
#pragma unroll
            for (int k = 0; k < 4; ++k) x += cwv[k] * rx[i + k];
            xb[i] = x; XB[(t0 + i) * 64 + c] = x; }
        __syncthreads();
        float ar[4] = {ba, ba, ba, ba}, ai[4] = {bx, bx, bx, bx};
#pragma unroll 4
        for (int j4 = 0; j4 < 16; ++j4) {
            float wra[4], wrx[4];
#pragma unroll
            for (int e = 0; e < 4; ++e) { wra[e] = wa[(j4 * 4 + e) * 64 + c]; wrx[e] = wx[(j4 * 4 + e) * 64 + c]; }
#pragma unroll
            for (int i = 0; i < 4; ++i) { const f32x4 x4 = *(const LAS f32x4*)(XB + (t0 + i) * 64 + j4 * 4);
                ar[i] += x4[0] * wra[0] + x4[1] * wra[1] + x4[2] * wra[2] + x4[3] * wra[3]; ai[i] += x4[0] * wrx[0] + x4[1] * wrx[1] + x4[2] * wrx[2] + x4[3] * wrx[3]; }
        }
#pragma unroll
        for (int i = 0; i < 4; ++i) { const float r = sigmoidf_(ar[i]), ig = sigmoidf_(ai[i]), la = -8.0f * r * spl, a = __expf(la);
            const float u = sqrtf(fmaxf(1.0f - a * a, 0.f)) * (ig * xb[i]);
            A_[(t0 + i) * 64 + c] = a; U_[(t0 + i) * 64 + c] = u; }
        __syncthreads();
        if (wv == 0) {
#pragma unroll 8
            for (int t = 0; t < TC; ++t) { hstate = A_[t * 64 + c] * hstate + U_[t * 64 + c]; HS[t * 64 + c] = hstate; }
        }
        __syncthreads();
#pragma unroll
        for (int i = 0; i < 4; ++i) { const size_t R = R0 + t0 + i; const float g = cg[i];
            const float u2 = 1.5957691216f * (g + 0.044715f * g * g * g);
            if (!dry) P[R * LDP + PC_LG + cbi] = f2bf(HS[(t0 + i) * 64 + c] * g * sigmoidf_(u2)); }
    }
#undef LRU_LOAD
}

__device__ void ssd_post(const Params& p, int L, int ordG, int ordC) {
    int zo = 0; asm volatile("" : "+s"(zo));
    int tid_ = threadIdx.x; asm volatile("" : "+v"(tid_));
    const int wid = tid_ >> 6, lane = tid_ & 63;
    bf16_t* P = (bf16_t*)(p.ws + OFF_P);
    const f32x4 g0 = *(const f32x4*)(p.in[zo + I_SNG] + L * 512 + lane * 8), g1 = *(const f32x4*)(p.in[zo + I_SNG] + L * 512 + lane * 8 + 4);
    const f32x4 gg0 = *(const f32x4*)(p.in[zo + I_GNG] + L * 128 + (lane & 15) * 8), gg1 = *(const f32x4*)(p.in[zo + I_GNG] + L * 128 + (lane & 15) * 8 + 4);
    for (int row = ordC * 8 + wid; row < T; row += ordG * 8) {
        u32x4* pp = (u32x4*)(P + (size_t)row * LDP + PC_Z + lane * 8); const u32x4 w = *pp;
        float v[8] = {bflo(w.x), bfhi(w.x), bflo(w.y), bfhi(w.y), bflo(w.z), bfhi(w.z), bflo(w.w), bfhi(w.w)};
        float ss = 0.f;
#pragma unroll
        for (int j = 0; j < 8; ++j) ss += v[j] * v[j];
        ss = red32(ss); const float rstd = rsqrtf(ss * (1.0f / 256.0f) + 1e-6f);
        u32x4 o; o.x = cvt_pk_bf16(v[0] * rstd * g0[0], v[1] * rstd * g0[1]); o.y = cvt_pk_bf16(v[2] * rstd * g0[2], v[3] * rstd * g0[3]);
        o.z = cvt_pk_bf16(v[4] * rstd * g1[0], v[5] * rstd * g1[1]); o.w = cvt_pk_bf16(v[6] * rstd * g1[2], v[7] * rstd * g1[3]);
        *pp = o;
        if (!GLA_SPLIT) continue;
        u32x4* gp = (u32x4*)(P + (size_t)row * LDP + PC_GR + lane * 8); const u32x4 yw = *(const u32x4*)(P + (size_t)row * LDP + PC_GV + lane * 8), rw = *gp;
        float y[8] = {bflo(yw.x), bfhi(yw.x), bflo(yw.y), bfhi(yw.y), bflo(yw.z), bfhi(yw.z), bflo(yw.w), bfhi(yw.w)};
        float rg[8] = {bflo(rw.x), bfhi(rw.x), bflo(rw.y), bfhi(rw.y), bflo(rw.z), bfhi(rw.z), bflo(rw.w), bfhi(rw.w)};
        float s2 = 0.f;
#pragma unroll
        for (int j = 0; j < 8; ++j) s2 += y[j] * y[j];
        s2 = red16(s2); const float rs2 = rsqrtf(s2 * (1.0f / 128.0f) + 1e-6f);
        float og[8];
#pragma unroll
        for (int j = 0; j < 8; ++j) og[j] = y[j] * rs2 * (j < 4 ? gg0[j] : gg1[j - 4]) * siluf_(rg[j]);
        u32x4 o2; o2.x = cvt_pk_bf16(og[0], og[1]); o2.y = cvt_pk_bf16(og[2], og[3]); o2.z = cvt_pk_bf16(og[4], og[5]); o2.w = cvt_pk_bf16(og[6], og[7]);
        *gp = o2;
    }
}


__device__ __forceinline__ void b1_fixup(const Params& p, int L, const bf16_t* stp, const float* sts) {
    int zo = 0; asm volatile("" : "+s"(zo));
    int tid_ = threadIdx.x; asm volatile("" : "+v"(tid_));
    bf16_t* P = (bf16_t*)(p.ws + OFF_P); float* SM = (float*)(p.ws + OFF_SM); bf16_t* VF = (bf16_t*)(p.ws + OFF_VF);
    const float* mu = p.in[zo + I_RMU] + L * 1696;
    for (int idx = blockIdx.x * 512 + tid_; idx < 512 * 1792; idx += gridDim.x * 512) {
        const int g = idx / 1792, c = idx % 1792; const size_t R = (size_t)g * 64; const bool first = (R % SEQ) == 0;
        if (c < 1536) { const float cur = bf2f(P[R * LDP + PC_RR + c]), prev = first ? 0.f : bf2f(stp[(size_t)(g - 1) * 1536 + c]);
            const bf16_t o = f2bf(cur + (prev - cur) * mu[c]); P[R * LDP + PC_RR + c] = o; if (L == 0 && c >= 1024) VF[R * 512 + c - 1024] = o; }
        else { const int sc = c - 1536; const float m = (sc >= 64 && sc < 224) ? mu[1536 + sc - 64] : 0.f;
            const float cur = SM[R * 256 + sc], prev = first ? 0.f : sts[(size_t)(g - 1) * 256 + sc]; SM[R * 256 + sc] = cur + (prev - cur) * m; }
    }
}

#define XB_TMO      128
#define XB_XCNT(j)  (256  + 64 * (j))
#define XB_XSUB(j)  (1280 + 64 * (j))
#define XB_XGEN(j)  (2304 + 64 * (j))
#define XB_TOP      3328
#define XB_TOPGEN   3392
#define XCD_BAR_WORDS 3456
#define XB_SPIN_CAP (1u << 22)
__device__ __forceinline__ unsigned xb_ld(unsigned* p)              { return __hip_atomic_load(p, __ATOMIC_RELAXED, __HIP_MEMORY_SCOPE_AGENT); }
__device__ __forceinline__ unsigned xb_add(unsigned* p, unsigned v) { return __hip_atomic_fetch_add(p, v, __ATOMIC_RELAXED, __HIP_MEMORY_SCOPE_AGENT); }
__device__ __forceinline__ unsigned xb_xcc_id() { return (unsigned)__builtin_amdgcn_s_getreg((3 << 11) | 20) & 0xFu; }
#define XB_SPIN(cond, bar) do { unsigned _sp = 0; while (cond) { __builtin_amdgcn_s_sleep(1); \
    if ((++_sp & 255u) == 0u) { if (xb_ld(&(bar)[XB_TMO])) break; if (_sp > XB_SPIN_CAP) { atomicAdd(&(bar)[XB_TMO], 1u); break; } } } } while (0)
struct XcdBarrier { unsigned* bar; unsigned x; volatile LAS unsigned* st; };
__device__ __forceinline__ XcdBarrier xcd_barrier_post(unsigned* bar, volatile LAS unsigned* st) {
    XcdBarrier b; b.bar = bar; b.x = xb_xcc_id(); b.st = st;
    if (threadIdx.x == 0) (void)xb_add(&bar[XB_XCNT(b.x)], 1u);
    return b;
}
__device__ __forceinline__ void xcd_barrier_complete(unsigned* bar, unsigned x, unsigned& nloc, unsigned& nx) {
    const unsigned G = gridDim.x * gridDim.y * gridDim.z;
    unsigned sum, cnt, mine, sp = 0u;
    for (;;) {
        sum = 0u; cnt = 0u; mine = 0u;
#pragma unroll
        for (unsigned j = 0; j < 16; ++j) { const unsigned c = xb_ld(&bar[XB_XCNT(j)]); sum += c; cnt += (c > 0u) ? 1u : 0u; mine = (j == x) ? c : mine; }
        if (sum == G) break;
        __builtin_amdgcn_s_sleep(1);
        if ((++sp & 255u) == 0u) { if (xb_ld(&bar[XB_TMO])) break; if (sp > XB_SPIN_CAP) { atomicAdd(&bar[XB_TMO], 1u); break; } }
    }
    nloc = mine > 0u ? mine : 1u; nx = cnt > 0u ? cnt : 1u;
}
__device__ __attribute__((noinline)) void xcd_barrier(const XcdBarrier b) {
    asm volatile("s_waitcnt vmcnt(0)" ::: "memory");
    __syncthreads();
    if (threadIdx.x == 0) {
        unsigned* bar = b.bar;
        __builtin_amdgcn_s_waitcnt(0);
        unsigned nloc = b.st[0], nx = b.st[1];
        if (nloc == 0u) { xcd_barrier_complete(bar, b.x, nloc, nx); b.st[0] = nloc; b.st[1] = nx; }
        const unsigned old = xb_add(&bar[XB_XSUB(b.x)], 1u);
        const unsigned gen = old / nloc;
        if (old + 1u == (gen + 1u) * nloc) {
            __builtin_amdgcn_fence(__ATOMIC_RELEASE, "agent");
            asm volatile("s_waitcnt vmcnt(0)" ::: "memory");
            const unsigned og = xb_add(&bar[XB_TOP], 1u);
            const unsigned tg = og / nx;
            if (og + 1u == (tg + 1u) * nx) xb_add(&bar[XB_TOPGEN], 1u);
            else XB_SPIN(xb_ld(&bar[XB_TOPGEN]) == tg, bar);
            __builtin_amdgcn_fence(__ATOMIC_ACQUIRE, "agent");
            xb_add(&bar[XB_XGEN(b.x)], 1u);
            asm volatile("s_waitcnt vmcnt(0)" ::: "memory");
        } else {
            XB_SPIN(xb_ld(&bar[XB_XGEN(b.x)]) == gen, bar);
            __builtin_amdgcn_fence(__ATOMIC_ACQUIRE, "agent");
            asm volatile("s_waitcnt vmcnt(0)" ::: "memory");
        }
    }
    __syncthreads();
}

__device__ __attribute__((noinline)) void sub_barrier(unsigned* word, unsigned n) {
    asm volatile("s_waitcnt vmcnt(0)" ::: "memory");
    __syncthreads();
    if (threadIdx.x == 0) {
        __builtin_amdgcn_fence(__ATOMIC_RELEASE, "agent");
        asm volatile("s_waitcnt vmcnt(0)" ::: "memory");
        (void)xb_add(word, 1u);
        unsigned sp = 0;
        while (xb_ld(word) < n) { __builtin_amdgcn_s_sleep(2); if (++sp > (1u << 24)) break; }
        __builtin_amdgcn_fence(__ATOMIC_ACQUIRE, "agent");
        asm volatile("s_waitcnt vmcnt(0)" ::: "memory");
    }
    __syncthreads();
}

__global__ __launch_bounds__(512) void mega(Params p) {
    extern __shared__ __attribute__((aligned(16))) unsigned char smem[];
    cg::grid_group grid = cg::this_grid();
    LAS unsigned char* lds = (LAS unsigned char*)smem; LAS float* lf = (LAS float*)smem;
    unsigned char* ws = p.ws;
    int zo = 0; asm volatile("" : "+s"(zo));
    bf16_t* H = (bf16_t*)(ws + OFF_H); bf16_t* P = (bf16_t*)(ws + OFF_P); float* SM = (float*)(ws + OFF_SM); bf16_t* VF = (bf16_t*)(ws + OFF_VF);
    const bf16_t* zrow = (const bf16_t*)(ws + OFF_Z);
    volatile LAS unsigned* xst = (volatile LAS unsigned*)(lds + LDS_BYTES - 16);
    if (threadIdx.x == 0) { xst[0] = 0u; xst[1] = 0u; }
    __syncthreads();
    const XcdBarrier xb = xcd_barrier_post((unsigned*)(ws + OFF_BAR), xst);
    float* X = p.out;
    bf16_t* ACT = P; float* FO = (float*)(ws + OFF_P + 176 * MiB);
    const int G = (int)gridDim.x, bid = (int)blockIdx.x;
    unsigned* subw = (unsigned*)(ws + OFF_BAR) + 3584;
    if (blockIdx.x == 0) for (int i = threadIdx.x; i < 1024; i += 512) ((unsigned*)(ws + OFF_Z))[i] = 0u;
    convert_weights(p, 0, lf, 0, 1408, G, bid);
    resnorm<0>(p.in[zo + I_X], nullptr, 0, nullptr, nullptr, p.in[zo + I_NG] + 0, H);
    grid.sync();
    for (int L = 0; L < 2; ++L) {
        asm volatile("" : "+s"(zo));
        const float* ng = p.in[zo + I_NG] + (size_t)L * 4 * DM;
        const float* xin = (L == 0) ? p.in[zo + I_X] : X;
        { Epi<EPI_B1> e{}; e.o16 = P; e.o32 = SM; e.vf = (L == 0) ? VF : nullptr; e.mu = p.in[zo + I_RMU] + L * 1696; e.stp = (bf16_t*)(ws + WB_R + 7 * MiB / 2); e.sts = (float*)(ws + WB_R + 5 * MiB);
          gemm_phase<Epi<EPI_B1>, false>(lds, H, DM, (const bf16_t*)(ws + WB_R), T, 1792, 1024, e, zrow, G, bid); }
        xcd_barrier(xb);
        b1_fixup(p, L, (const bf16_t*)(ws + WB_R + 7 * MiB / 2), (const float*)(ws + WB_R + 5 * MiB));
        xcd_barrier(xb);
        {
            const int NR = 64, NO = G - NR;
            if (bid < NR) {
                for (int item = bid; item < 64; item += NR) rwkv_item_old(p, L, item, lds, false);
            } else {
                const int oc = bid - NR;
                { Epi<EPI_B2> e{}; e.o16 = P; gemm_phase<Epi<EPI_B2>, false>(lds, H, DM, (const bf16_t*)(ws + WB_2), T, 3840, 1024, e, zrow, NO, oc); }
                sub_barrier(subw + (L * 2 + 0) * 64, (unsigned)NO);
                for (int item = oc; item < 192; item += NO) {
                    if (item < 64) gla_item(p, L, item, lf, false);
                    else if (item < 128) plain_item<1>(p, L, item - 64, lf, false);
                    else lru_item(p, L, item - 128, lf, false);
                }
                sub_barrier(subw + (L * 2 + 1) * 64, (unsigned)NO);
                ssd_post(p, L, NO, oc);
                convert_weights(p, L, lf, 1408, 5312, NO, oc);
                if (L == 0) convert_weights(p, 1, lf, 0, 1408, NO, oc);
            }
        }
        xcd_barrier(xb);
        bf16_t* U = (L == 0) ? (bf16_t*)p.out : (bf16_t*)(ws + OFF_SM);
        for (int q = 0; q < 4; ++q) {
            { Epi<EPI_U> e{}; e.o16 = U; gemm_phase<Epi<EPI_U>, false>(lds, P + (size_t)q * 8192 * LDP, LDP, (const bf16_t*)(ws + WB_B), 8192, 4096, 512, e, zrow, G, bid); }
            xcd_barrier(xb);
            { Epi<EPI_MERGE> e{}; e.o16 = P + (size_t)q * 8192 * LDP; e.uq = U; gemm_phase<Epi<EPI_MERGE>, false>(lds, H + (size_t)q * 8192 * DM, DM, (const bf16_t*)(ws + WB_G), 8192, 4096, 1024, e, zrow, G, bid); }
            xcd_barrier(xb);
        }
        { Epi<EPI_O> e{}; e.o16 = P; gemm_phase<Epi<EPI_O>, false>(lds, P + PC_MERGED, LDP, (const bf16_t*)(ws + WB_O), T, 1024, 1024, e, zrow, G, bid); }
        xcd_barrier(xb);
        resnorm<1>(xin, P + PC_O, LDP, ng + DM, X, ng + 2 * DM, H);
        xcd_barrier(xb);
        { Epi<EPI_FFN> e{}; e.o16 = ACT; gemm_phase<Epi<EPI_FFN>, false>(lds, H, DM, (const bf16_t*)(ws + WB_F), T, 5632, 1024, e, zrow, G, bid); }
        xcd_barrier(xb);
        { Epi<EPI_DOWN> e{}; e.o16 = (bf16_t*)FO; gemm_phase<Epi<EPI_DOWN>, false>(lds, ACT, FH, (const bf16_t*)(ws + WB_D), T, 1024, FH, e, zrow, G, bid); }
        xcd_barrier(xb);
        if (L == 0) {
            resnorm<1>(X, FO, DM, ng + 3 * DM, X, p.in[zo + I_NG] + 4 * DM, H);
            xcd_barrier(xb);
        } else {
            resnorm<1>(X, FO, DM, ng + 3 * DM, X, nullptr, nullptr);
        }
    }
}

extern "C" void kernel_launch(void* const* d_in, const int* in_sizes, int n_in, void* d_out, int out_size, void* d_ws, size_t ws_size, hipStream_t stream) {
    static int grid_blocks = 0;
    if (grid_blocks == 0) {
        if (n_in != N_INPUTS || out_size != T * DM || ws_size < WS_END) { fprintf(stderr, "kernel_launch: unexpected problem (n_in %d, out %d, ws %zu)\n", n_in, out_size, ws_size); grid_blocks = -1; return; }
        int dev = 0, cus = 0, per_cu = 0;
        (void)hipGetDevice(&dev); (void)hipDeviceGetAttribute(&cus, hipDeviceAttributeMultiprocessorCount, dev);
        if (hipFuncSetAttribute((const void*)mega, hipFuncAttributeMaxDynamicSharedMemorySize, LDS_BYTES) != hipSuccess) { fprintf(stderr, "kernel_launch: hipFuncSetAttribute failed\n"); grid_blocks = -1; return; }
        if (hipOccupancyMaxActiveBlocksPerMultiprocessor(&per_cu, (const void*)mega, 512, LDS_BYTES) != hipSuccess || per_cu < 1) { fprintf(stderr, "kernel_launch: occupancy query says %d\n", per_cu); per_cu = 1; }
        (void)hipGetLastError();
        grid_blocks = cus * 1;
        if (grid_blocks < 128) { fprintf(stderr, "kernel_launch: needs at least 128 CUs\n"); grid_blocks = -1; return; }
    }
    if (grid_blocks < 0) return;
    if (hipMemsetAsync((char*)d_ws + OFF_BAR, 0, 4096 * 4, stream) != hipSuccess) { fprintf(stderr, "kernel_launch: memset failed\n"); return; }
    Params p{};
    for (int i = 0; i < N_INPUTS; ++i) p.in[i] = (const float*)d_in[i];
    p.out = (float*)d_out; p.ws = (unsigned char*)d_ws;
    void* args[] = {&p};
    hipError_t e = hipLaunchCooperativeKernel((const void*)mega, dim3(grid_blocks), dim3(512), args, LDS_BYTES, stream);
    if (e != hipSuccess) fprintf(stderr, "cooperative launch failed: %s (grid %d)\n", hipGetErrorString(e), grid_blocks);
}
```
